# Optimizing an MI355X kernel written in HIP

```python
import jax
import jax.numpy as jnp
from jax import lax
import numpy as np

D_MODEL = 2048
BATCH = 8
SEQ = 4096
DEPTH = 4

GRID_W = 64
CTX_LEN = 256
N_MIXERS = 2
N_ATTN_LAYERS = (DEPTH + 1) // 2
N_MLSTM_LAYERS = DEPTH // 2
RMS_EPS = 1e-6

ATTN_HEAD_DIM = 128
ATTN_Q_HEADS = D_MODEL // ATTN_HEAD_DIM
ATTN_KV_HEADS = 4
ATTN_GROUP = ATTN_Q_HEADS // ATTN_KV_HEADS
ATTN_QKV_COLS = (ATTN_Q_HEADS + 2 * ATTN_KV_HEADS) * ATTN_HEAD_DIM
WINDOW = 128
ATTN_BLOCK = WINDOW
ROPE_THETA = 10000.0
NEG_INF = -1e30

MLSTM_HEADS = 8
MLSTM_DV = D_MODEL // MLSTM_HEADS
MLSTM_DQK = MLSTM_DV // 2
MLSTM_CHUNK = 64
MLSTM_QK_COLS = MLSTM_HEADS * MLSTM_DQK
MLSTM_V_COLS = MLSTM_HEADS * MLSTM_DV
MLSTM_IN_COLS = 2 * MLSTM_QK_COLS + 2 * MLSTM_V_COLS + 4 * MLSTM_HEADS

D_FF = 5632
CONV_W = 3

kernel_name = 'hybrid_swa_mlstm_convffn_dit'


def rmsnorm(x, g):
    xf = x.astype(jnp.float32)
    y = xf * lax.rsqrt(jnp.mean(xf * xf, axis=-1, keepdims=True) + RMS_EPS)
    return (y * g.astype(jnp.float32)).astype(x.dtype)


def modulate(h, shift, scale):
    return h * (1.0 + scale) + shift


def axial_rope_tables(n_tokens):
    rows = n_tokens // GRID_W
    row = jnp.repeat(jnp.arange(rows, dtype=jnp.float32), GRID_W)
    col = jnp.tile(jnp.arange(GRID_W, dtype=jnp.float32), rows)
    n_freq = ATTN_HEAD_DIM // 4
    inv_freq = ROPE_THETA ** (-jnp.arange(n_freq, dtype=jnp.float32) / n_freq)
    ang = jnp.concatenate([row[:, None] * inv_freq, col[:, None] * inv_freq], axis=-1)
    ang = jnp.concatenate([ang, ang], axis=-1)
    return jnp.cos(ang), jnp.sin(ang)


def apply_rope(t, cos, sin):
    half = t.shape[-1] // 2
    tf = t.astype(jnp.float32)
    rot = jnp.concatenate([-tf[..., half:], tf[..., :half]], axis=-1)
    return (tf * cos[None, :, None, :] + rot * sin[None, :, None, :]).astype(t.dtype)


def windowed_gqa_with_context(hx, hc, w_qkv, sink, w_o, cos, sin, need_ctx_out):
    B, L, _ = hx.shape
    Lc = hc.shape[1]
    H, KVH, G, Dh, BLK = ATTN_Q_HEADS, ATTN_KV_HEADS, ATTN_GROUP, ATTN_HEAD_DIM, ATTN_BLOCK
    scale = Dh ** -0.5

    def project(h):
        T = h.shape[1]
        q, k, v = jnp.split(h @ w_qkv, [H * Dh, (H + KVH) * Dh], axis=-1)
        return q.reshape(B, T, H, Dh), k.reshape(B, T, KVH, Dh), v.reshape(B, T, KVH, Dh)

    qx, kx, vx = project(hx)
    qc, kc, vc = project(hc)
    qx = apply_rope(qx, cos, sin)
    kx = apply_rope(kx, cos, sin)
    sink_g = sink.reshape(KVH, G).astype(jnp.float32)

    nb = L // BLK
    qb = qx.reshape(B, nb, BLK, KVH, G, Dh) * scale

    def band(t):
        tp = jnp.pad(t, ((0, 0), (BLK, BLK), (0, 0), (0, 0)))
        tb = tp.reshape(B, nb + 2, BLK, KVH, Dh)
        return jnp.concatenate([tb[:, :-2], tb[:, 1:-1], tb[:, 2:]], axis=2)

    kb, vb = band(kx), band(vx)
    qi = jnp.arange(BLK)[:, None]
    kj = jnp.arange(3 * BLK)[None, :]
    kpos = (jnp.arange(nb)[:, None, None] - 1) * BLK + kj[None]
    valid = (jnp.abs(kj - BLK - qi) <= WINDOW)[None] & (kpos >= 0) & (kpos < L)

    s_loc = jnp.einsum('bnqhgd,bnkhd->bhgnqk', qb, kb).astype(jnp.float32)
    s_loc = jnp.where(valid, s_loc, NEG_INF)
    s_ctx = jnp.einsum('bnqhgd,bchd->bhgnqc', qb, kc).astype(jnp.float32)
    s_sink = jnp.broadcast_to(sink_g[None, :, :, None, None, None], s_loc.shape[:-1] + (1,))
    p = jax.nn.softmax(jnp.concatenate([s_loc, s_ctx, s_sink], axis=-1), axis=-1).astype(vx.dtype)
    ox = (jnp.einsum('bhgnqk,bnkhd->bnqhgd', p[..., :3 * BLK], vb)
          + jnp.einsum('bhgnqc,bchd->bnqhgd', p[..., 3 * BLK:3 * BLK + Lc], vc))
    out_x = ox.reshape(B, L, H * Dh) @ w_o
    if not need_ctx_out:
        return out_x, None

    qcg = qc.reshape(B, Lc, KVH, G, Dh) * scale
    s_cc = jnp.einsum('bqhgd,bkhd->bhgqk', qcg, kc).astype(jnp.float32)
    s_sink_c = jnp.broadcast_to(sink_g[None, :, :, None, None], s_cc.shape[:-1] + (1,))
    pc = jax.nn.softmax(jnp.concatenate([s_cc, s_sink_c], axis=-1), axis=-1)[..., :Lc].astype(vc.dtype)
    oc = jnp.einsum('bhgqk,bkhd->bqhgd', pc, vc)
    out_c = oc.reshape(B, Lc, H * Dh) @ w_o
    return out_x, out_c


def mlstm_chunk_scan(q, k, v, i_pre, log_f, state):
    B, NH, T, _ = q.shape
    CH = MLSTM_CHUNK
    nc = T // CH

    def chunks(t):
        t = t.reshape(t.shape[:2] + (nc, CH) + t.shape[3:])
        return jnp.moveaxis(t, 2, 0)

    causal = jnp.tril(jnp.ones((CH, CH), dtype=bool))

    def step(carry, inp):
        C, n, m = carry
        qc, kc, vc, ic, fc = inp
        b = jnp.cumsum(fc, axis=-1)
        d = b[..., :, None] - b[..., None, :] + ic[..., None, :]
        d = jnp.where(causal, d, -jnp.inf)
        inter = b + m[..., None]
        m_t = jnp.maximum(inter, jnp.max(d, axis=-1))
        w = jnp.exp(d - m_t[..., None])
        e_inter = jnp.exp(inter - m_t)
        s = jnp.einsum('bhtd,bhsd->bhts', qc, kc) * w
        num = e_inter[..., None] * jnp.einsum('bhtd,bhdv->bhtv', qc, C) + jnp.einsum('bhts,bhsv->bhtv', s, vc)
        den = e_inter * jnp.einsum('bhtd,bhd->bht', qc, n) + jnp.sum(s, axis=-1)
        h = num / jnp.maximum(jnp.abs(den), jnp.exp(-m_t))[..., None]
        b_end = b[..., -1]
        g = b_end[..., None] - b + ic
        m_new = jnp.maximum(b_end + m, jnp.max(g, axis=-1))
        e_prev = jnp.exp(b_end + m - m_new)
        wg = jnp.exp(g - m_new[..., None])
        C_new = e_prev[..., None, None] * C + jnp.einsum('bhs,bhsd,bhsv->bhdv', wg, kc, vc)
        n_new = e_prev[..., None] * n + jnp.einsum('bhs,bhsd->bhd', wg, kc)
        return (C_new, n_new, m_new), h

    state, h = lax.scan(step, state, (chunks(q), chunks(k), chunks(v), chunks(i_pre), chunks(log_f)))
    h = jnp.moveaxis(h, 0, 2).reshape(B, NH, T, MLSTM_DV)
    return h, state


def mlstm_project(h, w_in, b_in):
    B, T, _ = h.shape
    NH = MLSTM_HEADS
    z = (h @ w_in + b_in).astype(jnp.float32)
    q, k, v, o, g = jnp.split(z, [MLSTM_QK_COLS, 2 * MLSTM_QK_COLS, 2 * MLSTM_QK_COLS + MLSTM_V_COLS,
                                  2 * MLSTM_QK_COLS + 2 * MLSTM_V_COLS], axis=-1)
    q = q.reshape(B, T, NH, MLSTM_DQK).transpose(0, 2, 1, 3)
    k = k.reshape(B, T, NH, MLSTM_DQK).transpose(0, 2, 1, 3) * (MLSTM_DQK ** -0.5)
    v = v.reshape(B, T, NH, MLSTM_DV).transpose(0, 2, 1, 3)
    g = g.reshape(B, T, 4, NH).transpose(2, 0, 3, 1)
    fwd = (g[0], jax.nn.log_sigmoid(g[1]))
    bwd = (g[2], jax.nn.log_sigmoid(g[3]))
    return q, k, v, o, fwd, bwd


def mlstm_output(h, o, g_head, w_o, dtype):
    B, NH, T, DV = h.shape
    hn = h * lax.rsqrt(jnp.mean(h * h, axis=-1, keepdims=True) + RMS_EPS)
    hn = hn.transpose(0, 2, 1, 3).reshape(B, T, NH * DV)
    y = jax.nn.sigmoid(o) * hn * g_head.astype(jnp.float32)
    return y.astype(dtype) @ w_o


def bidirectional_mlstm_with_context(hx, hc, w_in, b_in, g_head, w_o, need_ctx_out):
    B = hx.shape[0]
    qx, kx, vx, ox, fx, bx = mlstm_project(hx, w_in, b_in)
    qc, kc, vc, oc, fc, bc = mlstm_project(hc, w_in, b_in)
    zero = (jnp.zeros((B, MLSTM_HEADS, MLSTM_DQK, MLSTM_DV), jnp.float32),
            jnp.zeros((B, MLSTM_HEADS, MLSTM_DQK), jnp.float32),
            jnp.zeros((B, MLSTM_HEADS), jnp.float32))

    def flip(t):
        return jnp.flip(t, axis=2)

    hc_f, st_f = mlstm_chunk_scan(qc, kc, vc, fc[0], fc[1], zero)
    hx_f, _ = mlstm_chunk_scan(qx, kx, vx, fx[0], fx[1], st_f)
    hc_b, st_b = mlstm_chunk_scan(flip(qc), flip(kc), flip(vc), flip(bc[0]), flip(bc[1]), zero)
    hx_b, _ = mlstm_chunk_scan(flip(qx), flip(kx), flip(vx), flip(bx[0]), flip(bx[1]), st_b)

    out_x = mlstm_output(hx_f + flip(hx_b), ox, g_head, w_o, hx.dtype)
    if not need_ctx_out:
        return out_x, None
    out_c = mlstm_output(hc_f + flip(hc_b), oc, g_head, w_o, hc.dtype)
    return out_x, out_c


def conv_ffn(h, w_up, conv_w, conv_b, w_down):
    T = h.shape[1]
    u = h @ w_up
    pad = CONV_W // 2
    up = jnp.pad(u, ((0, 0), (pad, pad), (0, 0)))
    acc = conv_b
    for j in range(CONV_W):
        acc = acc + up[:, j:j + T] * conv_w[j]
    a, b = jnp.split(acc, 2, axis=-1)
    return (jax.nn.silu(a) * b) @ w_down


def setup_inputs(seed: int = 0) -> dict:
    key = jax.random.key(seed)
    ks = jax.random.split(key, 20)
    f32 = jnp.float32
    D = D_MODEL
    NH = MLSTM_HEADS

    def normal(k, shape, scale=1.0):
        return scale * jax.random.normal(k, shape, f32)

    gate_offset = jnp.concatenate([
        jnp.zeros((2 * MLSTM_QK_COLS + 2 * MLSTM_V_COLS,), f32),
        jnp.full((NH,), -2.0, f32), jnp.linspace(3.0, 6.0, NH, dtype=f32),
        jnp.full((NH,), -2.0, f32), jnp.linspace(3.0, 6.0, NH, dtype=f32)])
    return {
        'x': normal(ks[0], (BATCH, SEQ, D)),
        'c': normal(ks[1], (BATCH, D)),
        'ctx': normal(ks[2], (BATCH, CTX_LEN, D)),
        'c_ctx': normal(ks[3], (D,)),
        'w_mod': normal(ks[4], (DEPTH, D, 6 * D), 0.5 * D ** -0.5),
        'b_mod': normal(ks[5], (DEPTH, 6 * D), 0.02),
        'g_mix': 1.0 + normal(ks[6], (DEPTH, D), 0.02),
        'g_ffn': 1.0 + normal(ks[7], (DEPTH, D), 0.02),
        'attn_w_qkv': normal(ks[8], (N_ATTN_LAYERS, D, ATTN_QKV_COLS), D ** -0.5),
        'attn_sink': normal(ks[9], (N_ATTN_LAYERS, ATTN_Q_HEADS)),
        'attn_w_o': normal(ks[10], (N_ATTN_LAYERS, ATTN_Q_HEADS * ATTN_HEAD_DIM, D), (ATTN_Q_HEADS * ATTN_HEAD_DIM) ** -0.5),
        'mlstm_w_in': normal(ks[11], (N_MLSTM_LAYERS, D, MLSTM_IN_COLS), D ** -0.5),
        'mlstm_b_in': gate_offset + normal(ks[12], (N_MLSTM_LAYERS, MLSTM_IN_COLS), 0.05),
        'mlstm_g_head': 1.0 + normal(ks[13], (N_MLSTM_LAYERS, MLSTM_V_COLS), 0.02),
        'mlstm_w_o': normal(ks[14], (N_MLSTM_LAYERS, MLSTM_V_COLS, D), MLSTM_V_COLS ** -0.5),
        'ffn_w_up': normal(ks[15], (DEPTH, D, 2 * D_FF), D ** -0.5),
        'ffn_conv_w': normal(ks[16], (DEPTH, CONV_W, 2 * D_FF), CONV_W ** -0.5),
        'ffn_conv_b': normal(ks[17], (DEPTH, 2 * D_FF), 0.02),
        'ffn_w_down': normal(ks[18], (DEPTH, D_FF, D), D_FF ** -0.5),
        'g_final': 1.0 + normal(ks[19], (D,), 0.02),
    }


def reference(x, c, ctx, c_ctx, w_mod, b_mod, g_mix, g_ffn, attn_w_qkv, attn_sink, attn_w_o,
              mlstm_w_in, mlstm_b_in, mlstm_g_head, mlstm_w_o, ffn_w_up, ffn_conv_w, ffn_conv_b,
              ffn_w_down, g_final):
    L = x.shape[1]
    cos, sin = axial_rope_tables(L)
    sc = jax.nn.silu(c)
    scc = jax.nn.silu(c_ctx)
    for i in range(DEPTH):
        last = i == DEPTH - 1
        j = i // N_MIXERS
        mx = (sc @ w_mod[i] + b_mod[i])[:, None, :]
        mc = scc @ w_mod[i] + b_mod[i]
        sh1x, sc1x, gt1x, sh2x, sc2x, gt2x = jnp.split(mx, 6, axis=-1)
        sh1c, sc1c, gt1c, sh2c, sc2c, gt2c = jnp.split(mc, 6, axis=-1)

        hx = modulate(rmsnorm(x, g_mix[i]), sh1x, sc1x)
        hc = modulate(rmsnorm(ctx, g_mix[i]), sh1c, sc1c)
        if i % N_MIXERS == 0:
            dx, dc = windowed_gqa_with_context(hx, hc, attn_w_qkv[j], attn_sink[j], attn_w_o[j],
                                               cos, sin, not last)
        else:
            dx, dc = bidirectional_mlstm_with_context(hx, hc, mlstm_w_in[j], mlstm_b_in[j],
                                                      mlstm_g_head[j], mlstm_w_o[j], not last)
        x = x + gt1x * dx
        hx = modulate(rmsnorm(x, g_ffn[i]), sh2x, sc2x)
        x = x + gt2x * conv_ffn(hx, ffn_w_up[i], ffn_conv_w[i], ffn_conv_b[i], ffn_w_down[i])
        if not last:
            ctx = ctx + gt1c * dc
            hc = modulate(rmsnorm(ctx, g_ffn[i]), sh2c, sc2c)
            ctx = ctx + gt2c * conv_ffn(hc, ffn_w_up[i], ffn_conv_w[i], ffn_conv_b[i], ffn_w_down[i])
    return rmsnorm(x, g_final)
```

```cpp
#include <hip/hip_runtime.h>
namespace pg8 {
#define PG8_LAS __attribute__((address_space(3)))
typedef unsigned short bf16_t;
typedef short bf16x8 __attribute__((ext_vector_type(8)));
typedef float f32x4 __attribute__((ext_vector_type(4)));
typedef unsigned u32x4 __attribute__((ext_vector_type(4)));
constexpr int BM = 256, BK = 64, HALF = 128, HTB = HALF * BK * 2  , STAGE_BYTES = 8 * HTB, NXCD = 8, WGM = 8;

__host__ __device__ __forceinline__ int lds_byte(int r, int c) { const int st = (r >> 4) * 2 + (c >> 5), rr = r & 15, cc = c & 31, ob = rr * 64 + cc * 2; return st * 1024 + (ob ^ (((ob >> 9) & 1) << 5)); }
__host__ __device__ __forceinline__ void stage_rc(int b, int& R, int& C) { const int st = b / 1024, sb = b % 1024, swz = sb ^ (((sb >> 9) & 1) << 5); R = (st >> 1) * 16 + swz / 64; C = (st & 1) * 32 + (swz % 64) / 2; }
__host__ __device__ __forceinline__ int perm32(int rho) { const int n = rho >> 4, i = rho & 15; return 8 * (i >> 2) + 4 * n + (i & 3); }

struct Unit { int pm, pn; };
struct Gemm { const bf16_t* A; const bf16_t* Bt; int M, N, K; };

struct StaticOrder {
    int nM, nN, nwg, G, c;
    __host__ __device__ void init(int M, int N, int G_, int c_) { nM = M / BM; nN = N / BM; nwg = nM * nN; G = G_; c = c_; }
    __host__ __device__ bool next(int i, Unit& u) const {
        const long L = (long)i * G + c; if (L >= nwg) return false;
        int wgid = (int)L; { const int q = nwg / NXCD, r = nwg % NXCD, xcd = wgid % NXCD, off = wgid / NXCD; wgid = (xcd < r ? xcd * (q + 1) : r * (q + 1) + (xcd - r) * q) + off; }
        const int nig = WGM * nN, gid = wgid / nig, fm = gid * WGM, gsz = (nM - fm) < WGM ? (nM - fm) : WGM;
        u.pm = fm + ((wgid % nig) % gsz); u.pn = (wgid % nig) / gsz; return true;
    }
    __device__ __forceinline__ void a_ready(const Unit&) const {}
    __device__ __forceinline__ void done(const Unit&) const {}
};
struct CountedOrder : StaticOrder {
    const unsigned* ready; unsigned need; unsigned* tmo;
    __device__ __forceinline__ void a_ready(const Unit& u) const {
        if (threadIdx.x < 64) {
            const unsigned long long t0 = __builtin_amdgcn_s_memrealtime(); unsigned polls = 0;
            while ((unsigned)__builtin_amdgcn_readfirstlane(__hip_atomic_load(ready + 64 * u.pm, __ATOMIC_RELAXED, __HIP_MEMORY_SCOPE_AGENT)) < need) {
                if ((++polls & 255u) == 0u && __builtin_amdgcn_readfirstlane(__hip_atomic_load(tmo, __ATOMIC_RELAXED, __HIP_MEMORY_SCOPE_AGENT)) != 0u) break;
                if (__builtin_amdgcn_s_memrealtime() - t0 > 2000000ull) {
                    if (threadIdx.x == 0) { unsigned expect = 0u; __hip_atomic_compare_exchange_strong(tmo + 1, &expect, 0x600u | (unsigned)(u.pm & 0xff), __ATOMIC_RELAXED, __ATOMIC_RELAXED, __HIP_MEMORY_SCOPE_AGENT); __hip_atomic_store(tmo, 1u, __ATOMIC_RELAXED, __HIP_MEMORY_SCOPE_AGENT); }
                    break; }
                __builtin_amdgcn_s_sleep(2); }
            __builtin_amdgcn_fence(__ATOMIC_ACQUIRE, "agent");
            asm volatile("s_waitcnt vmcnt(0)" ::: "memory");
        }
#if !defined(BROKEN_HOOK_NO_BARRIER)
        asm volatile("" ::: "memory"); __builtin_amdgcn_s_barrier(); asm volatile("" ::: "memory");
#endif
    }
};

template <class Epi, class Sched, bool STAMP = false>
__device__ __forceinline__ void gemm_phase(PG8_LAS unsigned char* lds, const Gemm g, const Sched& S, const Epi& E, unsigned long long* stamps) {
    int tid_l = threadIdx.x; asm volatile("" : "+v"(tid_l));
    const int tid = tid_l, wid = __builtin_amdgcn_readfirstlane(tid >> 6), lane = tid & 63, wr = wid >> 2, wc = wid & 3, fr = lane & 15, fq = lane >> 4;
    const int K = g.K, nt = K / BK;
    int ts_lo = 0, ts_hi = 0, nts = 0; const unsigned long long rt_entry = STAMP ? (unsigned long long)wall_clock64() : 0ull;
#define PG8_STAMP() do { if (STAMP && wid == 0 && nts < 64) { const unsigned long long _c = (unsigned long long)clock64(); \
        ts_lo = (lane == nts) ? (int)(unsigned)_c : ts_lo; ts_hi = (lane == nts) ? (int)(unsigned)(_c >> 32) : ts_hi; ++nts; } } while (0)
    PG8_STAMP();
    unsigned voffA[2], voffB[2];
#pragma unroll
    for (int i = 0; i < 2; ++i) { int R, C; stage_rc(tid * 16 + i * 8192, R, C); const int Rb = Epi::PERM ? ((R & ~31) + perm32(R & 31)) : R;
        voffA[i] = (unsigned)(R * K + C) * 2u; voffB[i] = (unsigned)(Rb * K + C) * 2u; }
    const size_t kstep = (size_t)(BK * 2);
    const size_t hstep = (size_t)HALF * K * 2;
    const size_t tstep = 2 * hstep;
    const unsigned ldsw = (unsigned)wid * 1024u;
    const int aoff = lds_byte(wr * 64 + fr, fq * 8), boff = lds_byte(wc * 32 + fr, fq * 8);
#define PG8_SA(b, h) (((b) * 2 + (h)) * HTB)
#define PG8_SB(b, h) ((4 + (b) * 2 + (h)) * HTB)
#define PG8_STAGE(bufoff, gbase, voff) do { _Pragma("unroll") for (int _i = 0; _i < 2; ++_i) \
        __builtin_amdgcn_global_load_lds((const unsigned*)((const char*)(gbase) + (voff)[_i]), (PG8_LAS unsigned*)(lds + (bufoff) + ldsw + _i * 8192), 16, 0, 0); } while (0)
#define PG8_LDA(dst, b, h) do { _Pragma("unroll") for (int m = 0; m < 4; ++m) _Pragma("unroll") for (int k = 0; k < 2; ++k) dst[m][k] = *(const PG8_LAS bf16x8*)(lds + PG8_SA(b, h) + aoff + m * 2048 + k * 1024); } while (0)
#define PG8_LDB(dst, b, h) do { _Pragma("unroll") for (int n = 0; n < 2; ++n) _Pragma("unroll") for (int k = 0; k < 2; ++k) dst[n][k] = *(const PG8_LAS bf16x8*)(lds + PG8_SB(b, h) + boff + n * 2048 + k * 1024); } while (0)
#define PG8_MMA(ai, bj, At, Bt) do { __builtin_amdgcn_s_setprio(1); _Pragma("unroll") for (int m = 0; m < 4; ++m) _Pragma("unroll") for (int n = 0; n < 2; ++n) _Pragma("unroll") for (int k = 0; k < 2; ++k) \
        acc[ai][bj][m][n] = __builtin_amdgcn_mfma_f32_16x16x32_bf16(Bt[n][k], At[m][k], acc[ai][bj][m][n], 0, 0, 0); __builtin_amdgcn_s_setprio(0); } while (0)
#define PG8_WAIT_V(n) asm volatile("s_waitcnt vmcnt(" #n ")" ::: "memory")
#define PG8_WAIT_L(n) asm volatile("s_waitcnt lgkmcnt(" #n ")" ::: "memory")
#define PG8_BAR __builtin_amdgcn_s_barrier()
#define PG8_SCHED __builtin_amdgcn_sched_barrier(0)
    Unit cur, nxt; int ui = 0;
    if (!S.next(0, cur)) return;
    f32x4 acc[2][2][4][2];
#pragma unroll
    for (int a = 0; a < 2; ++a)
#pragma unroll
        for (int b = 0; b < 2; ++b)
#pragma unroll
            for (int m = 0; m < 4; ++m)
#pragma unroll
                for (int n = 0; n < 2; ++n) acc[a][b][m][n] = (f32x4){0.f, 0.f, 0.f, 0.f};
    bf16x8 At[4][2], B0[2][2], B1[2][2];
    const char* cA = (const char*)g.A + (size_t)cur.pm * tstep; const char* cB = (const char*)g.Bt + (size_t)cur.pn * tstep;
    S.a_ready(cur);
    PG8_STAGE(PG8_SB(0, 0), cB, voffB); PG8_STAGE(PG8_SA(0, 0), cA, voffA); PG8_STAGE(PG8_SB(0, 1), cB + hstep, voffB); PG8_STAGE(PG8_SA(0, 1), cA + hstep, voffA);
    if (wr == 1) PG8_BAR;
    PG8_WAIT_V(4); PG8_BAR;
    PG8_STAGE(PG8_SB(1, 0), cB + kstep, voffB); PG8_STAGE(PG8_SA(1, 0), cA + kstep, voffA); PG8_STAGE(PG8_SB(1, 1), cB + hstep + kstep, voffB);
    PG8_WAIT_V(6); PG8_BAR;
    PG8_STAMP();
    for (;;) {
        const bool has_next = S.next(ui + 1, nxt);
        const char* nA = has_next ? (const char*)g.A + (size_t)nxt.pm * tstep : cA; const char* nB = has_next ? (const char*)g.Bt + (size_t)nxt.pn * tstep : cB;
        for (int t = 0; t < nt; t += 2) {
            const bool last = (t == nt - 2);
            const char* a1 = cA + (size_t)(t + 1) * kstep;
            const char* a2 = last ? nA : cA + (size_t)(t + 2) * kstep; const char* b2 = last ? nB : cB + (size_t)(t + 2) * kstep;
            const char* a3 = a2 + kstep; const char* b3 = b2 + kstep;
            if (last && has_next) S.a_ready(nxt);
            PG8_LDB(B0, 0, 0); PG8_SCHED; PG8_LDA(At, 0, 0); PG8_STAGE(PG8_SA(1, 1), a1 + hstep, voffA);
            PG8_WAIT_L(8); PG8_BAR; PG8_WAIT_L(0); PG8_MMA(0, 0, At, B0); PG8_BAR; PG8_SCHED;
            PG8_LDB(B1, 0, 1); PG8_STAGE(PG8_SB(0, 0), b2, voffB);
            PG8_BAR; PG8_WAIT_L(0); PG8_MMA(0, 1, At, B1); PG8_BAR;
            PG8_LDA(At, 0, 1); PG8_STAGE(PG8_SA(0, 0), a2, voffA);
            PG8_BAR; PG8_WAIT_L(0); PG8_MMA(1, 0, At, B0); PG8_BAR; PG8_SCHED;
            PG8_STAGE(PG8_SB(0, 1), b2 + hstep, voffB);
            PG8_WAIT_V(6); PG8_BAR; PG8_MMA(1, 1, At, B1); PG8_BAR;
            PG8_LDB(B0, 1, 0); PG8_SCHED; PG8_LDA(At, 1, 0); PG8_STAGE(PG8_SA(0, 1), a2 + hstep, voffA);
            PG8_WAIT_L(8); PG8_BAR; PG8_WAIT_L(0); PG8_MMA(0, 0, At, B0); PG8_BAR; PG8_SCHED;
            PG8_LDB(B1, 1, 1); PG8_STAGE(PG8_SB(1, 0), b3, voffB);
            PG8_BAR; PG8_WAIT_L(0); PG8_MMA(0, 1, At, B1); PG8_BAR;
            PG8_LDA(At, 1, 1); PG8_STAGE(PG8_SA(1, 0), a3, voffA);
            PG8_BAR; PG8_WAIT_L(0); PG8_MMA(1, 0, At, B0); PG8_BAR; PG8_SCHED;
            PG8_STAGE(PG8_SB(1, 1), b3 + hstep, voffB);
            PG8_WAIT_V(6); PG8_BAR; PG8_MMA(1, 1, At, B1); PG8_BAR;
        }
        PG8_STAMP();
        if constexpr (!Epi::AFTER_DRAIN) { E(acc, cur, wr, wc, fr, fq); S.done(cur); }
        PG8_STAMP();
        if (!has_next) break;
#pragma unroll
        for (int a = 0; a < 2; ++a)
#pragma unroll
            for (int b = 0; b < 2; ++b)
#pragma unroll
                for (int m = 0; m < 4; ++m)
#pragma unroll
                    for (int n = 0; n < 2; ++n) acc[a][b][m][n] = (f32x4){0.f, 0.f, 0.f, 0.f};
        cur = nxt; cA = nA; cB = nB; ++ui;
    }
    PG8_WAIT_V(0);
    if (wr == 0) PG8_BAR;
    PG8_BAR;
    if constexpr (Epi::AFTER_DRAIN) { E.fused(acc, cur, wr, wc, fr, fq, lds, wid, lane); S.done(cur); }
    PG8_STAMP();
    if (STAMP && wid == 0) { stamps[lane] = lane < nts ? (((unsigned long long)(unsigned)ts_hi << 32) | (unsigned)ts_lo) : 0ull;
        if (lane == 62) stamps[62] = rt_entry; if (lane == 63) stamps[63] = (unsigned long long)wall_clock64(); }
#undef PG8_STAMP
#undef PG8_SA
#undef PG8_SB
#undef PG8_STAGE
#undef PG8_LDA
#undef PG8_LDB
#undef PG8_MMA
#undef PG8_WAIT_V
#undef PG8_WAIT_L
#undef PG8_BAR
#undef PG8_SCHED
}
}

#include <cstdio>
#include <cstdint>
#define LAS __attribute__((address_space(3)))
typedef unsigned short bf16_t;
typedef short bf16x8 __attribute__((ext_vector_type(8)));
typedef short s16x4 __attribute__((ext_vector_type(4)));
typedef float f32x4 __attribute__((ext_vector_type(4)));
typedef float f32x8 __attribute__((ext_vector_type(8)));
typedef float f32x16 __attribute__((ext_vector_type(16)));
typedef unsigned u32x4 __attribute__((ext_vector_type(4)));
typedef unsigned u32x2 __attribute__((ext_vector_type(2)));

constexpr int DM = 2048, NBATCH = 8, SEQ = 4096, CTXL = 256;
constexpr int MX = NBATCH * SEQ, MC = NBATCH * CTXL, MT = MX + MC;
constexpr int NQKV = 3072, NMI = 6144, NMI_RAW = 6176, NMI_PAD = 6400, DFF = 5632, NUP = 2 * DFF;
constexpr int MODW = 6 * DM;
constexpr float RMS_EPS = 1e-6f;
constexpr int NTHREADS = 512, NWAVES = 8;

constexpr size_t MiB = 1u << 20;
constexpr size_t WS_CTL = 0, CTL_ZERO_BYTES = 1 * MiB;
constexpr size_t WS_MOD = 1 * MiB;
constexpr size_t WS_ROPE = 3 * MiB;
constexpr size_t WS_WQKV = 8 * MiB;
constexpr size_t WS_WAO = 32 * MiB;
constexpr size_t WS_WMI = 48 * MiB;
constexpr size_t WS_WMO = 98 * MiB;
constexpr size_t WS_WUP = 114 * MiB;
constexpr size_t WS_WDN = 290 * MiB;
constexpr size_t WS_X = 378 * MiB;
constexpr size_t WS_H = 650 * MiB;
constexpr size_t WS_Z = 786 * MiB;
constexpr size_t WS_GATE = 1194 * MiB;
constexpr size_t WS_HF = 1200 * MiB;
constexpr size_t WS_HB = 1336 * MiB;
constexpr size_t WS_END = 1472 * MiB;
constexpr int CW_TMO = 0;
constexpr int CW_BAR = 4096;

constexpr int LDS_BYTES = 147456;
constexpr int MISC_OFF = 131072 + 320;

#define XB_TMO      128
#define XB_XCNT(j)  (256  + 64 * (j))
#define XB_XSUB(j)  (1280 + 64 * (j))
#define XB_XGEN(j)  (2304 + 64 * (j))
#define XB_TOP      3328
#define XB_TOPGEN   3392
#define XCD_BAR_WORDS 3456
#define XB_SPIN_CAP (1u << 18)

__device__ __forceinline__ unsigned xb_ld(unsigned* p)              { return __hip_atomic_load(p, __ATOMIC_RELAXED, __HIP_MEMORY_SCOPE_AGENT); }
__device__ __forceinline__ unsigned xb_add(unsigned* p, unsigned v) { return __hip_atomic_fetch_add(p, v, __ATOMIC_RELAXED, __HIP_MEMORY_SCOPE_AGENT); }
__device__ __forceinline__ unsigned xb_xcc_id() { return (unsigned)__builtin_amdgcn_s_getreg((3 << 11) | 20) & 0xFu; }
#define XB_SPIN(cond, bar) do { unsigned _sp = 0; while (cond) { __builtin_amdgcn_s_sleep(1); \
    if ((++_sp & 255u) == 0u) { if (xb_ld(&(bar)[XB_TMO])) break; if (_sp > XB_SPIN_CAP) { atomicAdd(&(bar)[XB_TMO], 1u); break; } } } } while (0)

struct XcdBarrier { unsigned* bar; unsigned x; volatile LAS unsigned* st; };

__device__ __forceinline__ XcdBarrier xcd_barrier_post(unsigned* bar, volatile LAS unsigned* st) {
    XcdBarrier b; b.bar = bar; b.x = xb_xcc_id(); b.st = st;
    if (threadIdx.x == 0) (void)xb_add(&bar[XB_XCNT(b.x)], 1u);
    return b;
}
__device__ __forceinline__ void xcd_barrier_complete(unsigned* bar, unsigned x, unsigned& nloc, unsigned& nx) {
    const unsigned G = gridDim.x * gridDim.y * gridDim.z;
    unsigned sum, cnt, mine, sp = 0u;
    for (;;) {
        sum = 0u; cnt = 0u; mine = 0u;
#pragma unroll
        for (unsigned j = 0; j < 16; ++j) { const unsigned c = xb_ld(&bar[XB_XCNT(j)]); sum += c; cnt += (c > 0u) ? 1u : 0u; mine = (j == x) ? c : mine; }
        if (sum == G) break;
        __builtin_amdgcn_s_sleep(1);
        if ((++sp & 255u) == 0u) { if (xb_ld(&bar[XB_TMO])) break; if (sp > XB_SPIN_CAP) { atomicAdd(&bar[XB_TMO], 1u); break; } }
    }
    nloc = mine > 0u ? mine : 1u; nx = cnt > 0u ? cnt : 1u;
}
__device__ __forceinline__ void xcd_barrier(const XcdBarrier& b) {
    asm volatile("s_waitcnt vmcnt(0)" ::: "memory");
    __syncthreads();
    if (threadIdx.x == 0) {
        unsigned* bar = b.bar;
        __builtin_amdgcn_s_waitcnt(0);
        unsigned nloc = b.st[0], nx = b.st[1];
        if (nloc == 0u) { xcd_barrier_complete(bar, b.x, nloc, nx); b.st[0] = nloc; b.st[1] = nx; }
        const unsigned old = xb_add(&bar[XB_XSUB(b.x)], 1u);
        const unsigned gen = old / nloc;
        if (old + 1u == (gen + 1u) * nloc) {
            __builtin_amdgcn_fence(__ATOMIC_RELEASE, "agent");
            asm volatile("s_waitcnt vmcnt(0)" ::: "memory");
            const unsigned og = xb_add(&bar[XB_TOP], 1u);
            const unsigned tg = og / nx;
            if (og + 1u == (tg + 1u) * nx) xb_add(&bar[XB_TOPGEN], 1u);
            else XB_SPIN(xb_ld(&bar[XB_TOPGEN]) == tg, bar);
            __builtin_amdgcn_fence(__ATOMIC_ACQUIRE, "agent");
            xb_add(&bar[XB_XGEN(b.x)], 1u);
            asm volatile("s_waitcnt vmcnt(0)" ::: "memory");
        } else {
            XB_SPIN(xb_ld(&bar[XB_XGEN(b.x)]) == gen, bar);
            __builtin_amdgcn_fence(__ATOMIC_ACQUIRE, "agent");
            asm volatile("s_waitcnt vmcnt(0)" ::: "memory");
        }
    }
    __syncthreads();
}

#define LDS_WAIT() asm volatile("s_waitcnt lgkmcnt(0)" ::: "memory")
__device__ __forceinline__ unsigned cvtpk(float lo, float hi) { unsigned r; asm volatile("v_cvt_pk_bf16_f32 %0, %1, %2" : "=v"(r) : "v"(lo), "v"(hi)); return r; }
__device__ __forceinline__ float bf2f(bf16_t b) { return __uint_as_float(((unsigned)b) << 16); }
__device__ __forceinline__ float bflo(unsigned w) { return __uint_as_float(w << 16); }
__device__ __forceinline__ float bfhi(unsigned w) { return __uint_as_float(w & 0xffff0000u); }
__device__ __forceinline__ float wave_sum(float v) {
#pragma unroll
    for (int o = 1; o < 64; o <<= 1) v += __shfl_xor(v, o);
    return v;
}
__device__ __forceinline__ float silu_f(float v) { return v / (1.0f + __expf(-v)); }
__device__ __forceinline__ float sigmoid_f(float v) { return 1.0f / (1.0f + __expf(-v)); }
__device__ __forceinline__ float log_sigmoid_f(float v) { return v < 0.f ? v - log1pf(expf(v)) : -log1pf(expf(-v)); }

struct Args { const float* in[20]; float* out; unsigned char* ws; int ph_lo, ph_hi; int li, pad; };
enum { I_X = 0, I_C, I_CTX, I_CCTX, I_WMOD, I_BMOD, I_GMIX, I_GFFN, I_WQKV, I_SINK, I_WAO, I_WMI, I_BMI, I_GHEAD, I_WMO, I_WUP, I_CONVW, I_CONVB, I_WDN, I_GFINAL };

__device__ __forceinline__ void p0_transpose_item(const float* W, int K, int N, bf16_t* WT, LAS float* scr, int item, int lane) {
    const int nblk = N / 32, kb = item / nblk, nb = item % nblk, k0 = 64 * kb, n0 = 32 * nb;
#pragma unroll 8
    for (int i = 0; i < 32; ++i) { const int kk = 2 * i + (lane >> 5); scr[kk * 33 + (lane & 31)] = W[(size_t)(k0 + kk) * N + n0 + (lane & 31)]; }
    LDS_WAIT(); asm volatile("" ::: "memory");
    const int c = lane & 7;
#pragma unroll
    for (int j = 0; j < 4; ++j) { const int n = (lane >> 3) + 8 * j; const LAS float* s = scr + (8 * c) * 33 + n;
        u32x4 o; o.x = cvtpk(s[0 * 33], s[1 * 33]); o.y = cvtpk(s[2 * 33], s[3 * 33]); o.z = cvtpk(s[4 * 33], s[5 * 33]); o.w = cvtpk(s[6 * 33], s[7 * 33]);
        *(u32x4*)(WT + (size_t)(n0 + n) * K + k0 + 8 * c) = o; }
    LDS_WAIT(); asm volatile("" ::: "memory");
}
__device__ __forceinline__ void get_mat(const Args& a, int m, const float*& W, bf16_t*& WT, int& K, int& N) {
    unsigned char* ws = a.ws;
    if (m < 2)       { K = DM;  N = NQKV;    W = a.in[I_WQKV] + (size_t)m * DM * NQKV;          WT = (bf16_t*)(ws + WS_WQKV) + (size_t)m * NQKV * DM; }
    else if (m < 4)  { K = DM;  N = DM;      W = a.in[I_WAO] + (size_t)(m - 2) * DM * DM;       WT = (bf16_t*)(ws + WS_WAO) + (size_t)(m - 2) * DM * DM; }
    else if (m < 6)  { K = DM;  N = NMI_RAW; W = a.in[I_WMI] + (size_t)(m - 4) * DM * NMI_RAW;  WT = (bf16_t*)(ws + WS_WMI) + (size_t)(m - 4) * NMI_PAD * DM; }
    else if (m < 8)  { K = DM;  N = DM;      W = a.in[I_WMO] + (size_t)(m - 6) * DM * DM;       WT = (bf16_t*)(ws + WS_WMO) + (size_t)(m - 6) * DM * DM; }
    else if (m < 12) { K = DM;  N = NUP;     W = a.in[I_WUP] + (size_t)(m - 8) * DM * NUP;      WT = (bf16_t*)(ws + WS_WUP) + (size_t)(m - 8) * NUP * DM; }
    else             { K = DFF; N = DM;      W = a.in[I_WDN] + (size_t)(m - 12) * DFF * DM;     WT = (bf16_t*)(ws + WS_WDN) + (size_t)(m - 12) * DM * DFF; }
}
__device__ __forceinline__ void phase_prologue(const Args& a, LAS unsigned char* lds, int tid, int lane, int wave) {
    const int gw = blockIdx.x * NWAVES + wave, NGW = gridDim.x * NWAVES;
    LAS float* scr = (LAS float*)(lds + wave * 16384);
    for (int m = 0; m < 16; ++m) {
        const float* W; bf16_t* WT; int K, N; get_mat(a, m, W, WT, K, N);
        const int nitems = (K / 64) * (N / 32);
        for (int it = gw; it < nitems; it += NGW) p0_transpose_item(W, K, N, WT, scr, it, lane);
    }
    {
        const size_t per = (size_t)(NMI_PAD - NMI_RAW) * DM / 8;
        const size_t gt = (size_t)blockIdx.x * NTHREADS + tid, GT = (size_t)gridDim.x * NTHREADS;
        for (size_t e = gt; e < 2 * per; e += GT) { const size_t j = e / per, o = e % per;
            *(u32x4*)((bf16_t*)(a.ws + WS_WMI) + j * NMI_PAD * DM + (size_t)NMI_RAW * DM + o * 8) = (u32x4){0u, 0u, 0u, 0u}; }
        float* rc = (float*)(a.ws + WS_ROPE); float* rs = (float*)(a.ws + WS_ROPE + 1 * MiB);
        for (size_t e = gt; e < (size_t)SEQ * 64; e += GT) { const int t = (int)(e >> 6), jj = (int)(e & 63), fi = jj & 31;
            const float inv = powf(10000.0f, -(float)fi / 32.0f); const float pos = (float)(jj < 32 ? (t >> 6) : (t & 63)); const float ang = pos * inv;
            rc[e] = cosf(ang); rs[e] = sinf(ang); }
    }
    __syncthreads();
    for (int bt = blockIdx.x; bt < 192; bt += gridDim.x) {
        LAS float* sc = (LAS float*)lds;
        for (int e = tid; e < 9 * DM; e += NTHREADS) { const int r = e / DM, k = e % DM; const float v = r < 8 ? a.in[I_C][r * DM + k] : a.in[I_CCTX][k]; sc[e] = v / (1.0f + expf(-v)); }
        __syncthreads();
        const int i = bt / 48, n0 = (bt % 48) * 256 + wave * 32 + (lane & 7) * 4, kp = lane >> 3;
        float acc[9][4];
#pragma unroll
        for (int r = 0; r < 9; ++r) { acc[r][0] = 0.f; acc[r][1] = 0.f; acc[r][2] = 0.f; acc[r][3] = 0.f; }
        const float* wp = a.in[I_WMOD] + (size_t)i * DM * MODW + n0;
#pragma unroll 4
        for (int k = kp; k < DM; k += 8) {
            const f32x4 w = *(const f32x4*)(wp + (size_t)k * MODW);
#pragma unroll
            for (int r = 0; r < 9; ++r) { const float s = sc[r * DM + k]; acc[r][0] = fmaf(s, w[0], acc[r][0]); acc[r][1] = fmaf(s, w[1], acc[r][1]); acc[r][2] = fmaf(s, w[2], acc[r][2]); acc[r][3] = fmaf(s, w[3], acc[r][3]); }
        }
#pragma unroll
        for (int r = 0; r < 9; ++r)
#pragma unroll
            for (int j = 0; j < 4; ++j) { float v = acc[r][j]; v += __shfl_xor(v, 8); v += __shfl_xor(v, 16); v += __shfl_xor(v, 32); acc[r][j] = v; }
        if (kp == 0) {
            const f32x4 bv = *(const f32x4*)(a.in[I_BMOD] + (size_t)i * MODW + n0);
            float* mo = (float*)(a.ws + WS_MOD) + (size_t)i * 9 * MODW + n0;
#pragma unroll
            for (int r = 0; r < 9; ++r) *(f32x4*)(mo + (size_t)r * MODW) = (f32x4){acc[r][0] + bv[0], acc[r][1] + bv[1], acc[r][2] + bv[2], acc[r][3] + bv[3]};
        }
        __syncthreads();
    }
}

__device__ __forceinline__ void phase_norm(const float* xs, const float* cs, const float* g, const float* modl, int sh_off, int sc_off, bf16_t* H, int row_end, int lane, int wave) {
    const int gw = blockIdx.x * NWAVES + wave, NGW = gridDim.x * NWAVES;
    for (int r = gw; r < row_end; r += NGW) {
        const float* xr = (r < MX ? xs : cs) + (size_t)r * DM;
        const int mr = r < MX ? (r >> 12) : 8;
        f32x4 v[8]; float ss = 0.f;
#pragma unroll
        for (int j = 0; j < 8; ++j) { v[j] = *(const f32x4*)(xr + 4 * (lane + 64 * j)); ss += (v[j][0] * v[j][0] + v[j][1] * v[j][1]) + (v[j][2] * v[j][2] + v[j][3] * v[j][3]); }
        ss = wave_sum(ss);
        const float rs = 1.0f / sqrtf(ss * (1.0f / DM) + RMS_EPS);
        const float* mrow = modl + (size_t)mr * MODW;
#pragma unroll
        for (int j = 0; j < 8; ++j) { const int col = 4 * (lane + 64 * j);
            const f32x4 gg = *(const f32x4*)(g + col), scv = *(const f32x4*)(mrow + sc_off + col), shv = *(const f32x4*)(mrow + sh_off + col);
            float h[4];
#pragma unroll
            for (int e = 0; e < 4; ++e) h[e] = (v[j][e] * rs * gg[e]) * (1.0f + scv[e]) + shv[e];
            u32x2 o; o.x = cvtpk(h[0], h[1]); o.y = cvtpk(h[2], h[3]);
            *(u32x2*)(H + (size_t)r * DM + col) = o; }
    }
}
__device__ __forceinline__ void phase_final(const float* X, const float* g, float* out, int lane, int wave) {
    const int gw = blockIdx.x * NWAVES + wave, NGW = gridDim.x * NWAVES;
    for (int r = gw; r < MX; r += NGW) {
        const float* xr = X + (size_t)r * DM;
        f32x4 v[8]; float ss = 0.f;
#pragma unroll
        for (int j = 0; j < 8; ++j) { v[j] = *(const f32x4*)(xr + 4 * (lane + 64 * j)); ss += (v[j][0] * v[j][0] + v[j][1] * v[j][1]) + (v[j][2] * v[j][2] + v[j][3] * v[j][3]); }
        ss = wave_sum(ss);
        const float rs = 1.0f / sqrtf(ss * (1.0f / DM) + RMS_EPS);
#pragma unroll
        for (int j = 0; j < 8; ++j) { const int col = 4 * (lane + 64 * j); const f32x4 gg = *(const f32x4*)(g + col);
            *(f32x4*)(out + (size_t)r * DM + col) = (f32x4){v[j][0] * rs * gg[0], v[j][1] * rs * gg[1], v[j][2] * rs * gg[2], v[j][3] * rs * gg[3]}; }
    }
}

struct RangeOrder {
    pg8::StaticOrder b; int pm0;
    __device__ void init(int pm_lo, int pm_hi, int N, int G, int c) { b.init((pm_hi - pm_lo) * 256, N, G, c); pm0 = pm_lo; }
    __device__ __forceinline__ bool next(int i, pg8::Unit& u) const { if (!b.next(i, u)) return false; u.pm += pm0; return true; }
    __device__ __forceinline__ void a_ready(const pg8::Unit&) const {}
    __device__ __forceinline__ void done(const pg8::Unit&) const {}
};
struct EpiRes {
    static constexpr bool PERM = false, AFTER_DRAIN = false;
    const float* bx; const float* bc; float* out; const float* gate;
    __device__ __forceinline__ void operator()(const pg8::f32x4 (&acc)[2][2][4][2], const pg8::Unit& u, int wr, int wc, int fr, int fq) const {
        const int row0 = u.pm * 256 + wr * 64 + fr, col0 = u.pn * 256 + wc * 32 + 4 * fq;
        const int mr = u.pm < (MX / 256) ? (u.pm >> 4) : 8;
        const float* base = u.pm < (MX / 256) ? bx : bc;
        const float* gp = gate + (size_t)mr * MODW + col0;
        f32x4 gv[2][2];
#pragma unroll
        for (int bj = 0; bj < 2; ++bj)
#pragma unroll
            for (int n = 0; n < 2; ++n) gv[bj][n] = *(const f32x4*)(gp + bj * 128 + n * 16);
#pragma unroll
        for (int ai = 0; ai < 2; ++ai)
#pragma unroll
            for (int m = 0; m < 4; ++m) { const size_t off = (size_t)(row0 + ai * 128 + m * 16) * DM + col0;
#pragma unroll
                for (int bj = 0; bj < 2; ++bj)
#pragma unroll
                    for (int n = 0; n < 2; ++n) { const f32x4 bs = *(const f32x4*)(base + off + bj * 128 + n * 16);
                        *(f32x4*)(out + off + bj * 128 + n * 16) = bs + gv[bj][n] * acc[ai][bj][m][n]; }
                asm volatile("" ::: "memory"); }
    }
};
struct EpiBf {
    static constexpr bool PERM = true, AFTER_DRAIN = false;
    bf16_t* O; int ldc;
    __device__ __forceinline__ void operator()(const pg8::f32x4 (&acc)[2][2][4][2], const pg8::Unit& u, int wr, int wc, int fr, int fq) const {
        const int row0 = u.pm * 256 + wr * 64 + fr, col0 = u.pn * 256 + wc * 32 + 8 * fq;
#pragma unroll
        for (int ai = 0; ai < 2; ++ai)
#pragma unroll
            for (int m = 0; m < 4; ++m) { bf16_t* rowp = O + (size_t)(row0 + ai * 128 + m * 16) * ldc + col0;
#pragma unroll
                for (int bj = 0; bj < 2; ++bj) { const f32x4 v0 = acc[ai][bj][m][0], v1 = acc[ai][bj][m][1];
                    u32x4 w; w.x = cvtpk(v0[0], v0[1]); w.y = cvtpk(v0[2], v0[3]); w.z = cvtpk(v1[0], v1[1]); w.w = cvtpk(v1[2], v1[3]);
                    *(u32x4*)(rowp + bj * 128) = w; } }
    }
};
struct EpiMI {
    static constexpr bool PERM = true, AFTER_DRAIN = false;
    bf16_t* Z; float* G; const float* bias;
    __device__ __forceinline__ void operator()(const pg8::f32x4 (&acc)[2][2][4][2], const pg8::Unit& u, int wr, int wc, int fr, int fq) const {
        const int row0 = u.pm * 256 + wr * 64 + fr;
        if (u.pn < 24) {
            const int col0 = u.pn * 256 + wc * 32 + 8 * fq;
            const float sc = (u.pn >= 4 && u.pn < 8) ? 0.08838834764831845f : 1.0f;
            f32x4 bv[2][2];
#pragma unroll
            for (int bj = 0; bj < 2; ++bj)
#pragma unroll
                for (int n = 0; n < 2; ++n) bv[bj][n] = *(const f32x4*)(bias + col0 + bj * 128 + 4 * n);
#pragma unroll
            for (int ai = 0; ai < 2; ++ai)
#pragma unroll
                for (int m = 0; m < 4; ++m) { bf16_t* rowp = Z + (size_t)(row0 + ai * 128 + m * 16) * NMI + col0;
#pragma unroll
                    for (int bj = 0; bj < 2; ++bj) { const f32x4 v0 = (acc[ai][bj][m][0] + bv[bj][0]) * sc, v1 = (acc[ai][bj][m][1] + bv[bj][1]) * sc;
                        u32x4 w; w.x = cvtpk(v0[0], v0[1]); w.y = cvtpk(v0[2], v0[3]); w.z = cvtpk(v1[0], v1[1]); w.w = cvtpk(v1[2], v1[3]);
                        *(u32x4*)(rowp + bj * 128) = w; } }
        } else if (wc == 0) {
            const f32x4 b0 = *(const f32x4*)(bias + NMI + 8 * fq), b1 = *(const f32x4*)(bias + NMI + 8 * fq + 4);
#pragma unroll
            for (int ai = 0; ai < 2; ++ai)
#pragma unroll
                for (int m = 0; m < 4; ++m) { float* gp = G + (size_t)(row0 + ai * 128 + m * 16) * 32 + 8 * fq;
                    f32x4 v0 = acc[ai][0][m][0] + b0, v1 = acc[ai][0][m][1] + b1;
                    if (fq & 1) {
#pragma unroll
                        for (int e = 0; e < 4; ++e) { v0[e] = log_sigmoid_f(v0[e]); v1[e] = log_sigmoid_f(v1[e]); } }
                    *(f32x4*)gp = v0; *(f32x4*)(gp + 4) = v1; }
        }
    }
};

__device__ __forceinline__ void phase_rope(bf16_t* Z, const float* rc, const float* rs, int lane, int wave) {
    const int gw = blockIdx.x * NWAVES + wave, NGW = gridDim.x * NWAVES;
    for (int r = gw; r < MX; r += NGW) {
        const int t = r & (SEQ - 1);
        const float c = rc[t * 64 + lane], s = rs[t * 64 + lane];
        bf16_t* zr = Z + (size_t)r * NQKV;
#pragma unroll 4
        for (int hd = 0; hd < 20; ++hd) {
            const float x0 = bf2f(zr[hd * 128 + lane]), x1 = bf2f(zr[hd * 128 + 64 + lane]);
            const float y0 = x0 * c - x1 * s, y1 = x1 * c + x0 * s;
            zr[hd * 128 + lane] = (bf16_t)(cvtpk(y0, y0) & 0xffffu); zr[hd * 128 + 64 + lane] = (bf16_t)(cvtpk(y1, y1) & 0xffffu);
        }
    }
}

namespace att {
constexpr int D = 128, KVBLK = 64, LDQ = NQKV;
constexpr float SCALE = 0.088388347648318440f;
constexpr float THR = 8.f;
#ifndef ATT_SDEPTH
#define ATT_SDEPTH 1
#endif
constexpr int SDEPTH = ATT_SDEPTH;
constexpr size_t SHM_V = KVBLK * D * 2, SHM_K = KVBLK * D * 2, SHM_ATTN = 2 * SHM_V + 2 * SHM_K + NWAVES * 64 * 4;
#define KSWZ(row, colB) ((row) * 256 + ((colB) ^ (((row) & 7) << 4)))
#define SBAR() __builtin_amdgcn_sched_barrier(0)
__device__ __forceinline__ int crow(int r, int hi) { return (r & 3) + 8 * (r >> 2) + 4 * hi; }
__device__ __forceinline__ void partialSM(f32x16& p0, f32x16& p1, float& m_reg, float& mn, float& alpha, bool masked, int dpos, int hi) {
  constexpr float C = SCALE * 1.4426950408889634f;
  if (masked) {
#pragma unroll
    for (int r = 0; r < 16; ++r) { const int d0 = dpos + crow(r, hi), d1 = d0 + 32;
      if (d0 > 128 || d0 < -128) p0[r] = -1e30f;
      if (d1 > 128 || d1 < -128) p1[r] = -1e30f; }
  }
  float pmax = p0[0];
#pragma unroll
  for (int r = 1; r < 16; ++r) pmax = fmaxf(pmax, p0[r]);
#pragma unroll
  for (int r = 0; r < 16; ++r) pmax = fmaxf(pmax, p1[r]);
  { auto rr = __builtin_amdgcn_permlane32_swap(__float_as_uint(pmax), __float_as_uint(pmax), false, false);
    pmax = fmaxf(__uint_as_float(rr[0]), __uint_as_float(rr[1])); }
  if (__builtin_expect(__all(pmax - m_reg <= THR / SCALE), 1)) { mn = m_reg; alpha = 1.f; }
  else { mn = fmaxf(m_reg, pmax); alpha = __builtin_amdgcn_exp2f((m_reg - mn) * C); m_reg = mn; }
  const float mnC = -mn * C;
#pragma unroll
  for (int r = 0; r < 16; ++r) p0[r] = fmaf(p0[r], C, mnC);
#pragma unroll
  for (int r = 0; r < 16; ++r) p1[r] = fmaf(p1[r], C, mnC);
#pragma unroll
  for (int r = 0; r < 16; ++r) p0[r] = __builtin_amdgcn_exp2f(p0[r]);
}
__device__ __forceinline__ void finishSM(f32x16& p0, f32x16& p1, float alpha, float& l_reg, bf16x8& pa0, bf16x8& pa1, bf16x8& pa2, bf16x8& pa3) {
#pragma unroll
  for (int r = 0; r < 16; ++r) p1[r] = __builtin_amdgcn_exp2f(p1[r]);
  float ps = 0;
#pragma unroll
  for (int r = 0; r < 16; ++r) ps += p0[r];
#pragma unroll
  for (int r = 0; r < 16; ++r) ps += p1[r];
  { auto rr = __builtin_amdgcn_permlane32_swap(__float_as_uint(ps), __float_as_uint(ps), false, false);
    ps = __uint_as_float(rr[0]) + __uint_as_float(rr[1]); }
  l_reg = l_reg * alpha + ps;
#define PK4(P, BASE, OUT) do { unsigned a0 = cvtpk(P[BASE + 0], P[BASE + 1]), a1 = cvtpk(P[BASE + 2], P[BASE + 3]);   \
    unsigned b0 = cvtpk(P[BASE + 4], P[BASE + 5]), b1 = cvtpk(P[BASE + 6], P[BASE + 7]);                              \
    auto r0 = __builtin_amdgcn_permlane32_swap(a0, b0, false, false); auto r1 = __builtin_amdgcn_permlane32_swap(a1, b1, false, false); \
    u32x4 w = {r0[0], r1[0], r0[1], r1[1]}; OUT = *reinterpret_cast<bf16x8*>(&w); } while (0)
  PK4(p0, 0, pa0); PK4(p0, 8, pa1); PK4(p1, 0, pa2); PK4(p1, 8, pa3);
#undef PK4
}
__device__ __forceinline__ void qkt(f32x16& p0, f32x16& p1, const char* Ks, const bf16x8* qr, int r32, int hi) {
  p0 = f32x16{}; p1 = f32x16{};
#pragma unroll
  for (int d0 = 0; d0 < 8; ++d0) { const int cb = (d0 * 16 + hi * 8) * 2;
    const bf16x8 b0 = *reinterpret_cast<const bf16x8*>(Ks + KSWZ(r32, cb));
    const bf16x8 b1 = *reinterpret_cast<const bf16x8*>(Ks + KSWZ(32 + r32, cb));
    p0 = __builtin_amdgcn_mfma_f32_32x32x16_bf16(b0, qr[d0], p0, 0, 0, 0);
    p1 = __builtin_amdgcn_mfma_f32_32x32x16_bf16(b1, qr[d0], p1, 0, 0, 0); }
}
__device__ __forceinline__ int v_st(int k, int c) { const int kk = (k & ~0xC) | ((k & 4) << 1) | ((k & 8) >> 1); return ((kk >> 3) * 4 + (c >> 5)) * 512 + ((kk & 7) * 32 + (c & 31)) * 2; }
__device__ __forceinline__ int v_rd_base(int lane) { return ((lane & 3) << 3) | (((lane >> 2) & 3) << 6) | (((lane >> 4) & 1) << 5) | (((lane >> 5) & 1) << 8); }
constexpr int v_rd_off(int d0, int ks, int half) { return d0 * 512 + ks * 4096 + half * 2048; }
template <int OFF> __device__ __forceinline__ s16x4 tr_read(int vb) {
  s16x4 r; asm volatile("ds_read_b64_tr_b16 %0, %1 offset:%2" : "=&v"(r) : "v"(vb), "i"(OFF) : "memory"); return r;
}
template <int D0> __device__ __forceinline__ void pv_one(f32x16& od, int vb, bf16x8 pa0, bf16x8 pa1, bf16x8 pa2, bf16x8 pa3) {
  const s16x4 l0 = tr_read<v_rd_off(D0, 0, 0)>(vb), h0 = tr_read<v_rd_off(D0, 0, 1)>(vb), l1 = tr_read<v_rd_off(D0, 1, 0)>(vb), h1 = tr_read<v_rd_off(D0, 1, 1)>(vb);
  const s16x4 l2 = tr_read<v_rd_off(D0, 2, 0)>(vb), h2 = tr_read<v_rd_off(D0, 2, 1)>(vb), l3 = tr_read<v_rd_off(D0, 3, 0)>(vb), h3 = tr_read<v_rd_off(D0, 3, 1)>(vb);
  asm volatile("s_waitcnt lgkmcnt(0)" ::: "memory"); SBAR();
#define PK(L, H) (bf16x8){L[0], L[1], L[2], L[3], H[0], H[1], H[2], H[3]}
  od = __builtin_amdgcn_mfma_f32_32x32x16_bf16(pa0, PK(l0, h0), od, 0, 0, 0);
  od = __builtin_amdgcn_mfma_f32_32x32x16_bf16(pa1, PK(l1, h1), od, 0, 0, 0);
  od = __builtin_amdgcn_mfma_f32_32x32x16_bf16(pa2, PK(l2, h2), od, 0, 0, 0);
  od = __builtin_amdgcn_mfma_f32_32x32x16_bf16(pa3, PK(l3, h3), od, 0, 0, 0);
#undef PK
}
__device__ __forceinline__ void pv_d0(f32x16* o, int vb, bf16x8 pa0, bf16x8 pa1, bf16x8 pa2, bf16x8 pa3) {
  pv_one<0>(o[0], vb, pa0, pa1, pa2, pa3); pv_one<1>(o[1], vb, pa0, pa1, pa2, pa3); pv_one<2>(o[2], vb, pa0, pa1, pa2, pa3); pv_one<3>(o[3], vb, pa0, pa1, pa2, pa3);
}

__device__ __forceinline__ void attn_unit(const bf16_t* __restrict__ Z, bf16_t* __restrict__ O, int qrow0, int head0, int kvh, int ctxrow0, int winrow0, int NT, int dq0, const float* __restrict__ sinkp, char* lds) {
  int tid_l = threadIdx.x; asm volatile("" : "+v"(tid_l));
  const int tid = tid_l, wid = tid >> 6, lane = tid & 63, r32 = lane & 31, hi = lane >> 5;
  char* V_lds = lds; char* K_lds = lds + 2 * SHM_V;
  float* wsl = (float*)(lds + 2 * SHM_V + 2 * SHM_K) + wid * 64; float* li_l = wsl; float* al_l = wsl + 32;
  float m_reg = -1e30f, l_reg = 0; f32x16 o[4] = {}; bf16x8 qr[8];
  const int head = head0 + (wid >> 2), qloc = (wid & 3) * 32 + r32;
  const bf16_t* Qw = Z + (size_t)(qrow0 + qloc) * LDQ + head * D + hi * 8;
#pragma unroll
  for (int d0 = 0; d0 < 8; ++d0) qr[d0] = *reinterpret_cast<const bf16x8*>(Qw + d0 * 16);
  const int sr = tid >> 4, sc = (tid & 15) * 8, vst0 = v_st(sr, sc), vst1 = v_st(32 + sr, sc);
  const int vb0 = (int)(uintptr_t)V_lds + v_rd_base(lane);
  const bf16_t* Kc = Z + 2048 + kvh * D + sc; const bf16_t* Vc = Z + 2560 + kvh * D + sc;
  const int dlane = dq0 - qloc;
  struct { bf16x8 vs0, vs1, ks0, ks1; } sr_[SDEPTH];
#define TROW(jt) ((jt) < 4 ? ctxrow0 + (jt) * 64 : winrow0 + ((jt) - 4) * 64)
#define SLOAD(i, jt) do { const size_t rb0_ = (size_t)(TROW(jt) + sr) * LDQ, rb1_ = rb0_ + (size_t)32 * LDQ; \
    sr_[i].vs0 = *reinterpret_cast<const bf16x8*>(Vc + rb0_); sr_[i].vs1 = *reinterpret_cast<const bf16x8*>(Vc + rb1_); \
    sr_[i].ks0 = *reinterpret_cast<const bf16x8*>(Kc + rb0_); sr_[i].ks1 = *reinterpret_cast<const bf16x8*>(Kc + rb1_); } while (0)
#define SWRITE(b, i) do { *(bf16x8*)(V_lds + (b) * SHM_V + vst0) = sr_[i].vs0;          \
    *(bf16x8*)(V_lds + (b) * SHM_V + vst1) = sr_[i].vs1; const int kc_ = sc * 2;               \
    *(bf16x8*)(K_lds + (b) * SHM_K + KSWZ(sr, kc_)) = sr_[i].ks0;                       \
    *(bf16x8*)(K_lds + (b) * SHM_K + KSWZ(32 + sr, kc_)) = sr_[i].ks1; } while (0)
#define SWAIT() do { if constexpr (SDEPTH == 2) asm volatile("s_waitcnt vmcnt(4)" ::: "memory"); else asm volatile("s_waitcnt vmcnt(0)" ::: "memory"); } while (0)
#define RESC(a) do { if (__any((a) < 1.f)) { if (hi == 0) al_l[r32] = (a); asm volatile("s_waitcnt lgkmcnt(0)" ::: "memory"); \
    _Pragma("unroll") for (int d = 0; d < 4; ++d) _Pragma("unroll") for (int r = 0; r < 16; ++r) o[d][r] *= al_l[crow(r, hi)]; } } while (0)
#define MSK(jt) ((jt) >= 4), (dlane + ((jt) - 4) * 64)
  f32x16 pA0, pA1, pB0, pB1; float mnA, mnB, alA, alB; bf16x8 pa0, pa1, pa2, pa3;
  constexpr int SE = 0, SO = SDEPTH - 1;
  SLOAD(SE, 0); asm volatile("s_waitcnt vmcnt(0)" ::: "memory"); SWRITE(0, SE); __syncthreads();
  qkt(pA0, pA1, K_lds, qr, r32, hi); partialSM(pA0, pA1, m_reg, mnA, alA, MSK(0), hi);
  SLOAD(SO, 1); if constexpr (SDEPTH == 2) { if (2 < NT) SLOAD(SE, 2); }
  SWAIT(); SWRITE(1, SO); __syncthreads();
  for (int j = 1; j + 1 < NT; j += 2) {
    SBAR(); qkt(pB0, pB1, K_lds + SHM_K, qr, r32, hi);
    finishSM(pA0, pA1, alA, l_reg, pa0, pa1, pa2, pa3); SBAR();
    SLOAD(SO, j + SDEPTH); SBAR();
    pv_d0(o, vb0, pa0, pa1, pa2, pa3); partialSM(pB0, pB1, m_reg, mnB, alB, MSK(j), hi);
    __syncthreads(); SWAIT(); SWRITE(0, SE);
    RESC(alB); __syncthreads();
    SBAR(); qkt(pA0, pA1, K_lds, qr, r32, hi);
    finishSM(pB0, pB1, alB, l_reg, pa0, pa1, pa2, pa3); SBAR();
    if (SDEPTH == 1 || j + 3 < NT) SLOAD(SE, j + 1 + SDEPTH);
    SBAR();
    pv_d0(o, vb0 + (int)SHM_V, pa0, pa1, pa2, pa3); partialSM(pA0, pA1, m_reg, mnA, alA, MSK(j + 1), hi);
    __syncthreads(); SWAIT(); SWRITE(1, SO);
    RESC(alA); __syncthreads();
  }
  SBAR(); qkt(pB0, pB1, K_lds + SHM_K, qr, r32, hi);
  finishSM(pA0, pA1, alA, l_reg, pa0, pa1, pa2, pa3); SBAR();
  pv_d0(o, vb0, pa0, pa1, pa2, pa3); partialSM(pB0, pB1, m_reg, mnB, alB, MSK(NT - 1), hi);
  __syncthreads(); RESC(alB);
  finishSM(pB0, pB1, alB, l_reg, pa0, pa1, pa2, pa3); SBAR();
  pv_d0(o, vb0 + (int)SHM_V, pa0, pa1, pa2, pa3);
  { constexpr float C = SCALE * 1.4426950408889634f; l_reg += __builtin_amdgcn_exp2f(sinkp[wid >> 2] * 1.4426950408889634f - m_reg * C); }
  if (hi == 0) li_l[r32] = l_reg; asm volatile("s_waitcnt lgkmcnt(0)" ::: "memory");
  float rli[16];
#pragma unroll
  for (int r = 0; r < 16; ++r) rli[r] = 1.0f / li_l[crow(r, hi)];
  bf16_t* Ow = O + (size_t)(qrow0 + (wid & 3) * 32) * DM + head * D;
#pragma unroll
  for (int r = 0; r < 16; ++r) { const int orow = crow(r, hi);
#pragma unroll
    for (int d0 = 0; d0 < 4; ++d0) { const float v = o[d0][r] * rli[r]; Ow[(size_t)orow * DM + d0 * 32 + r32] = (bf16_t)(cvtpk(v, v) & 0xffffu); } }
#undef TROW
#undef SLOAD
#undef SWRITE
#undef SWAIT
#undef RESC
#undef MSK
}
}

__device__ __forceinline__ void phase_attn(const bf16_t* Z, bf16_t* O, const float* sink, char* lds) {
    constexpr int NU_X = 2048, NU = NU_X + 128;
    for (int u = blockIdx.x; u < NU; u += gridDim.x) {
        if (u < NU_X) {
            const int hp = u & 1, qb = (u >> 1) & 31, kvh = (u >> 6) & 3, b = u >> 8;
            const int lo = qb > 0 ? (qb - 1) * 128 : 0, hi = qb < 31 ? (qb + 2) * 128 : SEQ;
            att::attn_unit(Z, O, b * SEQ + qb * 128, kvh * 4 + hp * 2, kvh, MX + b * CTXL, b * SEQ + lo, 4 + (hi - lo) / 64, lo - qb * 128, sink + kvh * 4 + hp * 2, lds);
        } else {
            const int v = u - NU_X; const int hp = v & 1, cqb = (v >> 1) & 1, kvh = (v >> 2) & 3, b = v >> 4;
            att::attn_unit(Z, O, MX + b * CTXL + cqb * 128, kvh * 4 + hp * 2, kvh, MX + b * CTXL, 0, 4, 0, sink + kvh * 4 + hp * 2, lds);
        }
        __syncthreads();
    }
}

__device__ __forceinline__ int scan_row(int b, int dir, int s) {
    if (dir == 0) return s < CTXL ? MX + b * CTXL + s : b * SEQ + (s - CTXL);
    return s < CTXL ? MX + b * CTXL + (CTXL - 1 - s) : b * SEQ + (SEQ - 1 - (s - CTXL));
}
__device__ __forceinline__ void phase_scan(const bf16_t* Z, const float* GATE, bf16_t* HF, bf16_t* HB, bool need_ctx_out, LAS unsigned char* lds, int tid, int lane, int wave) {
    constexpr int TB = 16, NSTEP = CTXL + SEQ;
    LAS float* sq = (LAS float*)lds;
    LAS float* spart = sq + TB * 512;
    LAS float* sg = spart + TB * 512;
    LAS float* sm = sg + TB * 2;
    LAS float* sden = sm + TB;
    const int v = tid & 255, dh = tid >> 8;
    for (int task = blockIdx.x; task < 128; task += gridDim.x) {
        const int dir = task & 1, hd = (task >> 1) & 7, b = task >> 4;
        float C[64];
#pragma unroll
        for (int d = 0; d < 64; ++d) C[d] = 0.f;
        float nst = 0.f, m = 0.f;
        bf16_t* HO = dir == 0 ? HF : HB;
        for (int s0 = 0; s0 < NSTEP; s0 += TB) {
            __syncthreads();
            { const int st = tid >> 5, e0 = (tid & 31) * 16; const int row = scan_row(b, dir, s0 + st);
              const int col = e0 < 128 ? hd * 128 + e0 : (e0 < 256 ? 1024 + hd * 128 + (e0 - 128) : 2048 + hd * 256 + (e0 - 256));
              const u32x4 w0 = *(const u32x4*)(Z + (size_t)row * NMI + col), w1 = *(const u32x4*)(Z + (size_t)row * NMI + col + 8);
              LAS float* dst = sq + st * 512 + e0;
              *(LAS f32x4*)(dst + 0) = (f32x4){bflo(w0.x), bfhi(w0.x), bflo(w0.y), bfhi(w0.y)};
              *(LAS f32x4*)(dst + 4) = (f32x4){bflo(w0.z), bfhi(w0.z), bflo(w0.w), bfhi(w0.w)};
              *(LAS f32x4*)(dst + 8) = (f32x4){bflo(w1.x), bfhi(w1.x), bflo(w1.y), bfhi(w1.y)};
              *(LAS f32x4*)(dst + 12) = (f32x4){bflo(w1.z), bfhi(w1.z), bflo(w1.w), bfhi(w1.w)};
              if (tid < 2 * TB) { const int st2 = tid >> 1, which = tid & 1; const int row2 = scan_row(b, dir, s0 + st2);
                  sg[tid] = GATE[(size_t)row2 * 32 + (dir * 2 + which) * 8 + hd]; } }
            __syncthreads();
            for (int st = 0; st < TB; ++st) {
                const float ig = sg[st * 2], lf = sg[st * 2 + 1];
                const float mn = fmaxf(lf + m, ig), fw = expf(lf + m - mn), iw = expf(ig - mn); m = mn;
                const LAS float* qs = sq + st * 512 + 64 * dh; const LAS float* ks = qs + 128;
                const float kv = iw * sq[st * 512 + 256 + v];
                float acc = 0.f;
#pragma unroll
                for (int d4 = 0; d4 < 16; ++d4) { const f32x4 kk = *(const LAS f32x4*)(ks + 4 * d4), qq = *(const LAS f32x4*)(qs + 4 * d4);
#pragma unroll
                    for (int e = 0; e < 4; ++e) { C[4 * d4 + e] = fmaf(fw, C[4 * d4 + e], kk[e] * kv); acc = fmaf(C[4 * d4 + e], qq[e], acc); } }
                spart[(st * 2 + dh) * 256 + v] = acc;
                if (tid < 128) { nst = fmaf(fw, nst, iw * sq[st * 512 + 128 + tid]); float dp = nst * sq[st * 512 + tid]; dp = wave_sum(dp); if (lane == 0) sden[st * 2 + wave] = dp; }
                if (tid == 0) sm[st] = mn;
            }
            __syncthreads();
            { const int st = tid >> 5, c0 = (tid & 31) * 8; const int row = scan_row(b, dir, s0 + st);
              if (need_ctx_out || row < MX) {
                  const float den = sden[st * 2] + sden[st * 2 + 1];
                  const float rd = 1.0f / fmaxf(fabsf(den), expf(-sm[st]));
                  const LAS float* p0 = spart + (st * 2) * 256 + c0; const LAS float* p1 = p0 + 256;
                  const f32x4 a0 = *(const LAS f32x4*)p0, a1 = *(const LAS f32x4*)(p0 + 4), b0 = *(const LAS f32x4*)p1, b1 = *(const LAS f32x4*)(p1 + 4);
                  u32x4 w; w.x = cvtpk((a0[0] + b0[0]) * rd, (a0[1] + b0[1]) * rd); w.y = cvtpk((a0[2] + b0[2]) * rd, (a0[3] + b0[3]) * rd);
                  w.z = cvtpk((a1[0] + b1[0]) * rd, (a1[1] + b1[1]) * rd); w.w = cvtpk((a1[2] + b1[2]) * rd, (a1[3] + b1[3]) * rd);
                  *(u32x4*)(HO + (size_t)row * DM + hd * 256 + c0) = w; } }
        }
        __syncthreads();
    }
}
__device__ __forceinline__ void phase_mfinish(const bf16_t* Z, const bf16_t* HF, const bf16_t* HB, const float* ghead, bf16_t* H, int row_end, int lane, int wave) {
    const int gw = blockIdx.x * NWAVES + wave, NGW = gridDim.x * NWAVES;
    for (int r = gw; r < row_end; r += NGW) {
#pragma unroll 2
        for (int hd = 0; hd < 8; ++hd) { const int col = hd * 256 + lane * 4;
            const u32x2 f = *(const u32x2*)(HF + (size_t)r * DM + col), bb = *(const u32x2*)(HB + (size_t)r * DM + col), oo = *(const u32x2*)(Z + (size_t)r * NMI + 4096 + col);
            const f32x4 gh = *(const f32x4*)(ghead + col);
            float s[4] = {bflo(f.x) + bflo(bb.x), bfhi(f.x) + bfhi(bb.x), bflo(f.y) + bflo(bb.y), bfhi(f.y) + bfhi(bb.y)};
            float ss = (s[0] * s[0] + s[1] * s[1]) + (s[2] * s[2] + s[3] * s[3]); ss = wave_sum(ss);
            const float rs = 1.0f / sqrtf(ss * (1.0f / 256.0f) + RMS_EPS);
            const float ov[4] = {bflo(oo.x), bfhi(oo.x), bflo(oo.y), bfhi(oo.y)};
            float y[4];
#pragma unroll
            for (int e = 0; e < 4; ++e) y[e] = sigmoid_f(ov[e]) * (s[e] * rs) * gh[e];
            u32x2 w; w.x = cvtpk(y[0], y[1]); w.y = cvtpk(y[2], y[3]);
            *(u32x2*)(H + (size_t)r * DM + col) = w; }
    }
}

__device__ __forceinline__ void phase_conv(const bf16_t* U, bf16_t* G, const float* cw, const float* cb, int row0, int row1, int tid) {
    const size_t total = (size_t)(row1 - row0) * (DFF / 8);
    for (size_t e = (size_t)blockIdx.x * NTHREADS + tid; e < total; e += (size_t)gridDim.x * NTHREADS) {
        const int lr = (int)(e / (DFF / 8)), j = (int)(e % (DFF / 8)) * 8; const int r = row0 + lr;
        const int t = r < MX ? (r & (SEQ - 1)) : ((r - MX) & (CTXL - 1)); const int T = r < MX ? SEQ : CTXL;
        float av[8], bv[8];
#pragma unroll
        for (int q = 0; q < 2; ++q) { const f32x4 ca = *(const f32x4*)(cb + j + 4 * q), cbv = *(const f32x4*)(cb + DFF + j + 4 * q);
#pragma unroll
            for (int c = 0; c < 4; ++c) { av[4 * q + c] = ca[c]; bv[4 * q + c] = cbv[c]; } }
#pragma unroll
        for (int w = 0; w < 3; ++w) { const int tt = t + w - 1; if (tt < 0 || tt >= T) continue;
            const bf16_t* up = U + (size_t)(lr + w - 1) * NUP + j;
            const u32x4 ua = *(const u32x4*)up, ub = *(const u32x4*)(up + DFF);
            const float* wa = cw + (size_t)w * NUP + j; const float* wb = wa + DFF;
            const f32x4 wa0 = *(const f32x4*)wa, wa1 = *(const f32x4*)(wa + 4), wb0 = *(const f32x4*)wb, wb1 = *(const f32x4*)(wb + 4);
            const float ua_f[8] = {bflo(ua.x), bfhi(ua.x), bflo(ua.y), bfhi(ua.y), bflo(ua.z), bfhi(ua.z), bflo(ua.w), bfhi(ua.w)};
            const float ub_f[8] = {bflo(ub.x), bfhi(ub.x), bflo(ub.y), bfhi(ub.y), bflo(ub.z), bfhi(ub.z), bflo(ub.w), bfhi(ub.w)};
#pragma unroll
            for (int c = 0; c < 4; ++c) { av[c] = fmaf(ua_f[c], wa0[c], av[c]); av[4 + c] = fmaf(ua_f[4 + c], wa1[c], av[4 + c]); bv[c] = fmaf(ub_f[c], wb0[c], bv[c]); bv[4 + c] = fmaf(ub_f[4 + c], wb1[c], bv[4 + c]); } }
        float g[8];
#pragma unroll
        for (int c = 0; c < 8; ++c) g[c] = silu_f(av[c]) * bv[c];
        u32x4 o; o.x = cvtpk(g[0], g[1]); o.y = cvtpk(g[2], g[3]); o.z = cvtpk(g[4], g[5]); o.w = cvtpk(g[6], g[7]);
        *(u32x4*)(G + (size_t)lr * DFF + j) = o;
    }
}

constexpr int N_PHASES = 50;
#ifndef EN_PRO
#define EN_PRO 1
#endif
#ifndef EN_NORM
#define EN_NORM 1
#endif
#ifndef EN_ROPE
#define EN_ROPE 1
#endif
#ifndef EN_ATTN
#define EN_ATTN 1
#endif
#ifndef EN_SCAN
#define EN_SCAN 1
#endif
#ifndef EN_MFIN
#define EN_MFIN 1
#endif
#ifndef EN_CONV
#define EN_CONV 1
#endif
#ifndef EN_FINAL
#define EN_FINAL 1
#endif
#ifndef EN_G1
#define EN_G1 1
#endif
#ifndef EN_G2
#define EN_G2 1
#endif
#ifndef EN_G3
#define EN_G3 1
#endif
#ifndef EN_G4
#define EN_G4 1
#endif
#ifndef EN_G5
#define EN_G5 1
#endif
#ifndef EN_G6
#define EN_G6 1
#endif
__global__ void __launch_bounds__(NTHREADS, 2) fwd(Args a) {
    extern __shared__ __attribute__((aligned(16))) unsigned char lds_raw[];
    LAS unsigned char* lds = (LAS unsigned char*)lds_raw;
    volatile LAS unsigned* MISC = (volatile LAS unsigned*)(lds + MISC_OFF);
    if (threadIdx.x < 32) MISC[threadIdx.x] = 0u;
    __syncthreads();
    unsigned* ctl = (unsigned*)(a.ws + WS_CTL);
    XcdBarrier bar = xcd_barrier_post(ctl + CW_BAR + a.li * XCD_BAR_WORDS, MISC + 8);
    const int G = gridDim.x, bx = blockIdx.x;
    const int lo = a.ph_lo, hi = a.ph_hi;
#define IN(k) (lo <= (k) && (k) < hi)
#define TL int tid = threadIdx.x; asm volatile("" : "+v"(tid)); const int lane = tid & 63, wave = __builtin_amdgcn_readfirstlane(tid >> 6); (void)lane; (void)wave;
#define SEAM(k) do { if (IN(k) && IN((k) + 1)) xcd_barrier(bar); } while (0)
    unsigned char* ws = a.ws;
    float* X = (float*)(ws + WS_X); bf16_t* H = (bf16_t*)(ws + WS_H); bf16_t* Z = (bf16_t*)(ws + WS_Z);
    float* GATE = (float*)(ws + WS_GATE); bf16_t* HF = (bf16_t*)(ws + WS_HF); bf16_t* HB = (bf16_t*)(ws + WS_HB);
    const float* mod = (const float*)(ws + WS_MOD);

    if (EN_PRO && IN(0)) { TL phase_prologue(a, lds, tid, lane, wave); }
    SEAM(0);

    for (int i = 0; i < 4; ++i) {
        const int P = 1 + 12 * i, j = i >> 1; const bool last = (i == 3);
        const float* modl = mod + (size_t)i * 9 * MODW;
        const float* xin = (i == 0) ? a.in[I_X] : X;
        const float* cin = (i == 0) ? a.in[I_CTX] - (size_t)MX * DM : X;
        const int pm_hi_mix = last ? MX / 256 : MT / 256;
        if (EN_NORM && IN(P + 0)) { TL phase_norm(xin, cin, a.in[I_GMIX] + (size_t)i * DM, modl, 0, DM, H, MT, lane, wave); }
        SEAM(P + 0);
        if ((i & 1) == 0) {
            if (EN_G1 && IN(P + 1)) { pg8::Gemm g{H, (const bf16_t*)(ws + WS_WQKV) + (size_t)j * NQKV * DM, MT, NQKV, DM}; RangeOrder S; S.init(0, MT / 256, NQKV, G, bx);
                EpiBf E{Z, NQKV}; pg8::gemm_phase<EpiBf, RangeOrder>(lds, g, S, E, nullptr); }
            SEAM(P + 1);
            if (EN_ROPE && IN(P + 2)) { TL phase_rope(Z, (const float*)(ws + WS_ROPE), (const float*)(ws + WS_ROPE + 1 * MiB), lane, wave); }
            SEAM(P + 2);
            if (EN_ATTN && IN(P + 3)) phase_attn(Z, H, a.in[I_SINK] + (size_t)j * 16, (char*)lds_raw);
            SEAM(P + 3);
            if (EN_G2 && IN(P + 4)) { pg8::Gemm g{H, (const bf16_t*)(ws + WS_WAO) + (size_t)j * DM * DM, MT, DM, DM}; RangeOrder S; S.init(0, pm_hi_mix, DM, G, bx);
                EpiRes E{xin, cin, X, modl + 2 * DM}; pg8::gemm_phase<EpiRes, RangeOrder>(lds, g, S, E, nullptr); }
            SEAM(P + 4);
        } else {
            if (EN_G3 && IN(P + 1)) { pg8::Gemm g{H, (const bf16_t*)(ws + WS_WMI) + (size_t)j * NMI_PAD * DM, MT, NMI_PAD, DM}; RangeOrder S; S.init(0, MT / 256, NMI_PAD, G, bx);
                EpiMI E{Z, GATE, a.in[I_BMI] + (size_t)j * NMI_RAW}; pg8::gemm_phase<EpiMI, RangeOrder>(lds, g, S, E, nullptr); }
            SEAM(P + 1);
            if (EN_SCAN && IN(P + 2)) { TL phase_scan(Z, GATE, HF, HB, !last, lds, tid, lane, wave); }
            SEAM(P + 2);
            if (EN_MFIN && IN(P + 3)) { TL phase_mfinish(Z, HF, HB, a.in[I_GHEAD] + (size_t)j * DM, H, last ? MX : MT, lane, wave); }
            SEAM(P + 3);
            if (EN_G4 && IN(P + 4)) { pg8::Gemm g{H, (const bf16_t*)(ws + WS_WMO) + (size_t)j * DM * DM, MT, DM, DM}; RangeOrder S; S.init(0, pm_hi_mix, DM, G, bx);
                EpiRes E{xin, cin, X, modl + 2 * DM}; pg8::gemm_phase<EpiRes, RangeOrder>(lds, g, S, E, nullptr); }
            SEAM(P + 4);
        }
        if (EN_NORM && IN(P + 5)) { TL phase_norm(X, X, a.in[I_GFFN] + (size_t)i * DM, modl, 3 * DM, 4 * DM, H, last ? MX : MT, lane, wave); }
        SEAM(P + 5);
        for (int hf = 0; hf < 2; ++hf) {
            const int Q = P + 6 + 3 * hf;
            const int pm_lo = hf == 0 ? 0 : 64, pm_hi = hf == 0 ? 64 : (last ? 128 : 136);
            bf16_t* U = (bf16_t*)(ws + WS_Z); bf16_t* Gb = (bf16_t*)(ws + WS_HF);
            if (EN_G5 && IN(Q + 0)) { pg8::Gemm g{H, (const bf16_t*)(ws + WS_WUP) + (size_t)i * NUP * DM, MT, NUP, DM}; RangeOrder S; S.init(pm_lo, pm_hi, NUP, G, bx);
                EpiBf E{U - (size_t)pm_lo * 256 * NUP, NUP}; pg8::gemm_phase<EpiBf, RangeOrder>(lds, g, S, E, nullptr); }
            SEAM(Q + 0);
            if (EN_CONV && IN(Q + 1)) { TL phase_conv(U, Gb, a.in[I_CONVW] + (size_t)i * 3 * NUP, a.in[I_CONVB] + (size_t)i * NUP, pm_lo * 256, pm_hi * 256, tid); }
            SEAM(Q + 1);
            if (EN_G6 && IN(Q + 2)) { pg8::Gemm g{Gb - (size_t)pm_lo * 256 * DFF, (const bf16_t*)(ws + WS_WDN) + (size_t)i * DM * DFF, MT, DM, DFF}; RangeOrder S; S.init(pm_lo, pm_hi, DM, G, bx);
                EpiRes E{X, X, X, modl + 5 * DM}; pg8::gemm_phase<EpiRes, RangeOrder>(lds, g, S, E, nullptr); }
            SEAM(Q + 2);
        }
    }
    if (EN_FINAL && IN(49)) { TL phase_final(X, a.in[I_GFINAL], a.out, lane, wave); }
#undef IN
#undef SEAM
}

#ifndef MK_N_LAUNCHES
#define MK_N_LAUNCHES 50
#endif
extern "C" void kernel_launch(void* const* d_in, const int* in_sizes, int n_in, void* d_out, int out_size, void* d_ws, size_t ws_size, hipStream_t stream) {
    static int grid = 0;
    if (grid == 0) {
        if (n_in != 20 || in_sizes[0] != MX * DM || out_size != MX * DM || ws_size < WS_END) {
            fprintf(stderr, "kernel_launch: shape mismatch (n_in %d, in0 %d, out %d, ws %zu, need ws >= %zu); nothing launched\n", n_in, n_in > 0 ? in_sizes[0] : -1, out_size, ws_size, (size_t)WS_END); grid = -1; return; }
        int dev = 0, cus = 0, per_cu = 0;
        if (hipGetDevice(&dev) != hipSuccess || hipDeviceGetAttribute(&cus, hipDeviceAttributeMultiprocessorCount, dev) != hipSuccess) { fprintf(stderr, "kernel_launch: device query failed\n"); grid = -1; return; }
        if (hipFuncSetAttribute((const void*)fwd, hipFuncAttributeMaxDynamicSharedMemorySize, LDS_BYTES) != hipSuccess) { fprintf(stderr, "kernel_launch: hipFuncSetAttribute failed\n"); grid = -1; return; }
        if (hipOccupancyMaxActiveBlocksPerMultiprocessor(&per_cu, (const void*)fwd, NTHREADS, LDS_BYTES) != hipSuccess || per_cu < 1) {
            fprintf(stderr, "kernel_launch: occupancy query reports %d workgroups per CU; nothing launched\n", per_cu); (void)hipGetLastError(); grid = -1; return; }
        grid = cus;
    }
    if (grid < 0) return;
    if (hipMemsetAsync((char*)d_ws + WS_CTL, 0, CTL_ZERO_BYTES, stream) != hipSuccess) { fprintf(stderr, "kernel_launch: memset failed\n"); return; }
    Args a{};
    for (int i = 0; i < 20; ++i) a.in[i] = (const float*)d_in[i];
    a.out = (float*)d_out; a.ws = (unsigned char*)d_ws; a.pad = 0;
    constexpr int NL = MK_N_LAUNCHES;
    for (int li = 0; li < NL; ++li) {
        a.ph_lo = (int)((long)li * N_PHASES / NL); a.ph_hi = (int)((long)(li + 1) * N_PHASES / NL); a.li = li;
        hipLaunchKernelGGL(fwd, dim3(grid), dim3(NTHREADS), LDS_BYTES, stream, a);
        const hipError_t le = hipPeekAtLastError();
        if (le != hipSuccess) { fprintf(stderr, "kernel_launch: launch %d failed: %s\n", li, hipGetErrorName(le)); break; }
    }
}
```

```cpp
#include <hip/hip_runtime.h>
namespace pg8 {
#define PG8_LAS __attribute__((address_space(3)))
typedef unsigned short bf16_t;
typedef short bf16x8 __attribute__((ext_vector_type(8)));
typedef float f32x4 __attribute__((ext_vector_type(4)));
typedef unsigned u32x4 __attribute__((ext_vector_type(4)));
constexpr int BM = 256, BK = 64, HALF = 128, HTB = HALF * BK * 2  , STAGE_BYTES = 8 * HTB, NXCD = 8, WGM = 4;

__host__ __device__ __forceinline__ int lds_byte(int r, int c) { const int st = (r >> 4) * 2 + (c >> 5), rr = r & 15, cc = c & 31, ob = rr * 64 + cc * 2; return st * 1024 + (ob ^ (((ob >> 9) & 1) << 5)); }
__host__ __device__ __forceinline__ void stage_rc(int b, int& R, int& C) { const int st = b / 1024, sb = b % 1024, swz = sb ^ (((sb >> 9) & 1) << 5); R = (st >> 1) * 16 + swz / 64; C = (st & 1) * 32 + (swz % 64) / 2; }
__host__ __device__ __forceinline__ int perm32(int rho) { const int n = rho >> 4, i = rho & 15; return 8 * (i >> 2) + 4 * n + (i & 3); }

struct Unit { int pm, pn, k0; };
struct Gemm { const bf16_t* A; const bf16_t* Bt; int M, N, K, ld; };

struct StaticOrder {
    int nM, nN, nwg, G, c;
    __host__ __device__ void init(int M, int N, int G_, int c_) { nM = M / BM; nN = N / BM; nwg = nM * nN; G = G_; c = c_; }
    __host__ __device__ bool next(int i, Unit& u) const {
        const long L = (long)i * G + c; if (L >= nwg) return false;
        int wgid = (int)L; { const int q = nwg / NXCD, r = nwg % NXCD, xcd = wgid % NXCD, off = wgid / NXCD; wgid = (xcd < r ? xcd * (q + 1) : r * (q + 1) + (xcd - r) * q) + off; }
        const int nig = WGM * nN, gid = wgid / nig, fm = gid * WGM, gsz = (nM - fm) < WGM ? (nM - fm) : WGM;
        u.pm = fm + ((wgid % nig) % gsz); u.pn = (wgid % nig) / gsz; u.k0 = 0; return true;
    }
    __device__ __forceinline__ void a_ready(const Unit&) const {}
    __device__ __forceinline__ void done(const Unit&) const {}
};
struct CountedOrder : StaticOrder {
    const unsigned* ready; unsigned need; unsigned* tmo;
    __device__ __forceinline__ void a_ready(const Unit& u) const {
        if (threadIdx.x < 64) {
            const unsigned long long t0 = __builtin_amdgcn_s_memrealtime(); unsigned polls = 0;
            while ((unsigned)__builtin_amdgcn_readfirstlane(__hip_atomic_load(ready + 64 * u.pm, __ATOMIC_RELAXED, __HIP_MEMORY_SCOPE_AGENT)) < need) {
                if ((++polls & 255u) == 0u && __builtin_amdgcn_readfirstlane(__hip_atomic_load(tmo, __ATOMIC_RELAXED, __HIP_MEMORY_SCOPE_AGENT)) != 0u) break;
                if (__builtin_amdgcn_s_memrealtime() - t0 > 2000000ull) {
                    if (threadIdx.x == 0) { unsigned expect = 0u; __hip_atomic_compare_exchange_strong(tmo + 1, &expect, 0x600u | (unsigned)(u.pm & 0xff), __ATOMIC_RELAXED, __ATOMIC_RELAXED, __HIP_MEMORY_SCOPE_AGENT); __hip_atomic_store(tmo, 1u, __ATOMIC_RELAXED, __HIP_MEMORY_SCOPE_AGENT); }
                    break; }
                __builtin_amdgcn_s_sleep(2); }
            __builtin_amdgcn_fence(__ATOMIC_ACQUIRE, "agent");
            asm volatile("s_waitcnt vmcnt(0)" ::: "memory");
        }
#if !defined(BROKEN_HOOK_NO_BARRIER)
        asm volatile("" ::: "memory"); __builtin_amdgcn_s_barrier(); asm volatile("" ::: "memory");
#endif
    }
};

template <class Epi, class Sched, bool STAMP = false>
__device__ __forceinline__ void gemm_phase(PG8_LAS unsigned char* lds, const Gemm g, const Sched& S, const Epi& E, unsigned long long* stamps) {
    int tid_l = threadIdx.x; asm volatile("" : "+v"(tid_l));
    const int tid = tid_l, wid = __builtin_amdgcn_readfirstlane(tid >> 6), lane = tid & 63, wr = wid >> 2, wc = wid & 3, fr = lane & 15, fq = lane >> 4;
    const int K = g.ld, nt = g.K / BK;
    int ts_lo = 0, ts_hi = 0, nts = 0; const unsigned long long rt_entry = STAMP ? (unsigned long long)wall_clock64() : 0ull;
#define PG8_STAMP() do { if (STAMP && wid == 0 && nts < 64) { const unsigned long long _c = (unsigned long long)clock64(); \
        ts_lo = (lane == nts) ? (int)(unsigned)_c : ts_lo; ts_hi = (lane == nts) ? (int)(unsigned)(_c >> 32) : ts_hi; ++nts; } } while (0)
    PG8_STAMP();
    unsigned voffA[2], voffB[2];
#pragma unroll
    for (int i = 0; i < 2; ++i) { int R, C; stage_rc(tid * 16 + i * 8192, R, C); const int Rb = Epi::PERM ? ((R & ~31) + perm32(R & 31)) : R;
        voffA[i] = (unsigned)(R * K + C) * 2u; voffB[i] = (unsigned)(Rb * K + C) * 2u; }
    const size_t kstep = (size_t)(BK * 2);
    const size_t hstep = (size_t)HALF * K * 2;
    const size_t tstep = 2 * hstep;
    const unsigned ldsw = (unsigned)wid * 1024u;
    const int aoff = lds_byte(wr * 64 + fr, fq * 8), boff = lds_byte(wc * 32 + fr, fq * 8);
#define PG8_SA(b, h) (((b) * 2 + (h)) * HTB)
#define PG8_SB(b, h) ((4 + (b) * 2 + (h)) * HTB)
#define PG8_STAGE(bufoff, gbase, voff) do { _Pragma("unroll") for (int _i = 0; _i < 2; ++_i) \
        __builtin_amdgcn_global_load_lds((const unsigned*)((const char*)(gbase) + (voff)[_i]), (PG8_LAS unsigned*)(lds + (bufoff) + ldsw + _i * 8192), 16, 0, 0); } while (0)
#define PG8_LDA(dst, b, h) do { _Pragma("unroll") for (int m = 0; m < 4; ++m) _Pragma("unroll") for (int k = 0; k < 2; ++k) dst[m][k] = *(const PG8_LAS bf16x8*)(lds + PG8_SA(b, h) + aoff + m * 2048 + k * 1024); } while (0)
#define PG8_LDB(dst, b, h) do { _Pragma("unroll") for (int n = 0; n < 2; ++n) _Pragma("unroll") for (int k = 0; k < 2; ++k) dst[n][k] = *(const PG8_LAS bf16x8*)(lds + PG8_SB(b, h) + boff + n * 2048 + k * 1024); } while (0)
#define PG8_MMA(ai, bj, At, Bt) do { __builtin_amdgcn_s_setprio(1); _Pragma("unroll") for (int m = 0; m < 4; ++m) _Pragma("unroll") for (int n = 0; n < 2; ++n) _Pragma("unroll") for (int k = 0; k < 2; ++k) \
        acc[ai][bj][m][n] = __builtin_amdgcn_mfma_f32_16x16x32_bf16(Bt[n][k], At[m][k], acc[ai][bj][m][n], 0, 0, 0); __builtin_amdgcn_s_setprio(0); } while (0)
#define PG8_WAIT_V(n) asm volatile("s_waitcnt vmcnt(" #n ")" ::: "memory")
#define PG8_WAIT_L(n) asm volatile("s_waitcnt lgkmcnt(" #n ")" ::: "memory")
#define PG8_BAR __builtin_amdgcn_s_barrier()
#define PG8_SCHED __builtin_amdgcn_sched_barrier(0)
    Unit cur, nxt; int ui = 0;
    if (!S.next(0, cur)) return;
    f32x4 acc[2][2][4][2];
#pragma unroll
    for (int a = 0; a < 2; ++a)
#pragma unroll
        for (int b = 0; b < 2; ++b)
#pragma unroll
            for (int m = 0; m < 4; ++m)
#pragma unroll
                for (int n = 0; n < 2; ++n) acc[a][b][m][n] = (f32x4){0.f, 0.f, 0.f, 0.f};
    bf16x8 At[4][2], B0[2][2], B1[2][2];
    const char* cA = (const char*)g.A + (size_t)cur.pm * tstep + (size_t)cur.k0 * 2; const char* cB = (const char*)g.Bt + (size_t)cur.pn * tstep + (size_t)cur.k0 * 2;
    S.a_ready(cur);
    PG8_STAGE(PG8_SB(0, 0), cB, voffB); PG8_STAGE(PG8_SA(0, 0), cA, voffA); PG8_STAGE(PG8_SB(0, 1), cB + hstep, voffB); PG8_STAGE(PG8_SA(0, 1), cA + hstep, voffA);
    if (wr == 1) PG8_BAR;
    PG8_WAIT_V(4); PG8_BAR;
    PG8_STAGE(PG8_SB(1, 0), cB + kstep, voffB); PG8_STAGE(PG8_SA(1, 0), cA + kstep, voffA); PG8_STAGE(PG8_SB(1, 1), cB + hstep + kstep, voffB);
    PG8_WAIT_V(6); PG8_BAR;
    PG8_STAMP();
    for (;;) {
        const bool has_next = S.next(ui + 1, nxt);
        const char* nA = has_next ? (const char*)g.A + (size_t)nxt.pm * tstep + (size_t)nxt.k0 * 2 : cA; const char* nB = has_next ? (const char*)g.Bt + (size_t)nxt.pn * tstep + (size_t)nxt.k0 * 2 : cB;
        for (int t = 0; t < nt; t += 2) {
            const bool last = (t == nt - 2);
            const char* a1 = cA + (size_t)(t + 1) * kstep;
            const char* a2 = last ? nA : cA + (size_t)(t + 2) * kstep; const char* b2 = last ? nB : cB + (size_t)(t + 2) * kstep;
            const char* a3 = a2 + kstep; const char* b3 = b2 + kstep;
            if (last && has_next) S.a_ready(nxt);
            PG8_LDB(B0, 0, 0); PG8_SCHED; PG8_LDA(At, 0, 0); PG8_STAGE(PG8_SA(1, 1), a1 + hstep, voffA);
            PG8_WAIT_L(8); PG8_BAR; PG8_WAIT_L(0); PG8_MMA(0, 0, At, B0); PG8_BAR; PG8_SCHED;
            PG8_LDB(B1, 0, 1); PG8_STAGE(PG8_SB(0, 0), b2, voffB);
            PG8_BAR; PG8_WAIT_L(0); PG8_MMA(0, 1, At, B1); PG8_BAR;
            PG8_LDA(At, 0, 1); PG8_STAGE(PG8_SA(0, 0), a2, voffA);
            PG8_BAR; PG8_WAIT_L(0); PG8_MMA(1, 0, At, B0); PG8_BAR; PG8_SCHED;
            PG8_STAGE(PG8_SB(0, 1), b2 + hstep, voffB);
            PG8_WAIT_V(6); PG8_BAR; PG8_MMA(1, 1, At, B1); PG8_BAR;
            PG8_LDB(B0, 1, 0); PG8_SCHED; PG8_LDA(At, 1, 0); PG8_STAGE(PG8_SA(0, 1), a2 + hstep, voffA);
            PG8_WAIT_L(8); PG8_BAR; PG8_WAIT_L(0); PG8_MMA(0, 0, At, B0); PG8_BAR; PG8_SCHED;
            PG8_LDB(B1, 1, 1); PG8_STAGE(PG8_SB(1, 0), b3, voffB);
            PG8_BAR; PG8_WAIT_L(0); PG8_MMA(0, 1, At, B1); PG8_BAR;
            PG8_LDA(At, 1, 1); PG8_STAGE(PG8_SA(1, 0), a3, voffA);
            PG8_BAR; PG8_WAIT_L(0); PG8_MMA(1, 0, At, B0); PG8_BAR; PG8_SCHED;
            PG8_STAGE(PG8_SB(1, 1), b3 + hstep, voffB);
            PG8_WAIT_V(6); PG8_BAR; PG8_MMA(1, 1, At, B1); PG8_BAR;
        }
        PG8_STAMP();
        if constexpr (!Epi::AFTER_DRAIN) { E(acc, cur, wr, wc, fr, fq); S.done(cur); }
        PG8_STAMP();
        if (!has_next) break;
#pragma unroll
        for (int a = 0; a < 2; ++a)
#pragma unroll
            for (int b = 0; b < 2; ++b)
#pragma unroll
                for (int m = 0; m < 4; ++m)
#pragma unroll
                    for (int n = 0; n < 2; ++n) acc[a][b][m][n] = (f32x4){0.f, 0.f, 0.f, 0.f};
        cur = nxt; cA = nA; cB = nB; ++ui;
    }
    PG8_WAIT_V(0);
    if (wr == 0) PG8_BAR;
    PG8_BAR;
    if constexpr (Epi::AFTER_DRAIN) { E.fused(acc, cur, wr, wc, fr, fq, lds, wid, lane); S.done(cur); }
    PG8_STAMP();
    if (STAMP && wid == 0) { stamps[lane] = lane < nts ? (((unsigned long long)(unsigned)ts_hi << 32) | (unsigned)ts_lo) : 0ull;
        if (lane == 62) stamps[62] = rt_entry; if (lane == 63) stamps[63] = (unsigned long long)wall_clock64(); }
#undef PG8_STAMP
#undef PG8_SA
#undef PG8_SB
#undef PG8_STAGE
#undef PG8_LDA
#undef PG8_LDB
#undef PG8_MMA
#undef PG8_WAIT_V
#undef PG8_WAIT_L
#undef PG8_BAR
#undef PG8_SCHED
}
}
#ifndef DUP_MASK
#define DUP_MASK 0
#endif

#include <cstdio>
#include <cstdint>
#define LAS __attribute__((address_space(3)))
typedef unsigned short bf16_t;
typedef short bf16x8 __attribute__((ext_vector_type(8)));
typedef short s16x4 __attribute__((ext_vector_type(4)));
typedef float f32x4 __attribute__((ext_vector_type(4)));
typedef float f32x8 __attribute__((ext_vector_type(8)));
typedef float f32x16 __attribute__((ext_vector_type(16)));
typedef unsigned u32x4 __attribute__((ext_vector_type(4)));
typedef unsigned u32x2 __attribute__((ext_vector_type(2)));

constexpr int DM = 2048, NBATCH = 8, SEQ = 4096, CTXL = 256;
constexpr int MX = NBATCH * SEQ, MC = NBATCH * CTXL, MT = MX + MC;
constexpr int NQKV = 3072, NMI = 6144, NMI_RAW = 6176, NMI_PAD = 6400, DFF = 5632, NUP = 2 * DFF;
constexpr int MODW = 6 * DM;
constexpr float RMS_EPS = 1e-6f;
constexpr int NTHREADS = 512, NWAVES = 8;

constexpr size_t MiB = 1u << 20;
constexpr size_t WS_CTL = 0, CTL_ZERO_BYTES = 1 * MiB;
constexpr size_t WS_MOD = 1 * MiB;
constexpr size_t WS_ROPE = 3 * MiB;
constexpr size_t WS_WQKV = 8 * MiB;
constexpr size_t WS_WAO = 32 * MiB;
constexpr size_t WS_WMI = 48 * MiB;
constexpr size_t WS_WMO = 98 * MiB;
constexpr size_t WS_WUP = 114 * MiB;
constexpr size_t WS_WDN = 290 * MiB;
constexpr size_t WS_X = 378 * MiB;
constexpr size_t WS_H = 650 * MiB;
constexpr size_t WS_Z = 786 * MiB;
constexpr size_t WS_GATE = 1194 * MiB;
constexpr size_t WS_HF = 1200 * MiB;
constexpr size_t WS_HB = 1336 * MiB;
constexpr size_t WS_END = 1472 * MiB;
constexpr int CW_TMO = 0;
constexpr int CW_BAR = 4096;

constexpr int LDS_BYTES = 147456;
constexpr int MISC_OFF = LDS_BYTES - 256;

#define XB_TMO      128
#define XB_XCNT(j)  (256  + 64 * (j))
#define XB_XSUB(j)  (1280 + 64 * (j))
#define XB_XGEN(j)  (2304 + 64 * (j))
#define XB_TOP      3328
#define XB_TOPGEN   3392
#define XCD_BAR_WORDS 3456
#define XB_SPIN_CAP (1u << 18)

__device__ __forceinline__ unsigned xb_ld(unsigned* p)              { return __hip_atomic_load(p, __ATOMIC_RELAXED, __HIP_MEMORY_SCOPE_AGENT); }
__device__ __forceinline__ unsigned xb_add(unsigned* p, unsigned v) { return __hip_atomic_fetch_add(p, v, __ATOMIC_RELAXED, __HIP_MEMORY_SCOPE_AGENT); }
__device__ __forceinline__ unsigned xb_xcc_id() { return (unsigned)__builtin_amdgcn_s_getreg((3 << 11) | 20) & 0xFu; }
#define XB_SPIN(cond, bar) do { unsigned _sp = 0; while (cond) { __builtin_amdgcn_s_sleep(1); \
    if ((++_sp & 255u) == 0u) { if (xb_ld(&(bar)[XB_TMO])) break; if (_sp > XB_SPIN_CAP) { atomicAdd(&(bar)[XB_TMO], 1u); break; } } } } while (0)

struct XcdBarrier { unsigned* bar; unsigned x; volatile LAS unsigned* st; };

__device__ __forceinline__ XcdBarrier xcd_barrier_post(unsigned* bar, volatile LAS unsigned* st) {
    XcdBarrier b; b.bar = bar; b.x = xb_xcc_id(); b.st = st;
    if (threadIdx.x == 0) (void)xb_add(&bar[XB_XCNT(b.x)], 1u);
    return b;
}
__device__ __forceinline__ void xcd_barrier_complete(unsigned* bar, unsigned x, unsigned& nloc, unsigned& nx) {
    const unsigned G = gridDim.x * gridDim.y * gridDim.z;
    unsigned sum, cnt, mine, sp = 0u;
    for (;;) {
        sum = 0u; cnt = 0u; mine = 0u;
#pragma unroll
        for (unsigned j = 0; j < 16; ++j) { const unsigned c = xb_ld(&bar[XB_XCNT(j)]); sum += c; cnt += (c > 0u) ? 1u : 0u; mine = (j == x) ? c : mine; }
        if (sum == G) break;
        __builtin_amdgcn_s_sleep(1);
        if ((++sp & 255u) == 0u) { if (xb_ld(&bar[XB_TMO])) break; if (sp > XB_SPIN_CAP) { atomicAdd(&bar[XB_TMO], 1u); break; } }
    }
    nloc = mine > 0u ? mine : 1u; nx = cnt > 0u ? cnt : 1u;
}
__device__ __forceinline__ void xcd_barrier(const XcdBarrier& b) {
    asm volatile("s_waitcnt vmcnt(0)" ::: "memory");
    __syncthreads();
    if (threadIdx.x == 0) {
        unsigned* bar = b.bar;
        __builtin_amdgcn_s_waitcnt(0);
        unsigned nloc = b.st[0], nx = b.st[1];
        if (nloc == 0u) { xcd_barrier_complete(bar, b.x, nloc, nx); b.st[0] = nloc; b.st[1] = nx; }
        const unsigned old = xb_add(&bar[XB_XSUB(b.x)], 1u);
        const unsigned gen = old / nloc;
        if (old + 1u == (gen + 1u) * nloc) {
            __builtin_amdgcn_fence(__ATOMIC_RELEASE, "agent");
            asm volatile("s_waitcnt vmcnt(0)" ::: "memory");
            const unsigned og = xb_add(&bar[XB_TOP], 1u);
            const unsigned tg = og / nx;
            if (og + 1u == (tg + 1u) * nx) xb_add(&bar[XB_TOPGEN], 1u);
            else XB_SPIN(xb_ld(&bar[XB_TOPGEN]) == tg, bar);
            __builtin_amdgcn_fence(__ATOMIC_ACQUIRE, "agent");
            xb_add(&bar[XB_XGEN(b.x)], 1u);
            asm volatile("s_waitcnt vmcnt(0)" ::: "memory");
        } else {
            XB_SPIN(xb_ld(&bar[XB_XGEN(b.x)]) == gen, bar);
            __builtin_amdgcn_fence(__ATOMIC_ACQUIRE, "agent");
            asm volatile("s_waitcnt vmcnt(0)" ::: "memory");
        }
    }
    __syncthreads();
}

#define LDS_WAIT() asm volatile("s_waitcnt lgkmcnt(0)" ::: "memory")
__device__ __forceinline__ unsigned cvtpk(float lo, float hi) { unsigned r; asm volatile("v_cvt_pk_bf16_f32 %0, %1, %2" : "=v"(r) : "v"(lo), "v"(hi)); return r; }
__device__ __forceinline__ float bf2f(bf16_t b) { return __uint_as_float(((unsigned)b) << 16); }
__device__ __forceinline__ float bflo(unsigned w) { return __uint_as_float(w << 16); }
__device__ __forceinline__ float bfhi(unsigned w) { return __uint_as_float(w & 0xffff0000u); }
__device__ __forceinline__ float wave_sum(float v) {
#pragma unroll
    for (int o = 1; o < 64; o <<= 1) v += __shfl_xor(v, o);
    return v;
}
__device__ __forceinline__ float silu_f(float v) { return v * __builtin_amdgcn_rcpf(1.0f + __expf(-v)); }
__device__ __forceinline__ float sigmoid_f(float v) { return __builtin_amdgcn_rcpf(1.0f + __expf(-v)); }
__device__ __forceinline__ float log_sigmoid_f(float v) { return v < 0.f ? v - log1pf(expf(v)) : -log1pf(expf(-v)); }

struct Args { const float* in[20]; float* out; unsigned char* ws; int ph_lo, ph_hi; int li, pad; };
enum { I_X = 0, I_C, I_CTX, I_CCTX, I_WMOD, I_BMOD, I_GMIX, I_GFFN, I_WQKV, I_SINK, I_WAO, I_WMI, I_BMI, I_GHEAD, I_WMO, I_WUP, I_CONVW, I_CONVB, I_WDN, I_GFINAL };

__device__ __forceinline__ void p0_transpose_item(const float* W, int K, int N, bf16_t* WT, LAS float* scr, int item, int lane, int mapkind) {
    const int nblk = (N + 63) / 64, kb = item / nblk, nb = item % nblk, k0 = 64 * kb, n0 = 64 * nb;
    f32x4 v[16];
    const int nn = (lane & 15) * 4; const bool nok = n0 + nn < N;
#pragma unroll
    for (int i = 0; i < 16; ++i) { const int kk = 4 * i + (lane >> 4); v[i] = nok ? __builtin_nontemporal_load((const f32x4*)(W + (size_t)(k0 + kk) * N + n0 + nn)) : (f32x4){0.f, 0.f, 0.f, 0.f}; }
#pragma unroll
    for (int i = 0; i < 16; ++i) { const int kk = 4 * i + (lane >> 4); LAS float* d = scr + kk * 65 + nn; d[0] = v[i][0]; d[1] = v[i][1]; d[2] = v[i][2]; d[3] = v[i][3]; }
    LDS_WAIT(); asm volatile("" ::: "memory");
    const int c = lane & 7;
#pragma unroll
    for (int j = 0; j < 8; ++j) { const int n = (lane >> 3) + 8 * j, nc = n0 + n;
        int row = nc;
        if (mapkind == 1) row = nc < DFF ? 256 * (nc / 128) + (nc % 128) : 256 * ((nc - DFF) / 128) + 128 + ((nc - DFF) % 128);
        if (mapkind == 2 && nc < 2560) { const int d0 = nc % 128; row = (nc - d0) + 2 * (d0 % 64) + d0 / 64; }
        const LAS float* s = scr + (8 * c) * 65 + n;
        u32x4 o; o.x = cvtpk(s[0 * 65], s[1 * 65]); o.y = cvtpk(s[2 * 65], s[3 * 65]); o.z = cvtpk(s[4 * 65], s[5 * 65]); o.w = cvtpk(s[6 * 65], s[7 * 65]);
        if (nc < N) *(u32x4*)(WT + (size_t)row * K + k0 + 8 * c) = o; }
    LDS_WAIT(); asm volatile("" ::: "memory");
}
__device__ __forceinline__ void get_mat(const Args& a, int m, const float*& W, bf16_t*& WT, int& K, int& N) {
    unsigned char* ws = a.ws;
    if (m < 2)       { K = DM;  N = NQKV;    W = a.in[I_WQKV] + (size_t)m * DM * NQKV;          WT = (bf16_t*)(ws + WS_WQKV) + (size_t)m * NQKV * DM; }
    else if (m < 4)  { K = DM;  N = DM;      W = a.in[I_WAO] + (size_t)(m - 2) * DM * DM;       WT = (bf16_t*)(ws + WS_WAO) + (size_t)(m - 2) * DM * DM; }
    else if (m < 6)  { K = DM;  N = NMI_RAW; W = a.in[I_WMI] + (size_t)(m - 4) * DM * NMI_RAW;  WT = (bf16_t*)(ws + WS_WMI) + (size_t)(m - 4) * NMI_PAD * DM; }
    else if (m < 8)  { K = DM;  N = DM;      W = a.in[I_WMO] + (size_t)(m - 6) * DM * DM;       WT = (bf16_t*)(ws + WS_WMO) + (size_t)(m - 6) * DM * DM; }
    else if (m < 12) { K = DM;  N = NUP;     W = a.in[I_WUP] + (size_t)(m - 8) * DM * NUP;      WT = (bf16_t*)(ws + WS_WUP) + (size_t)(m - 8) * NUP * DM; }
    else             { K = DFF; N = DM;      W = a.in[I_WDN] + (size_t)(m - 12) * DFF * DM;     WT = (bf16_t*)(ws + WS_WDN) + (size_t)(m - 12) * DM * DFF; }
}
constexpr int CW_BG = 2048;
__device__ __forceinline__ int bg_mat(int L, int q) {
    return q == 0 ? ((L & 1) ? 4 + (L >> 1) : (L >> 1)) : (q == 1 ? ((L & 1) ? 6 + (L >> 1) : 2 + (L >> 1)) : (q == 2 ? 8 + L : 12 + L));
}
__device__ __forceinline__ int bg_items(int m) { const int K = m >= 12 ? DFF : DM, N = m < 2 ? NQKV : (m < 4 ? DM : (m < 6 ? NMI_RAW : (m < 8 ? DM : (m < 12 ? NUP : DM)))); return (K / 64) * ((N + 63) / 64); }
__device__ __forceinline__ void bg_run(const Args& a, LAS unsigned char* lds, int L_lo, int L_hi, int max_claims, const unsigned* donectr, unsigned done_total, int tid, int lane, int wave) {
    unsigned* ctr = (unsigned*)(a.ws + WS_CTL) + CW_BG;
    LAS unsigned* slot = (LAS unsigned*)(lds + 8 * 17408);
    LAS float* scr = (LAS float*)(lds + wave * 17408);
    int claims = 0;
    for (int L = L_lo; L <= L_hi; ++L) {
        const int n0 = bg_items(bg_mat(L, 0)), n1 = n0 + bg_items(bg_mat(L, 1)), n2 = n1 + bg_items(bg_mat(L, 2)), total = n2 + bg_items(bg_mat(L, 3));
        for (;;) {
            if (claims >= max_claims) return;
            __syncthreads();
            if (tid == 0) { unsigned v = 0x7fffffffu;
                if (donectr == nullptr || __hip_atomic_load(donectr, __ATOMIC_RELAXED, __HIP_MEMORY_SCOPE_AGENT) < done_total) v = __hip_atomic_fetch_add(ctr + 64 * L, 8u, __ATOMIC_RELAXED, __HIP_MEMORY_SCOPE_AGENT);
                *slot = v; }
            __syncthreads();
            const int base = (int)*slot;
            if (base == 0x7fffffff) return;
            if (base >= total) break;
            ++claims;
            const int it = base + wave;
            if (it < total) {
                const int q = it < n0 ? 0 : (it < n1 ? 1 : (it < n2 ? 2 : 3)); const int m = bg_mat(L, q); const int loc = it - (q == 0 ? 0 : (q == 1 ? n0 : (q == 2 ? n1 : n2)));
                const float* W; bf16_t* WT; int K, N; get_mat(a, m, W, WT, K, N);
                p0_transpose_item(W, K, N, WT, scr, loc, lane, (m >= 8 && m < 12) ? 1 : (m < 2 ? 2 : 0));
            }
        }
    }
}
constexpr int CW_GATEQ = 3072;
__device__ __forceinline__ void gate_run(const Args& a, LAS unsigned char* lds, const bf16_t* Hm, const bf16_t* Wg, const float* bg, float* gates, int j, int tid, int lane, int wave) {
    unsigned* ctr = (unsigned*)(a.ws + WS_CTL) + CW_GATEQ + 64 * j;
    LAS unsigned* slot = (LAS unsigned*)(lds + 8 * 17408);
    const int r = lane & 31, h = lane >> 5;
    for (;;) {
        __syncthreads();
        if (tid == 0) *slot = __hip_atomic_fetch_add(ctr, 1u, __ATOMIC_RELAXED, __HIP_MEMORY_SCOPE_AGENT);
        __syncthreads();
        const int pm = (int)*slot;
        if (pm >= MT / 256) break;
        const int row0 = pm * 256 + 32 * wave;
        const bf16_t* ap = Hm + (size_t)(row0 + r) * DM + 8 * h; const bf16_t* bp = Wg + (size_t)r * DM + 8 * h;
        f32x16 acc;
#pragma unroll
        for (int i = 0; i < 16; ++i) acc[i] = 0.f;
        for (int k8 = 0; k8 < DM / 16; k8 += 8) {
            bf16x8 av[8], bv[8];
#pragma unroll
            for (int u = 0; u < 8; ++u) { av[u] = *(const bf16x8*)(ap + 16 * (k8 + u)); bv[u] = *(const bf16x8*)(bp + 16 * (k8 + u)); }
#pragma unroll
            for (int u = 0; u < 8; ++u) acc = __builtin_amdgcn_mfma_f32_32x32x16_bf16(av[u], bv[u], acc, 0, 0, 0);
        }
        const float bias = bg[r]; const bool ls = (r & 8) != 0;
#pragma unroll
        for (int i = 0; i < 16; ++i) { const int row = row0 + (i & 3) + 8 * (i >> 2) + 4 * h; float v = acc[i] + bias; if (ls) v = log_sigmoid_f(v); gates[(size_t)row * 32 + r] = v; }
    }
}
__device__ __forceinline__ void phase_prologue(const Args& a, LAS unsigned char* lds, int tid, int lane, int wave) {
    const int gw = blockIdx.x * NWAVES + wave, NGW = gridDim.x * NWAVES;
    LAS float* scr = (LAS float*)(lds + wave * 17408);
    for (int rpa = 0; rpa < (((DUP_MASK) >> 9) & 1) + 1; ++rpa)
    for (int q = 0; q < 4; ++q) {
        const int m = bg_mat(0, q);
        const float* W; bf16_t* WT; int K, N; get_mat(a, m, W, WT, K, N);
        const int nitems = (K / 64) * ((N + 63) / 64);
        for (int it = gw; it < nitems; it += NGW) p0_transpose_item(W, K, N, WT, scr, it, lane, (m >= 8 && m < 12) ? 1 : (m < 2 ? 2 : 0));
    }
    {
        const size_t per = (size_t)(NMI_PAD - NMI_RAW) * DM / 8;
        const size_t gt = (size_t)blockIdx.x * NTHREADS + tid, GT = (size_t)gridDim.x * NTHREADS;
        for (size_t e = gt; e < 2 * per; e += GT) { const size_t j = e / per, o = e % per;
            *(u32x4*)((bf16_t*)(a.ws + WS_WMI) + j * NMI_PAD * DM + (size_t)NMI_RAW * DM + o * 8) = (u32x4){0u, 0u, 0u, 0u}; }
        float* rc = (float*)(a.ws + WS_ROPE); float* rs = (float*)(a.ws + WS_ROPE + 1 * MiB);
        for (size_t e = gt; e < (size_t)SEQ * 64; e += GT) { const int t = (int)(e >> 6), jj = (int)(e & 63), fi = jj & 31;
            const float inv = __builtin_amdgcn_exp2f(-(float)fi * (13.287712379549449f / 32.0f)); const float pos = (float)(jj < 32 ? (t >> 6) : (t & 63)); const float rev = pos * inv * 0.15915494309189535f;
            rc[e] = __builtin_amdgcn_cosf(rev); rs[e] = __builtin_amdgcn_sinf(rev); }
    }
    __syncthreads();
    for (int rpd = 0; rpd < (((DUP_MASK) >> 10) & 1) + 1; ++rpd)
    for (int bt = blockIdx.x; bt < 192; bt += gridDim.x) {
        LAS float* sc = (LAS float*)lds;
#pragma unroll
        for (int u = 0; u < 9; ++u) { const int e = 4 * (tid + NTHREADS * u);
            const f32x4 v = u < 8 ? *(const f32x4*)(a.in[I_C] + e) : *(const f32x4*)(a.in[I_CCTX] + (e - 8 * DM));
            *(LAS f32x4*)(sc + e) = (f32x4){v[0] / (1.0f + __expf(-v[0])), v[1] / (1.0f + __expf(-v[1])), v[2] / (1.0f + __expf(-v[2])), v[3] / (1.0f + __expf(-v[3]))}; }
        __syncthreads();
        const int i = bt / 48, n0 = (bt % 48) * 256 + wave * 32 + (lane & 7) * 4, kp = lane >> 3;
        float acc[9][4];
#pragma unroll
        for (int r = 0; r < 9; ++r) { acc[r][0] = 0.f; acc[r][1] = 0.f; acc[r][2] = 0.f; acc[r][3] = 0.f; }
        const float* wp = a.in[I_WMOD] + (size_t)i * DM * MODW + n0;
#pragma unroll 8
        for (int k = kp; k < DM; k += 8) {
            const f32x4 w = __builtin_nontemporal_load((const f32x4*)(wp + (size_t)k * MODW));
#pragma unroll
            for (int r = 0; r < 9; ++r) { const float s = sc[r * DM + k]; acc[r][0] = fmaf(s, w[0], acc[r][0]); acc[r][1] = fmaf(s, w[1], acc[r][1]); acc[r][2] = fmaf(s, w[2], acc[r][2]); acc[r][3] = fmaf(s, w[3], acc[r][3]); }
        }
#pragma unroll
        for (int r = 0; r < 9; ++r)
#pragma unroll
            for (int j = 0; j < 4; ++j) { float v = acc[r][j]; v += __shfl_xor(v, 8); v += __shfl_xor(v, 16); v += __shfl_xor(v, 32); acc[r][j] = v; }
        if (kp == 0) {
            const f32x4 bv = *(const f32x4*)(a.in[I_BMOD] + (size_t)i * MODW + n0);
            float* mo = (float*)(a.ws + WS_MOD) + (size_t)i * 9 * MODW + n0;
#pragma unroll
            for (int r = 0; r < 9; ++r) *(f32x4*)(mo + (size_t)r * MODW) = (f32x4){acc[r][0] + bv[0], acc[r][1] + bv[1], acc[r][2] + bv[2], acc[r][3] + bv[3]};
        }
        __syncthreads();
    }
}

__device__ __forceinline__ void norm_row(int r, const void* xs, bool xs_f32, const void* cs, bool cs_f32, const float* g, const float* modl, int sh_off, int sc_off, bf16_t* H, const float* part, bf16_t* xout, int lane) {
    const bool f32src = r < MX ? xs_f32 : cs_f32; const void* src = r < MX ? xs : cs;
    const int mr = r < MX ? (r >> 12) : 8;
    f32x4 v[8]; float ss = 0.f;
    if (f32src) { const float* xr = (const float*)src + (size_t)r * DM;
#pragma unroll
        for (int j = 0; j < 4; ++j) { v[2 * j] = *(const f32x4*)(xr + 8 * lane + 512 * j); v[2 * j + 1] = *(const f32x4*)(xr + 8 * lane + 512 * j + 4); }
    } else { const bf16_t* xr = (const bf16_t*)src + (size_t)r * DM;
#pragma unroll
        for (int j = 0; j < 4; ++j) { const u32x4 b = *(const u32x4*)(xr + 8 * lane + 512 * j);
            v[2 * j] = (f32x4){bflo(b.x), bfhi(b.x), bflo(b.y), bfhi(b.y)}; v[2 * j + 1] = (f32x4){bflo(b.z), bfhi(b.z), bflo(b.w), bfhi(b.w)}; } }
    if (part != nullptr && r >= MX) {
#pragma unroll
        for (int q = 0; q < 4; ++q) { const float* pr = part + ((size_t)q * MC + (r - MX)) * DM;
#pragma unroll
            for (int j = 0; j < 4; ++j) { v[2 * j] += *(const f32x4*)(pr + 8 * lane + 512 * j); v[2 * j + 1] += *(const f32x4*)(pr + 8 * lane + 512 * j + 4); } }
#pragma unroll
        for (int j = 0; j < 4; ++j) { u32x4 w; w.x = cvtpk(v[2 * j][0], v[2 * j][1]); w.y = cvtpk(v[2 * j][2], v[2 * j][3]); w.z = cvtpk(v[2 * j + 1][0], v[2 * j + 1][1]); w.w = cvtpk(v[2 * j + 1][2], v[2 * j + 1][3]);
            *(u32x4*)(xout + (size_t)r * DM + 8 * lane + 512 * j) = w;
            v[2 * j] = (f32x4){bflo(w.x), bfhi(w.x), bflo(w.y), bfhi(w.y)}; v[2 * j + 1] = (f32x4){bflo(w.z), bfhi(w.z), bflo(w.w), bfhi(w.w)}; }
    }
#pragma unroll
    for (int j = 0; j < 8; ++j) ss += (v[j][0] * v[j][0] + v[j][1] * v[j][1]) + (v[j][2] * v[j][2] + v[j][3] * v[j][3]);
    ss = wave_sum(ss);
    const float rs = 1.0f / sqrtf(ss * (1.0f / DM) + RMS_EPS);
    const float* mrow = modl + (size_t)mr * MODW;
#pragma unroll
    for (int j = 0; j < 4; ++j) { const int col = 8 * lane + 512 * j;
        unsigned o[4];
#pragma unroll
        for (int q = 0; q < 2; ++q) { const f32x4 gg = *(const f32x4*)(g + col + 4 * q), scv = *(const f32x4*)(mrow + sc_off + col + 4 * q), shv = *(const f32x4*)(mrow + sh_off + col + 4 * q);
            float hh[4];
#pragma unroll
            for (int e = 0; e < 4; ++e) hh[e] = (v[2 * j + q][e] * rs * gg[e]) * (1.0f + scv[e]) + shv[e];
            o[2 * q] = cvtpk(hh[0], hh[1]); o[2 * q + 1] = cvtpk(hh[2], hh[3]); }
        *(u32x4*)(H + (size_t)r * DM + col) = (u32x4){o[0], o[1], o[2], o[3]}; }
}
__device__ __forceinline__ void phase_norm(const void* xs, bool xs_f32, const void* cs, bool cs_f32, const float* g, const float* modl, int sh_off, int sc_off, bf16_t* H, int row_end, const float* part, bf16_t* xout, int lane, int wave) {
    const int gw = blockIdx.x * NWAVES + wave, NGW = gridDim.x * NWAVES;
    if (NGW != 2048) { for (int r = gw; r < row_end; r += NGW) norm_row(r, xs, xs_f32, cs, cs_f32, g, modl, sh_off, sc_off, H, part, xout, lane); return; }
    const int b = gw & 7, w8 = gw >> 3;
    f32x4 gs[8], sh[8];
    { const float* mrow = modl + (size_t)b * MODW;
#pragma unroll
      for (int j = 0; j < 4; ++j)
#pragma unroll
        for (int q = 0; q < 2; ++q) { const int col = 8 * lane + 512 * j + 4 * q; const f32x4 gg = *(const f32x4*)(g + col), scv = *(const f32x4*)(mrow + sc_off + col);
            gs[2 * j + q] = gg * (scv + 1.0f); sh[2 * j + q] = *(const f32x4*)(mrow + sh_off + col); } }
    if (MX + gw < row_end) norm_row(MX + gw, xs, xs_f32, cs, cs_f32, g, modl, sh_off, sc_off, H, part, xout, lane);
    for (int k = 14; k >= 0; k -= 2) {
        const int r = b * SEQ + w8 + 256 * k, r2 = r + 256;
        f32x4 va[8], vb[8]; float sa = 0.f, sb = 0.f;
        if (xs_f32) { const float* xa = (const float*)xs + (size_t)r * DM; const float* xb = (const float*)xs + (size_t)r2 * DM;
#pragma unroll
            for (int j = 0; j < 4; ++j) { va[2 * j] = *(const f32x4*)(xa + 8 * lane + 512 * j); va[2 * j + 1] = *(const f32x4*)(xa + 8 * lane + 512 * j + 4);
                vb[2 * j] = *(const f32x4*)(xb + 8 * lane + 512 * j); vb[2 * j + 1] = *(const f32x4*)(xb + 8 * lane + 512 * j + 4); }
        } else { const bf16_t* xa = (const bf16_t*)xs + (size_t)r * DM; const bf16_t* xb = (const bf16_t*)xs + (size_t)r2 * DM;
            u32x4 ba[4], bb[4];
#pragma unroll
            for (int j = 0; j < 4; ++j) { ba[j] = *(const u32x4*)(xa + 8 * lane + 512 * j); bb[j] = *(const u32x4*)(xb + 8 * lane + 512 * j); }
#pragma unroll
            for (int j = 0; j < 4; ++j) { va[2 * j] = (f32x4){bflo(ba[j].x), bfhi(ba[j].x), bflo(ba[j].y), bfhi(ba[j].y)}; va[2 * j + 1] = (f32x4){bflo(ba[j].z), bfhi(ba[j].z), bflo(ba[j].w), bfhi(ba[j].w)};
                vb[2 * j] = (f32x4){bflo(bb[j].x), bfhi(bb[j].x), bflo(bb[j].y), bfhi(bb[j].y)}; vb[2 * j + 1] = (f32x4){bflo(bb[j].z), bfhi(bb[j].z), bflo(bb[j].w), bfhi(bb[j].w)}; } }
#pragma unroll
        for (int j = 0; j < 8; ++j) { sa += (va[j][0] * va[j][0] + va[j][1] * va[j][1]) + (va[j][2] * va[j][2] + va[j][3] * va[j][3]); sb += (vb[j][0] * vb[j][0] + vb[j][1] * vb[j][1]) + (vb[j][2] * vb[j][2] + vb[j][3] * vb[j][3]); }
#pragma unroll
        for (int o = 1; o < 64; o <<= 1) { sa += __shfl_xor(sa, o); sb += __shfl_xor(sb, o); }
        const float ra = 1.0f / sqrtf(sa * (1.0f / DM) + RMS_EPS), rb = 1.0f / sqrtf(sb * (1.0f / DM) + RMS_EPS);
#pragma unroll
        for (int j = 0; j < 4; ++j) { const int col = 8 * lane + 512 * j;
            const f32x4 a0 = va[2 * j] * ra * gs[2 * j] + sh[2 * j], a1 = va[2 * j + 1] * ra * gs[2 * j + 1] + sh[2 * j + 1];
            const f32x4 b0 = vb[2 * j] * rb * gs[2 * j] + sh[2 * j], b1 = vb[2 * j + 1] * rb * gs[2 * j + 1] + sh[2 * j + 1];
            *(u32x4*)(H + (size_t)r * DM + col) = (u32x4){cvtpk(a0[0], a0[1]), cvtpk(a0[2], a0[3]), cvtpk(a1[0], a1[1]), cvtpk(a1[2], a1[3])};
            *(u32x4*)(H + (size_t)r2 * DM + col) = (u32x4){cvtpk(b0[0], b0[1]), cvtpk(b0[2], b0[3]), cvtpk(b1[0], b1[1]), cvtpk(b1[2], b1[3])}; }
    }
}
__device__ __forceinline__ void phase_final(const bf16_t* X, const float* g, float* out, int lane, int wave) {
    const int gw = blockIdx.x * NWAVES + wave, NGW = gridDim.x * NWAVES;
    f32x4 gg[8];
#pragma unroll
    for (int j = 0; j < 4; ++j) { gg[2 * j] = *(const f32x4*)(g + 8 * lane + 512 * j); gg[2 * j + 1] = *(const f32x4*)(g + 8 * lane + 512 * j + 4); }
    const bool fast = NGW == 2048; const int b = gw & 7, w8 = gw >> 3;
    const int n_it = fast ? 8 : (gw < MX ? (MX - gw + 2 * NGW - 1) / (2 * NGW) : 0);
    for (int it = 0; it < n_it; ++it) {
        int r, r2;
        if (fast) { r = b * SEQ + w8 + 256 * (15 - 2 * it); r2 = r - 256; }
        else { r = gw + 2 * NGW * it; r2 = (r + NGW < MX) ? r + NGW : r; }
        u32x4 ba[4], bb[4];
#pragma unroll
        for (int j = 0; j < 4; ++j) { ba[j] = *(const u32x4*)(X + (size_t)r * DM + 8 * lane + 512 * j); bb[j] = *(const u32x4*)(X + (size_t)r2 * DM + 8 * lane + 512 * j); }
        f32x4 va[8], vb[8]; float sa = 0.f, sb = 0.f;
#pragma unroll
        for (int j = 0; j < 4; ++j) { va[2 * j] = (f32x4){bflo(ba[j].x), bfhi(ba[j].x), bflo(ba[j].y), bfhi(ba[j].y)}; va[2 * j + 1] = (f32x4){bflo(ba[j].z), bfhi(ba[j].z), bflo(ba[j].w), bfhi(ba[j].w)};
            vb[2 * j] = (f32x4){bflo(bb[j].x), bfhi(bb[j].x), bflo(bb[j].y), bfhi(bb[j].y)}; vb[2 * j + 1] = (f32x4){bflo(bb[j].z), bfhi(bb[j].z), bflo(bb[j].w), bfhi(bb[j].w)}; }
#pragma unroll
        for (int j = 0; j < 8; ++j) { sa += (va[j][0] * va[j][0] + va[j][1] * va[j][1]) + (va[j][2] * va[j][2] + va[j][3] * va[j][3]); sb += (vb[j][0] * vb[j][0] + vb[j][1] * vb[j][1]) + (vb[j][2] * vb[j][2] + vb[j][3] * vb[j][3]); }
#pragma unroll
        for (int o = 1; o < 64; o <<= 1) { sa += __shfl_xor(sa, o); sb += __shfl_xor(sb, o); }
        const float ra = 1.0f / sqrtf(sa * (1.0f / DM) + RMS_EPS), rb = 1.0f / sqrtf(sb * (1.0f / DM) + RMS_EPS);
#pragma unroll
        for (int j = 0; j < 4; ++j) { const int col = 8 * lane + 512 * j;
            *(f32x4*)(out + (size_t)r * DM + col) = va[2 * j] * ra * gg[2 * j]; *(f32x4*)(out + (size_t)r * DM + col + 4) = va[2 * j + 1] * ra * gg[2 * j + 1];
            *(f32x4*)(out + (size_t)r2 * DM + col) = vb[2 * j] * rb * gg[2 * j]; *(f32x4*)(out + (size_t)r2 * DM + col + 4) = vb[2 * j + 1] * rb * gg[2 * j + 1]; }
    }
}

struct RangeOrder {
    pg8::StaticOrder b; int pm0; unsigned* donectr;
    __device__ void init(int pm_lo, int pm_hi, int N, int G, int c) { b.init((pm_hi - pm_lo) * 256, N, G, c); pm0 = pm_lo; donectr = nullptr; }
    __device__ __forceinline__ bool next(int i, pg8::Unit& u) const { if (!b.next(i, u)) return false; u.pm += pm0; return true; }
    __device__ __forceinline__ void a_ready(const pg8::Unit&) const {}
    __device__ __forceinline__ void done(const pg8::Unit&) const { if (donectr != nullptr && threadIdx.x == 0) (void)__hip_atomic_fetch_add(donectr, 1u, __ATOMIC_RELAXED, __HIP_MEMORY_SCOPE_AGENT); }
};
struct EpiRes {
    static constexpr bool PERM = true, AFTER_DRAIN = false;
    const float* b32; const bf16_t* b16; bf16_t* out; const float* gate;
    __device__ __forceinline__ void operator()(const pg8::f32x4 (&acc)[2][2][4][2], const pg8::Unit& u, int wr, int wc, int fr, int fq) const {
        const int row0 = u.pm * 256 + wr * 64 + fr, col0 = u.pn * 256 + wc * 32 + 8 * fq;
        const int mr = u.pm < (MX / 256) ? (u.pm >> 4) : 8;
        const float* gp = gate + (size_t)mr * MODW + col0;
        f32x4 gv[2][2];
#pragma unroll
        for (int bj = 0; bj < 2; ++bj)
#pragma unroll
            for (int n = 0; n < 2; ++n) gv[bj][n] = *(const f32x4*)(gp + bj * 128 + n * 4);
        if (b16 != nullptr) {
#pragma unroll
            for (int ai = 0; ai < 2; ++ai) {
                u32x4 bs[4][2];
#pragma unroll
                for (int m = 0; m < 4; ++m)
#pragma unroll
                    for (int bj = 0; bj < 2; ++bj) bs[m][bj] = *(const u32x4*)(b16 + (size_t)(row0 + ai * 128 + m * 16) * DM + col0 + bj * 128);
#pragma unroll
                for (int m = 0; m < 4; ++m)
#pragma unroll
                    for (int bj = 0; bj < 2; ++bj) { const u32x4 b = bs[m][bj]; const f32x4 a0 = acc[ai][bj][m][0] * gv[bj][0], a1 = acc[ai][bj][m][1] * gv[bj][1];
                        u32x4 w; w.x = cvtpk(bflo(b.x) + a0[0], bfhi(b.x) + a0[1]); w.y = cvtpk(bflo(b.y) + a0[2], bfhi(b.y) + a0[3]);
                        w.z = cvtpk(bflo(b.z) + a1[0], bfhi(b.z) + a1[1]); w.w = cvtpk(bflo(b.w) + a1[2], bfhi(b.w) + a1[3]);
                        *(u32x4*)(out + (size_t)(row0 + ai * 128 + m * 16) * DM + col0 + bj * 128) = w; }
                asm volatile("" ::: "memory"); }
        } else {
#pragma unroll
            for (int am = 0; am < 4; ++am) {
                const int ai = am >> 1;
                f32x4 bs[2][2][2];
#pragma unroll
                for (int m2 = 0; m2 < 2; ++m2) { const size_t off = (size_t)(row0 + ai * 128 + ((am & 1) * 2 + m2) * 16) * DM + col0;
#pragma unroll
                    for (int bj = 0; bj < 2; ++bj)
#pragma unroll
                        for (int n = 0; n < 2; ++n) bs[m2][bj][n] = *(const f32x4*)(b32 + off + bj * 128 + n * 4); }
#pragma unroll
                for (int m2 = 0; m2 < 2; ++m2) { const int m = (am & 1) * 2 + m2; const size_t off = (size_t)(row0 + ai * 128 + m * 16) * DM + col0;
#pragma unroll
                    for (int bj = 0; bj < 2; ++bj) { const f32x4 o0 = bs[m2][bj][0] + gv[bj][0] * acc[ai][bj][m][0], o1 = bs[m2][bj][1] + gv[bj][1] * acc[ai][bj][m][1];
                        u32x4 w; w.x = cvtpk(o0[0], o0[1]); w.y = cvtpk(o0[2], o0[3]); w.z = cvtpk(o1[0], o1[1]); w.w = cvtpk(o1[2], o1[3]);
                        *(u32x4*)(out + off + bj * 128) = w; } }
                asm volatile("" ::: "memory"); }
        }
    }
};
struct SplitOrder {
    int nN, kq, G, c;
    __device__ void init(int N, int K, int G_, int c_) { nN = N / 256; kq = K / 4; G = G_; c = c_; }
    __device__ __forceinline__ bool next(int i, pg8::Unit& u) const { const int L = i * G + c; if (L >= 8 * nN * 4) return false;
        const int t = L >> 2; u.k0 = (L & 3) * kq; u.pm = MX / 256 + (t & 7); u.pn = t >> 3; return true; }
    __device__ __forceinline__ void a_ready(const pg8::Unit&) const {}
    __device__ __forceinline__ void done(const pg8::Unit&) const {}
};
struct EpiPart {
    static constexpr bool PERM = false, AFTER_DRAIN = false;
    float* part; const float* gate; int kq;
    __device__ __forceinline__ void operator()(const pg8::f32x4 (&acc)[2][2][4][2], const pg8::Unit& u, int wr, int wc, int fr, int fq) const {
        const int row0 = (u.pm - MX / 256) * 256 + wr * 64 + fr, col0 = u.pn * 256 + wc * 32 + 4 * fq;
        const float* gp = gate + (size_t)8 * MODW + col0;
        float* pq = part + (size_t)(u.k0 / kq) * MC * DM;
        f32x4 gv[2][2];
#pragma unroll
        for (int bj = 0; bj < 2; ++bj)
#pragma unroll
            for (int n = 0; n < 2; ++n) gv[bj][n] = *(const f32x4*)(gp + bj * 128 + n * 16);
#pragma unroll
        for (int ai = 0; ai < 2; ++ai)
#pragma unroll
            for (int m = 0; m < 4; ++m) { float* rowp = pq + (size_t)(row0 + ai * 128 + m * 16) * DM + col0;
#pragma unroll
                for (int bj = 0; bj < 2; ++bj)
#pragma unroll
                    for (int n = 0; n < 2; ++n) *(f32x4*)(rowp + bj * 128 + n * 16) = gv[bj][n] * acc[ai][bj][m][n]; }
    }
};
struct EpiBf {
    static constexpr bool PERM = true, AFTER_DRAIN = false;
    bf16_t* O; int ldc;
    __device__ __forceinline__ void operator()(const pg8::f32x4 (&acc)[2][2][4][2], const pg8::Unit& u, int wr, int wc, int fr, int fq) const {
        const int row0 = u.pm * 256 + wr * 64 + fr, col0 = u.pn * 256 + wc * 32 + 8 * fq;
#pragma unroll
        for (int ai = 0; ai < 2; ++ai)
#pragma unroll
            for (int m = 0; m < 4; ++m) { bf16_t* rowp = O + (size_t)(row0 + ai * 128 + m * 16) * ldc + col0;
#pragma unroll
                for (int bj = 0; bj < 2; ++bj) { const f32x4 v0 = acc[ai][bj][m][0], v1 = acc[ai][bj][m][1];
                    u32x4 w; w.x = cvtpk(v0[0], v0[1]); w.y = cvtpk(v0[2], v0[3]); w.z = cvtpk(v1[0], v1[1]); w.w = cvtpk(v1[2], v1[3]);
                    *(u32x4*)(rowp + bj * 128) = w; } }
    }
};
#define DPPF(oldv, src, CTRL) __builtin_bit_cast(float, __builtin_amdgcn_update_dpp(__builtin_bit_cast(int, (float)(oldv)), __builtin_bit_cast(int, (float)(src)), (CTRL), 0xF, 0xF, false))
#define DPPM(src, CTRL) __builtin_bit_cast(float, __builtin_amdgcn_mov_dpp(__builtin_bit_cast(int, (float)(src)), (CTRL), 0xF, 0xF, true))
#define DPP_SHR1 0x111
#define DPP_SHL1 0x101
#define DPP_ROR1 0x121
#define DPP_ROR15 0x12F
__device__ __forceinline__ int xi_idx(int wrx, int aix, int edge, int bj, int n, int wc, int fq) { return ((((((wrx * 2 + aix) * 2 + edge) * 2 + bj) * 4 + wc) * 2 + n) * 4 + fq) * 4; }
struct EpiUpConv {
    static constexpr bool PERM = true, AFTER_DRAIN = false;
    bf16_t* G; float* EA; float* EB; const float* cw; const float* cb; LAS float* xl;
    __device__ __forceinline__ void operator()(const pg8::f32x4 (&acc)[2][2][4][2], const pg8::Unit& u, int wr, int wc, int fr, int fq) const {
        const int j0 = u.pn * 128 + wc * 32 + 8 * fq;
#define XI(wrx, aix, edge, bj, n) xi_idx((wrx), (aix), (edge), (bj), (n), wc, fq)
#pragma unroll
        for (int ai = 0; ai < 2; ++ai)
#pragma unroll
            for (int bj = 0; bj < 2; ++bj)
#pragma unroll
                for (int n = 0; n < 2; ++n) {
                    if (fr == 0) *(LAS f32x4*)(xl + XI(wr, ai, 0, bj, n)) = acc[ai][bj][0][n];
                    if (fr == 15) *(LAS f32x4*)(xl + XI(wr, ai, 1, bj, n)) = acc[ai][bj][3][n];
                }
        if (wr == 0 && fr < 2) {
#pragma unroll
            for (int bj = 0; bj < 2; ++bj)
#pragma unroll
                for (int n = 0; n < 2; ++n) *(f32x4*)((bj ? EB : EA) + ((size_t)u.pm * 4 + fr) * DFF + j0 + 4 * n) = acc[0][bj][0][n];
        }
        if (wr == 1 && fr >= 14) {
#pragma unroll
            for (int bj = 0; bj < 2; ++bj)
#pragma unroll
                for (int n = 0; n < 2; ++n) *(f32x4*)((bj ? EB : EA) + ((size_t)u.pm * 4 + 2 + (fr - 14)) * DFF + j0 + 4 * n) = acc[1][bj][3][n];
        }
        asm volatile("s_waitcnt lgkmcnt(0)" ::: "memory"); __builtin_amdgcn_s_barrier(); __builtin_amdgcn_s_barrier(); asm volatile("" ::: "memory");
        const int pwr = wr ^ 1;
        const unsigned long long m15 = __ballot(fr == 15), m00 = __ballot(fr == 0);
        u32x2 keep[2][4];
#pragma unroll
        for (int n = 0; n < 2; ++n) {
            const float* wp = cw + j0 + 4 * n; const float* bp = cb + j0 + 4 * n;
            const f32x4 wa0 = *(const f32x4*)wp, wa1 = *(const f32x4*)(wp + NUP), wa2 = *(const f32x4*)(wp + 2 * NUP), ba = *(const f32x4*)bp;
            const f32x4 wb0 = *(const f32x4*)(wp + DFF), wb1 = *(const f32x4*)(wp + NUP + DFF), wb2 = *(const f32x4*)(wp + 2 * NUP + DFF), bb = *(const f32x4*)(bp + DFF);
#pragma unroll
            for (int ai = 0; ai < 2; ++ai) {
                const int pai = (wr == 1) ? ai : ai - 1, nai = (wr == 0) ? ai : ai + 1;
                const bool hasp = !(wr == 0 && ai == 0), hasn = !(wr == 1 && ai == 1);
                f32x4 pa = {0.f, 0.f, 0.f, 0.f}, pb = pa, na = pa, nb = pa;
                if (hasp) { pa = *(const LAS f32x4*)(xl + XI(pwr, pai, 1, 0, n)); pb = *(const LAS f32x4*)(xl + XI(pwr, pai, 1, 1, n)); }
                if (hasn) { na = *(const LAS f32x4*)(xl + XI(pwr, nai, 0, 0, n)); nb = *(const LAS f32x4*)(xl + XI(pwr, nai, 0, 1, n)); }
#pragma unroll
                for (int mm = 0; mm < 4; ++mm) {
                    f32x4 Av = wa1 * acc[ai][0][mm][n] + ba, Bv = wb1 * acc[ai][1][mm][n] + bb;
#pragma unroll
                    for (int e = 0; e < 4; ++e) {
                        const float ac = acc[ai][0][mm][n][e], bc = acc[ai][1][mm][n][e];
                        const float psa = (mm == 0) ? pa[e] : acc[ai][0][mm > 0 ? mm - 1 : 0][n][e], psb = (mm == 0) ? pb[e] : acc[ai][1][mm > 0 ? mm - 1 : 0][n][e];
                        const float nsa = (mm == 3) ? na[e] : acc[ai][0][mm < 3 ? mm + 1 : 3][n][e], nsb = (mm == 3) ? nb[e] : acc[ai][1][mm < 3 ? mm + 1 : 3][n][e];
                        float A = Av[e], B = Bv[e], t0, t1, t2, t3;
                        asm("v_cndmask_b32_e64 %2, %6, %7, %16\n\t"
                            "v_cndmask_b32_e64 %3, %6, %8, %17\n\t"
                            "v_cndmask_b32_e64 %4, %9, %10, %16\n\t"
                            "v_cndmask_b32_e64 %5, %9, %11, %17\n\t"
                            "v_fmac_f32_dpp %0, %2, %12 row_ror:1 row_mask:0xf bank_mask:0xf bound_ctrl:1\n\t"
                            "v_fmac_f32_dpp %0, %3, %13 row_ror:15 row_mask:0xf bank_mask:0xf bound_ctrl:1\n\t"
                            "v_fmac_f32_dpp %1, %4, %14 row_ror:1 row_mask:0xf bank_mask:0xf bound_ctrl:1\n\t"
                            "v_fmac_f32_dpp %1, %5, %15 row_ror:15 row_mask:0xf bank_mask:0xf bound_ctrl:1"
                            : "+v"(A), "+v"(B), "=&v"(t0), "=&v"(t1), "=&v"(t2), "=&v"(t3)
                            : "v"(ac), "v"(psa), "v"(nsa), "v"(bc), "v"(psb), "v"(nsb), "v"(wa0[e]), "v"(wa2[e]), "v"(wb0[e]), "v"(wb2[e]), "s"(m15), "s"(m00));
                        Av[e] = A; Bv[e] = B;
                    }
                    const f32x4 tv = Av * -1.44269504f;
                    f32x4 sv = {__builtin_amdgcn_exp2f(tv[0]), __builtin_amdgcn_exp2f(tv[1]), __builtin_amdgcn_exp2f(tv[2]), __builtin_amdgcn_exp2f(tv[3])};
                    sv = sv + 1.0f;
                    const f32x4 rv = {__builtin_amdgcn_rcpf(sv[0]), __builtin_amdgcn_rcpf(sv[1]), __builtin_amdgcn_rcpf(sv[2]), __builtin_amdgcn_rcpf(sv[3])};
                    const f32x4 g = (Av * Bv) * rv;
                    u32x2 w; w.x = cvtpk(g[0], g[1]); w.y = cvtpk(g[2], g[3]);
                    const int rt = ai * 128 + wr * 64 + mm * 16 + fr;
                    if (n == 0) keep[ai][mm] = w;
                    else if (rt != 0 && rt != 255) *(u32x4*)(G + (size_t)(u.pm * 256 + rt) * DFF + j0) = (u32x4){keep[ai][mm].x, keep[ai][mm].y, w.x, w.y};
                }
            }
        }
#undef XI
    }
};
__device__ __forceinline__ void phase_ffn_fix(bf16_t* G, const float* EA, const float* EB, const float* cw, const float* cb, int ntiles, int tid) {
    const int total = ntiles * 2 * (DFF / 4);
    for (int e = blockIdx.x * NTHREADS + tid; e < total; e += gridDim.x * NTHREADS) {
        const int j = (e % (DFF / 4)) * 4, which = (e / (DFF / 4)) & 1, pm = e / (2 * (DFF / 4));
        const int T = pm < MX / 256 ? SEQ : CTXL; const int t0 = pm < MX / 256 ? (pm * 256) & (SEQ - 1) : 0;
        const bool hasp = which == 0 ? (t0 != 0) : true, hasn = which == 0 ? true : (t0 + 256 != T);
        const size_t ip = which == 0 ? ((size_t)(pm - 1) * 4 + 3) : ((size_t)pm * 4 + 2), ic = (size_t)pm * 4 + (which == 0 ? 0 : 3), in_ = which == 0 ? ((size_t)pm * 4 + 1) : ((size_t)(pm + 1) * 4 + 0);
        const f32x4 z = {0.f, 0.f, 0.f, 0.f};
        const f32x4 ap = hasp ? *(const f32x4*)(EA + ip * DFF + j) : z, ac = *(const f32x4*)(EA + ic * DFF + j), an = hasn ? *(const f32x4*)(EA + in_ * DFF + j) : z;
        const f32x4 bp = hasp ? *(const f32x4*)(EB + ip * DFF + j) : z, bc = *(const f32x4*)(EB + ic * DFF + j), bn = hasn ? *(const f32x4*)(EB + in_ * DFF + j) : z;
        const f32x4 wa0 = *(const f32x4*)(cw + j), wa1 = *(const f32x4*)(cw + NUP + j), wa2 = *(const f32x4*)(cw + 2 * NUP + j), ba = *(const f32x4*)(cb + j);
        const f32x4 wb0 = *(const f32x4*)(cw + DFF + j), wb1 = *(const f32x4*)(cw + NUP + DFF + j), wb2 = *(const f32x4*)(cw + 2 * NUP + DFF + j), bb = *(const f32x4*)(cb + DFF + j);
        float g[4];
#pragma unroll
        for (int c = 0; c < 4; ++c) { const float A = fmaf(wa2[c], an[c], fmaf(wa1[c], ac[c], fmaf(wa0[c], ap[c], ba[c]))), B = fmaf(wb2[c], bn[c], fmaf(wb1[c], bc[c], fmaf(wb0[c], bp[c], bb[c]))); g[c] = silu_f(A) * B; }
        u32x2 w; w.x = cvtpk(g[0], g[1]); w.y = cvtpk(g[2], g[3]);
        *(u32x2*)(G + (size_t)(pm * 256 + (which == 0 ? 0 : 255)) * DFF + j) = w;
    }
}
struct EpiQKV {
    static constexpr bool PERM = true, AFTER_DRAIN = false;
    bf16_t* O; const float* rc; const float* rs;
    __device__ __forceinline__ void operator()(const pg8::f32x4 (&acc)[2][2][4][2], const pg8::Unit& u, int wr, int wc, int fr, int fq) const {
        const int row0 = u.pm * 256 + wr * 64 + fr, col0 = u.pn * 256 + wc * 32 + 8 * fq;
        const bool rope = (u.pm < MX / 256) && (u.pn < 10);
        const int jj0 = 16 * wc + 4 * fq;
#pragma unroll
        for (int ai = 0; ai < 2; ++ai)
#pragma unroll
            for (int m = 0; m < 4; ++m) { const int row = row0 + ai * 128 + m * 16; bf16_t* rowp = O + (size_t)row * NQKV + col0;
                f32x4 cv = {1.f, 1.f, 1.f, 1.f}, sv = {0.f, 0.f, 0.f, 0.f};
                if (rope) { const int t = row & (SEQ - 1); cv = *(const f32x4*)(rc + t * 64 + jj0); sv = *(const f32x4*)(rs + t * 64 + jj0); }
#pragma unroll
                for (int bj = 0; bj < 2; ++bj) { const f32x4 v0 = acc[ai][bj][m][0], v1 = acc[ai][bj][m][1];
                    u32x4 w;
                    w.x = cvtpk(v0[0] * cv[0] - v0[1] * sv[0], v0[1] * cv[0] + v0[0] * sv[0]);
                    w.y = cvtpk(v0[2] * cv[1] - v0[3] * sv[1], v0[3] * cv[1] + v0[2] * sv[1]);
                    w.z = cvtpk(v1[0] * cv[2] - v1[1] * sv[2], v1[1] * cv[2] + v1[0] * sv[2]);
                    w.w = cvtpk(v1[2] * cv[3] - v1[3] * sv[3], v1[3] * cv[3] + v1[2] * sv[3]);
                    *(u32x4*)(rowp + bj * 128) = w; } }
    }
};
struct EpiMI {
    static constexpr bool PERM = true, AFTER_DRAIN = false;
    bf16_t* Z; float* G; const float* bias;
    __device__ __forceinline__ void operator()(const pg8::f32x4 (&acc)[2][2][4][2], const pg8::Unit& u, int wr, int wc, int fr, int fq) const {
        const int row0 = u.pm * 256 + wr * 64 + fr;
        if (u.pn < 24) {
            const int col0 = u.pn * 256 + wc * 32 + 8 * fq;
            const float sc = (u.pn >= 4 && u.pn < 8) ? 0.08838834764831845f : 1.0f;
            f32x4 bv[2][2];
#pragma unroll
            for (int bj = 0; bj < 2; ++bj)
#pragma unroll
                for (int n = 0; n < 2; ++n) bv[bj][n] = *(const f32x4*)(bias + col0 + bj * 128 + 4 * n);
#pragma unroll
            for (int ai = 0; ai < 2; ++ai)
#pragma unroll
                for (int m = 0; m < 4; ++m) { bf16_t* rowp = Z + (size_t)(row0 + ai * 128 + m * 16) * NMI + col0;
#pragma unroll
                    for (int bj = 0; bj < 2; ++bj) { const f32x4 v0 = (acc[ai][bj][m][0] + bv[bj][0]) * sc, v1 = (acc[ai][bj][m][1] + bv[bj][1]) * sc;
                        u32x4 w; w.x = cvtpk(v0[0], v0[1]); w.y = cvtpk(v0[2], v0[3]); w.z = cvtpk(v1[0], v1[1]); w.w = cvtpk(v1[2], v1[3]);
                        *(u32x4*)(rowp + bj * 128) = w; } }
        } else if (wc == 0) {
            const f32x4 b0 = *(const f32x4*)(bias + NMI + 8 * fq), b1 = *(const f32x4*)(bias + NMI + 8 * fq + 4);
#pragma unroll
            for (int ai = 0; ai < 2; ++ai)
#pragma unroll
                for (int m = 0; m < 4; ++m) { float* gp = G + (size_t)(row0 + ai * 128 + m * 16) * 32 + 8 * fq;
                    f32x4 v0 = acc[ai][0][m][0] + b0, v1 = acc[ai][0][m][1] + b1;
                    if (fq & 1) {
#pragma unroll
                        for (int e = 0; e < 4; ++e) { v0[e] = log_sigmoid_f(v0[e]); v1[e] = log_sigmoid_f(v1[e]); } }
                    *(f32x4*)gp = v0; *(f32x4*)(gp + 4) = v1; }
        }
    }
};

namespace att {
constexpr int D = 128, KVBLK = 64, LDQ = NQKV;
constexpr float SCALE = 0.088388347648318440f;
constexpr float THR = 8.f;
#ifndef ATT_SDEPTH
#define ATT_SDEPTH 1
#endif
constexpr int SDEPTH = ATT_SDEPTH;
constexpr size_t SHM_V = KVBLK * D * 2, SHM_K = KVBLK * D * 2, SHM_ATTN = 2 * SHM_V + 2 * SHM_K + NWAVES * 64 * 4;
#define KSWZ(row, colB) ((row) * 256 + ((colB) ^ (((row) & 7) << 4)))
#define SBAR() __builtin_amdgcn_sched_barrier(0)
__device__ __forceinline__ int crow(int r, int hi) { return (r & 3) + 8 * (r >> 2) + 4 * hi; }
__device__ __forceinline__ void partialSM(f32x16& p0, f32x16& p1, float& m_reg, float& mn, float& alpha, bool masked, int dpos, int hi) {
  constexpr float C = SCALE * 1.4426950408889634f;
  if (masked) {
    const unsigned ub = (unsigned)(dpos + 4 * hi + 128);
#pragma unroll
    for (int r = 0; r < 16; ++r) { const unsigned kc = (unsigned)((r & 3) + 8 * (r >> 2));
      if (ub + kc > 256u) p0[r] = -1e30f;
      if (ub + kc + 32u > 256u) p1[r] = -1e30f; }
  }
  float pmax = p0[0];
#pragma unroll
  for (int r = 1; r < 16; ++r) pmax = fmaxf(pmax, p0[r]);
#pragma unroll
  for (int r = 0; r < 16; ++r) pmax = fmaxf(pmax, p1[r]);
  { auto rr = __builtin_amdgcn_permlane32_swap(__float_as_uint(pmax), __float_as_uint(pmax), false, false);
    pmax = fmaxf(__uint_as_float(rr[0]), __uint_as_float(rr[1])); }
  if (__builtin_expect(__all(pmax - m_reg <= THR / SCALE), 1)) { mn = m_reg; alpha = 1.f; }
  else { mn = fmaxf(m_reg, pmax); alpha = __builtin_amdgcn_exp2f((m_reg - mn) * C); m_reg = mn; }
  const float mnC = -mn * C;
#pragma unroll
  for (int r = 0; r < 16; ++r) p0[r] = fmaf(p0[r], C, mnC);
#pragma unroll
  for (int r = 0; r < 16; ++r) p1[r] = fmaf(p1[r], C, mnC);
#pragma unroll
  for (int r = 0; r < 16; ++r) p0[r] = __builtin_amdgcn_exp2f(p0[r]);
}
__device__ __forceinline__ void finishSM(f32x16& p0, f32x16& p1, float alpha, float& l_reg, bf16x8& pa0, bf16x8& pa1, bf16x8& pa2, bf16x8& pa3) {
#pragma unroll
  for (int r = 0; r < 16; ++r) p1[r] = __builtin_amdgcn_exp2f(p1[r]);
  float ps = 0;
#pragma unroll
  for (int r = 0; r < 16; ++r) ps += p0[r];
#pragma unroll
  for (int r = 0; r < 16; ++r) ps += p1[r];
  { auto rr = __builtin_amdgcn_permlane32_swap(__float_as_uint(ps), __float_as_uint(ps), false, false);
    ps = __uint_as_float(rr[0]) + __uint_as_float(rr[1]); }
  l_reg = l_reg * alpha + ps;
#define PK4(P, BASE, OUT) do { unsigned a0 = cvtpk(P[BASE + 0], P[BASE + 1]), a1 = cvtpk(P[BASE + 2], P[BASE + 3]);   \
    unsigned b0 = cvtpk(P[BASE + 4], P[BASE + 5]), b1 = cvtpk(P[BASE + 6], P[BASE + 7]);                              \
    auto r0 = __builtin_amdgcn_permlane32_swap(a0, b0, false, false); auto r1 = __builtin_amdgcn_permlane32_swap(a1, b1, false, false); \
    u32x4 w = {r0[0], r1[0], r0[1], r1[1]}; OUT = *reinterpret_cast<bf16x8*>(&w); } while (0)
  PK4(p0, 0, pa0); PK4(p0, 8, pa1); PK4(p1, 0, pa2); PK4(p1, 8, pa3);
#undef PK4
}
__device__ __forceinline__ void qkt(f32x16& p0, f32x16& p1, const char* Ks, const bf16x8* qr, int r32, int hi) {
  p0 = f32x16{}; p1 = f32x16{};
#pragma unroll
  for (int d0 = 0; d0 < 8; ++d0) { const int cb = (d0 * 16 + hi * 8) * 2;
    const bf16x8 b0 = *reinterpret_cast<const bf16x8*>(Ks + KSWZ(r32, cb));
    const bf16x8 b1 = *reinterpret_cast<const bf16x8*>(Ks + KSWZ(32 + r32, cb));
    p0 = __builtin_amdgcn_mfma_f32_32x32x16_bf16(b0, qr[d0], p0, 0, 0, 0);
    p1 = __builtin_amdgcn_mfma_f32_32x32x16_bf16(b1, qr[d0], p1, 0, 0, 0); }
}
__device__ __forceinline__ int v_st(int k, int c) { const int kk = (k & ~0xC) | ((k & 4) << 1) | ((k & 8) >> 1); return ((kk >> 3) * 4 + (c >> 5)) * 512 + ((kk & 7) * 32 + (c & 31)) * 2; }
__device__ __forceinline__ int v_rd_base(int lane) { return ((lane & 3) << 3) | (((lane >> 2) & 3) << 6) | (((lane >> 4) & 1) << 5) | (((lane >> 5) & 1) << 8); }
constexpr int v_rd_off(int d0, int ks, int half) { return d0 * 512 + ks * 4096 + half * 2048; }
template <int OFF> __device__ __forceinline__ s16x4 tr_read(int vb) {
  s16x4 r; asm volatile("ds_read_b64_tr_b16 %0, %1 offset:%2" : "=&v"(r) : "v"(vb), "i"(OFF) : "memory"); return r;
}
template <int D0> __device__ __forceinline__ void pv_one(f32x16& od, int vb, bf16x8 pa0, bf16x8 pa1, bf16x8 pa2, bf16x8 pa3) {
  const s16x4 l0 = tr_read<v_rd_off(D0, 0, 0)>(vb), h0 = tr_read<v_rd_off(D0, 0, 1)>(vb), l1 = tr_read<v_rd_off(D0, 1, 0)>(vb), h1 = tr_read<v_rd_off(D0, 1, 1)>(vb);
  const s16x4 l2 = tr_read<v_rd_off(D0, 2, 0)>(vb), h2 = tr_read<v_rd_off(D0, 2, 1)>(vb), l3 = tr_read<v_rd_off(D0, 3, 0)>(vb), h3 = tr_read<v_rd_off(D0, 3, 1)>(vb);
  asm volatile("s_waitcnt lgkmcnt(0)" ::: "memory"); SBAR();
#define PK(L, H) (bf16x8){L[0], L[1], L[2], L[3], H[0], H[1], H[2], H[3]}
  od = __builtin_amdgcn_mfma_f32_32x32x16_bf16(pa0, PK(l0, h0), od, 0, 0, 0);
  od = __builtin_amdgcn_mfma_f32_32x32x16_bf16(pa1, PK(l1, h1), od, 0, 0, 0);
  od = __builtin_amdgcn_mfma_f32_32x32x16_bf16(pa2, PK(l2, h2), od, 0, 0, 0);
  od = __builtin_amdgcn_mfma_f32_32x32x16_bf16(pa3, PK(l3, h3), od, 0, 0, 0);
#undef PK
}
__device__ __forceinline__ void pv_d0(f32x16* o, int vb, bf16x8 pa0, bf16x8 pa1, bf16x8 pa2, bf16x8 pa3) {
  pv_one<0>(o[0], vb, pa0, pa1, pa2, pa3); pv_one<1>(o[1], vb, pa0, pa1, pa2, pa3); pv_one<2>(o[2], vb, pa0, pa1, pa2, pa3); pv_one<3>(o[3], vb, pa0, pa1, pa2, pa3);
}

__device__ __forceinline__ void attn_unit(const bf16_t* __restrict__ Z, bf16_t* __restrict__ O, int qrow0, int head0, int kvh, int ctxrow0, int winrow0, int NT, int dq0, const float* __restrict__ sinkp, char* lds) {
  int tid_l = threadIdx.x; asm volatile("" : "+v"(tid_l));
  const int tid = tid_l, wid = tid >> 6, lane = tid & 63, r32 = lane & 31, hi = lane >> 5;
  char* V_lds = lds; char* K_lds = lds + 2 * SHM_V;
  float* wsl = (float*)(lds + 2 * SHM_V + 2 * SHM_K) + wid * 64; float* li_l = wsl; float* al_l = wsl + 32;
  float m_reg = -1e30f, l_reg = 0; f32x16 o[4] = {}; bf16x8 qr[8];
  const int head = head0 + (wid >> 2), qloc = (wid & 3) * 32 + r32;
  const bf16_t* Qw = Z + (size_t)(qrow0 + qloc) * LDQ + head * D + hi * 8;
#pragma unroll
  for (int d0 = 0; d0 < 8; ++d0) qr[d0] = *reinterpret_cast<const bf16x8*>(Qw + d0 * 16);
  const int sr = tid >> 4, sc = (tid & 15) * 8, vst0 = v_st(sr, sc), vst1 = v_st(32 + sr, sc);
  const int vb0 = (int)(uintptr_t)V_lds + v_rd_base(lane);
  const bf16_t* Kc = Z + 2048 + kvh * D + sc; const bf16_t* Vc = Z + 2560 + kvh * D + sc;
  const int dlane = dq0 - qloc;
  struct { bf16x8 vs0, vs1, ks0, ks1; } sr_[SDEPTH];
#define TROW(jt) ((jt) < 4 ? ctxrow0 + (jt) * 64 : winrow0 + ((jt) - 4) * 64)
#define SLOAD(i, jt) do { const size_t rb0_ = (size_t)(TROW(jt) + sr) * LDQ, rb1_ = rb0_ + (size_t)32 * LDQ; \
    sr_[i].vs0 = *reinterpret_cast<const bf16x8*>(Vc + rb0_); sr_[i].vs1 = *reinterpret_cast<const bf16x8*>(Vc + rb1_); \
    sr_[i].ks0 = *reinterpret_cast<const bf16x8*>(Kc + rb0_); sr_[i].ks1 = *reinterpret_cast<const bf16x8*>(Kc + rb1_); } while (0)
#define SWRITE(b, i) do { *(bf16x8*)(V_lds + (b) * SHM_V + vst0) = sr_[i].vs0;          \
    *(bf16x8*)(V_lds + (b) * SHM_V + vst1) = sr_[i].vs1; const int kc_ = sc * 2;               \
    *(bf16x8*)(K_lds + (b) * SHM_K + KSWZ(sr, kc_)) = sr_[i].ks0;                       \
    *(bf16x8*)(K_lds + (b) * SHM_K + KSWZ(32 + sr, kc_)) = sr_[i].ks1; } while (0)
#define SWAIT() do { if constexpr (SDEPTH == 2) asm volatile("s_waitcnt vmcnt(4)" ::: "memory"); else asm volatile("s_waitcnt vmcnt(0)" ::: "memory"); } while (0)
#define RESC(a) do { if (__any((a) < 1.f)) { if (hi == 0) al_l[r32] = (a); asm volatile("s_waitcnt lgkmcnt(0)" ::: "memory"); \
    _Pragma("unroll") for (int d = 0; d < 4; ++d) _Pragma("unroll") for (int r = 0; r < 16; ++r) o[d][r] *= al_l[crow(r, hi)]; } } while (0)
#define MSK(jt) ((jt) >= 4), (dlane + ((jt) - 4) * 64)
  f32x16 pA0, pA1, pB0, pB1; float mnA, mnB, alA, alB; bf16x8 pa0, pa1, pa2, pa3;
  constexpr int SE = 0, SO = SDEPTH - 1;
  SLOAD(SE, 0); asm volatile("s_waitcnt vmcnt(0)" ::: "memory"); SWRITE(0, SE); __syncthreads();
  qkt(pA0, pA1, K_lds, qr, r32, hi); partialSM(pA0, pA1, m_reg, mnA, alA, MSK(0), hi);
  SLOAD(SO, 1); if constexpr (SDEPTH == 2) { if (2 < NT) SLOAD(SE, 2); }
  SWAIT(); SWRITE(1, SO); __syncthreads();
  for (int j = 1; j + 1 < NT; j += 2) {
    SBAR(); qkt(pB0, pB1, K_lds + SHM_K, qr, r32, hi);
    finishSM(pA0, pA1, alA, l_reg, pa0, pa1, pa2, pa3); SBAR();
    SLOAD(SO, j + SDEPTH); SBAR();
    pv_d0(o, vb0, pa0, pa1, pa2, pa3); partialSM(pB0, pB1, m_reg, mnB, alB, MSK(j), hi);
    __syncthreads(); SWAIT(); SWRITE(0, SE);
    RESC(alB); __syncthreads();
    SBAR(); qkt(pA0, pA1, K_lds, qr, r32, hi);
    finishSM(pB0, pB1, alB, l_reg, pa0, pa1, pa2, pa3); SBAR();
    if (SDEPTH == 1 || j + 3 < NT) SLOAD(SE, j + 1 + SDEPTH);
    SBAR();
    pv_d0(o, vb0 + (int)SHM_V, pa0, pa1, pa2, pa3); partialSM(pA0, pA1, m_reg, mnA, alA, MSK(j + 1), hi);
    __syncthreads(); SWAIT(); SWRITE(1, SO);
    RESC(alA); __syncthreads();
  }
  SBAR(); qkt(pB0, pB1, K_lds + SHM_K, qr, r32, hi);
  finishSM(pA0, pA1, alA, l_reg, pa0, pa1, pa2, pa3); SBAR();
  pv_d0(o, vb0, pa0, pa1, pa2, pa3); partialSM(pB0, pB1, m_reg, mnB, alB, MSK(NT - 1), hi);
  __syncthreads(); RESC(alB);
  finishSM(pB0, pB1, alB, l_reg, pa0, pa1, pa2, pa3); SBAR();
  pv_d0(o, vb0 + (int)SHM_V, pa0, pa1, pa2, pa3);
  { constexpr float C = SCALE * 1.4426950408889634f; l_reg += __builtin_amdgcn_exp2f(sinkp[wid >> 2] * 1.4426950408889634f - m_reg * C); }
  if (hi == 0) li_l[r32] = l_reg; asm volatile("s_waitcnt lgkmcnt(0)" ::: "memory");
  float rli[16];
#pragma unroll
  for (int r = 0; r < 16; ++r) rli[r] = __builtin_amdgcn_rcpf(li_l[crow(r, hi)]);
  bf16_t* Ow = O + (size_t)(qrow0 + (wid & 3) * 32) * DM + head * D;
#pragma unroll
  for (int r = 0; r < 16; ++r) { const int orow = crow(r, hi);
#pragma unroll
    for (int d0 = 0; d0 < 4; ++d0) { const float v = o[d0][r] * rli[r]; Ow[(size_t)orow * DM + d0 * 32 + r32] = (bf16_t)(cvtpk(v, v) & 0xffffu); } }
#undef TROW
#undef SLOAD
#undef SWRITE
#undef SWAIT
#undef RESC
#undef MSK
}
}

__device__ __forceinline__ void phase_attn(const bf16_t* Z, bf16_t* O, const float* sink, char* lds) {
    constexpr int NU_X = 2048, NU = NU_X + 128;
    for (int u = blockIdx.x; u < NU; u += gridDim.x) {
        if (u < NU_X) {
            const int xw = u & 7, sw = (u >> 3) & 31, b = u >> 8;
            const int kvh = xw >> 1, qb = 16 * (xw & 1) + (sw >> 1), hp = sw & 1;
            const int lo = qb > 0 ? (qb - 1) * 128 : 0, hi = qb < 31 ? (qb + 2) * 128 : SEQ;
            att::attn_unit(Z, O, b * SEQ + qb * 128, kvh * 4 + hp * 2, kvh, MX + b * CTXL, b * SEQ + lo, 4 + (hi - lo) / 64, lo - qb * 128, sink + kvh * 4 + hp * 2, lds);
        } else {
            const int v = u - NU_X; const int hp = v & 1, cqb = (v >> 1) & 1, kvh = (v >> 2) & 3, b = v >> 4;
            att::attn_unit(Z, O, MX + b * CTXL + cqb * 128, kvh * 4 + hp * 2, kvh, MX + b * CTXL, 0, 4, 0, sink + kvh * 4 + hp * 2, lds);
        }
        __syncthreads();
    }
}

__device__ __forceinline__ int scan_row(int b, int dir, int s) {
    if (dir == 0) return s < CTXL ? MX + b * CTXL + s : b * SEQ + (s - CTXL);
    return s < CTXL ? MX + b * CTXL + (CTXL - 1 - s) : b * SEQ + (SEQ - 1 - (s - CTXL));
}
namespace ms {
typedef __bf16 bf16x8v __attribute__((ext_vector_type(8)));
typedef __bf16 bf16x4v __attribute__((ext_vector_type(4)));
constexpr int QOFF = 0, KOFF = 16384, VOFF = 32768, BUFB = 49152;
constexpr int NOFF = 2 * BUFB;
constexpr int WPOFF = NOFF + 1024;
constexpr int NCHUNK = (CTXL + SEQ) / 64;
__host__ __device__ __forceinline__ unsigned off_b(unsigned row, unsigned ch) { return 256u * row + 16u * (ch ^ (((row & 3) << 2) | ((row >> 2) & 3))); }
__host__ __device__ __forceinline__ unsigned tr_addr_nat(unsigned lane, unsigned c, unsigned ks, unsigned t) {
    const unsigned h = lane >> 5, blk = (lane >> 4) & 1, q = (lane & 15) >> 2, p = lane & 3;
    return off_b(16 * ks + 8 * h + 4 * t + q, 4 * c + 2 * blk + (p >> 1)) + 8 * (p & 1);
}
__host__ __device__ __forceinline__ unsigned tr_addr_perm(unsigned lane, unsigned c, unsigned ks, unsigned t) {
    const unsigned h = lane >> 5, blk = (lane >> 4) & 1, q = (lane & 15) >> 2, p = lane & 3;
    return off_b(16 * ks + 8 * t + 4 * h + q, 4 * c + 2 * blk + (p >> 1)) + 8 * (p & 1);
}
template <int OFF> __device__ __forceinline__ s16x4 trr(unsigned addr) { s16x4 r; asm volatile("ds_read_b64_tr_b16 %0, %1 offset:%2" : "=v"(r) : "v"(addr), "i"(OFF) : "memory"); return r; }
__host__ __device__ __forceinline__ unsigned xr16(unsigned r) { return ((r & 3) << 2) | ((r >> 2) & 3); }
#define MS_LWAIT() do { asm volatile("s_waitcnt lgkmcnt(0)" ::: "memory"); __builtin_amdgcn_sched_barrier(0); } while (0)
__device__ __forceinline__ int crow(int r, int hi) { return (r & 3) + 8 * (r >> 2) + 4 * hi; }
__device__ __forceinline__ bf16x8 pack8(const f32x16& x, int s) {
    const f32x8 v = {x[8 * s + 0], x[8 * s + 1], x[8 * s + 2], x[8 * s + 3], x[8 * s + 4], x[8 * s + 5], x[8 * s + 6], x[8 * s + 7]};
    return __builtin_bit_cast(bf16x8, __builtin_convertvector(v, bf16x8v));
}
__device__ __forceinline__ float scan_incl_add(float x, int lane) {
#pragma unroll
    for (int o = 1; o < 64; o <<= 1) { const float v = __shfl_up(x, o); if (lane >= o) x += v; }
    return x;
}
__device__ __forceinline__ float scan_incl_max(float x, int lane) {
#pragma unroll
    for (int o = 1; o < 64; o <<= 1) { const float v = __shfl_up(x, o); if (lane >= o) x = fmaxf(x, v); }
    return x;
}
}

__device__ __forceinline__ void phase_scan2(const bf16_t* Z, const float* GATE, bf16_t* HF, bf16_t* HB, bool need_ctx_out, LAS unsigned char* lds, int tid, int lane, int wave) {
    using namespace ms;
    const int cb = wave & 3, th = wave >> 2, r = lane & 31, h = lane >> 5;
    LAS float* wp = (LAS float*)(lds + WPOFF + wave * 2048);
    LAS float* colf_l = wp; LAS float* wg_l = wp + 64; LAS float* ein_l = wp + 128; LAS float* rden_l = wp + 192;
    for (int task = blockIdx.x; task < 256; task += gridDim.x) {
        const int dvh = task & 1, dir = (task >> 1) & 1, hd = (task >> 2) & 7, b = task >> 5;
        bf16_t* HO = dir == 0 ? HF : HB;
        const int ocol = hd * 256 + dvh * 128 + cb * 32 + r;
        const int d_rl = lane >> 4, d_ch = (lane & 15) ^ ((d_rl << 2) | (wave & 3));
        const int d_col0 = hd * 128 + d_ch * 8, d_col1 = 1024 + hd * 128 + d_ch * 8, d_col2 = 2048 + hd * 256 + dvh * 128 + d_ch * 8;
        float g_ig, g_lf;
#define MS_DMA(c_, buf_) do { _Pragma("unroll") for (int i_ = 0; i_ < 6; ++i_) { const int rg_ = 8 * (i_ & 1) + wave; const int row_ = scan_row(b, dir, (c_) * 64 + 4 * rg_ + d_rl); \
            const int col_ = (i_ >> 1) == 0 ? d_col0 : ((i_ >> 1) == 1 ? d_col1 : d_col2); \
            __builtin_amdgcn_global_load_lds((const unsigned*)(Z + (size_t)row_ * NMI + col_), (LAS unsigned*)(lds + (buf_) * BUFB + (i_ >> 1) * 16384 + 1024 * rg_), 16, 0, 0); } \
            { const int row_ = scan_row(b, dir, (c_) * 64 + lane); g_ig = GATE[(size_t)row_ * 32 + (dir * 2) * 8 + hd]; g_lf = GATE[(size_t)row_ * 32 + (dir * 2 + 1) * 8 + hd]; } } while (0)
        f32x16 C[4];
#pragma unroll
        for (int ti = 0; ti < 4; ++ti)
#pragma unroll
            for (int i = 0; i < 16; ++i) C[ti][i] = 0.f;
        float m_prev = 0.f;
        __syncthreads();
        MS_DMA(0, 0);
        if (tid < 128) ((LAS float*)(lds + NOFF))[tid] = 0.f;
        float c_ig = g_ig, c_lf = g_lf;
        asm volatile("s_waitcnt vmcnt(0)" ::: "memory");
        __syncthreads();
        for (int c = 0; c < NCHUNK; ++c) {
            const int cur = c & 1;
            int lane_l = lane; asm volatile("" : "+v"(lane_l));
            const unsigned ul = (unsigned)lane_l, uh = ul >> 5, ublk = (ul >> 4) & 1, uq = (ul & 15) >> 2, up = ul & 3, ur = ul & 31;
            const unsigned cbase = (unsigned)(cur * BUFB);
            const unsigned a_nat = cbase + 256u * (8u * uh + uq) + ((64u * uq) | (32u * (ublk ^ uh)) | (16u * (up >> 1))) + 8u * (up & 1);
            const unsigned a_perm = cbase + 256u * (4u * uh + uq) + ((64u * uq) | (32u * ublk) | (16u * ((up >> 1) ^ uh))) + 8u * (up & 1);
            const unsigned a_row = cbase + 256u * ur + ((16u * xr16(ur)) ^ (16u * uh));
            const unsigned a_q64 = cbase + 256u * ur + 16u * xr16(ur) + 8u * uh + 8192u * (unsigned)th;
            const unsigned a_qn = cbase + 256u * ur + ((16u * xr16(ur)) ^ (128u * uh)) + 8192u * (unsigned)th;
            const LAS float* ncur = (const LAS float*)(lds + NOFF + cur * 512); LAS float* nnxt = (LAS float*)(lds + NOFF + (cur ^ 1) * 512);
            if (c + 1 < NCHUNK) MS_DMA(c + 1, cur ^ 1);
            const float bsum = scan_incl_add(c_lf, lane);
            const float av = c_ig - bsum;
            const float pm = scan_incl_max(av, lane);
            const float mm = fmaxf(m_prev, pm);
            const float ein = __expf(m_prev - mm), eneg = __expf(-(bsum + mm));
            const float b_end = __shfl(bsum, 63), mm_end = __shfl(mm, 63);
            const float e_prev = __expf(m_prev - mm_end);
            colf_l[lane] = av; wg_l[lane] = __expf(av - mm_end); ein_l[lane] = ein;
            const float rowf_r = -__shfl(mm, 32 * th + r), ein_r = __shfl(ein, 32 * th + r), eneg_r = __shfl(eneg, 32 * th + r);
            m_prev = b_end + mm_end;
            f32x16 X0, X1;
#pragma unroll
            for (int i = 0; i < 16; ++i) { X0[i] = 0.f; X1[i] = 0.f; }
#pragma unroll
            for (int ks = 0; ks < 8; ++ks) {
                const unsigned ar = a_row ^ (32u * ks);
                const bf16x8 qf = *(const LAS bf16x8*)(lds + ar + QOFF + 8192 * th);
                const bf16x8 k0 = *(const LAS bf16x8*)(lds + ar + KOFF);
                X0 = __builtin_amdgcn_mfma_f32_32x32x16_bf16(k0, qf, X0, 0, 0, 0);
                if (th == 1) { const bf16x8 k1 = *(const LAS bf16x8*)(lds + ar + KOFF + 8192); X1 = __builtin_amdgcn_mfma_f32_32x32x16_bf16(k1, qf, X1, 0, 0, 0); }
            }
            float qn = 0.f;
#pragma unroll
            for (int cc = 0; cc < 8; ++cc) { const u32x4 qv = *(const LAS u32x4*)(lds + (a_qn ^ (16u * cc)) + QOFF);
                const f32x4 n0 = *(const LAS f32x4*)(ncur + 64 * h + 8 * cc), n1 = *(const LAS f32x4*)(ncur + 64 * h + 8 * cc + 4);
                qn += bflo(qv.x) * n0[0] + bfhi(qv.x) * n0[1] + bflo(qv.y) * n0[2] + bfhi(qv.y) * n0[3] + bflo(qv.z) * n1[0] + bfhi(qv.z) * n1[1] + bflo(qv.w) * n1[2] + bfhi(qv.w) * n1[3]; }
            qn += __shfl_xor(qn, 32);
            float rsum = 0.f;
            if (th == 0) {
#pragma unroll
                for (int g4 = 0; g4 < 4; ++g4) { const f32x4 cf0 = *(const LAS f32x4*)(colf_l + 8 * g4 + 4 * h);
#pragma unroll
                    for (int e = 0; e < 4; ++e) { const int i = 4 * g4 + e; const int srow_ = 8 * g4 + 4 * h + e;
                        const float w = (srow_ <= r) ? __expf(rowf_r + cf0[e]) : 0.f; X0[i] *= w; rsum += X0[i]; } }
            } else {
#pragma unroll
                for (int g4 = 0; g4 < 4; ++g4) { const f32x4 cf0 = *(const LAS f32x4*)(colf_l + 8 * g4 + 4 * h), cf1 = *(const LAS f32x4*)(colf_l + 32 + 8 * g4 + 4 * h);
#pragma unroll
                    for (int e = 0; e < 4; ++e) { const int i = 4 * g4 + e; const int srow_ = 8 * g4 + 4 * h + e;
                        const float w0 = __expf(rowf_r + cf0[e]); X0[i] *= w0; rsum += X0[i];
                        const float w1 = (srow_ <= r) ? __expf(rowf_r + cf1[e]) : 0.f; X1[i] *= w1; rsum += X1[i]; } }
            }
            rsum += __shfl_xor(rsum, 32);
            { const float den = ein_r * qn + rsum; const float rd = 1.0f / fmaxf(fabsf(den), eneg_r); if (h == 0) rden_l[r] = rd; }
            f32x16 hacc;
#pragma unroll
            for (int i = 0; i < 16; ++i) hacc[i] = 0.f;
#pragma unroll
            for (int ti = 0; ti < 4; ++ti)
#pragma unroll
                for (int ks2 = 0; ks2 < 2; ++ks2) {
                    const s16x4 qa = *(const LAS s16x4*)(lds + (a_q64 ^ (16u * (4 * ti + 2 * ks2 + 0))) + QOFF);
                    const s16x4 qb = *(const LAS s16x4*)(lds + (a_q64 ^ (16u * (4 * ti + 2 * ks2 + 1))) + QOFF);
                    const bf16x8 af = {qa[0], qa[1], qa[2], qa[3], qb[0], qb[1], qb[2], qb[3]};
                    hacc = __builtin_amdgcn_mfma_f32_32x32x16_bf16(af, pack8(C[ti], ks2), hacc, 0, 0, 0);
                }
#pragma unroll
            for (int g4 = 0; g4 < 4; ++g4) { const f32x4 ev = *(const LAS f32x4*)(ein_l + 32 * th + 8 * g4 + 4 * h);
#pragma unroll
                for (int e = 0; e < 4; ++e) hacc[4 * g4 + e] *= ev[e]; }
            {
                const unsigned vb = (unsigned)(uintptr_t)lds + (a_perm ^ (64u * (unsigned)cb));
                const unsigned vb1 = vb ^ 32u;
                const s16x4 l00 = trr<VOFF + 256 * 0>(vb), h00 = trr<VOFF + 256 * 8>(vb1), l01 = trr<VOFF + 256 * 16>(vb), h01 = trr<VOFF + 256 * 24>(vb1);
                MS_LWAIT();
                hacc = __builtin_amdgcn_mfma_f32_32x32x16_bf16(pack8(X0, 0), (bf16x8){l00[0], l00[1], l00[2], l00[3], h00[0], h00[1], h00[2], h00[3]}, hacc, 0, 0, 0);
                hacc = __builtin_amdgcn_mfma_f32_32x32x16_bf16(pack8(X0, 1), (bf16x8){l01[0], l01[1], l01[2], l01[3], h01[0], h01[1], h01[2], h01[3]}, hacc, 0, 0, 0);
                if (th == 1) {
                    const s16x4 l10 = trr<VOFF + 256 * 32>(vb), h10 = trr<VOFF + 256 * 40>(vb1), l11 = trr<VOFF + 256 * 48>(vb), h11 = trr<VOFF + 256 * 56>(vb1);
                    MS_LWAIT();
                    hacc = __builtin_amdgcn_mfma_f32_32x32x16_bf16(pack8(X1, 0), (bf16x8){l10[0], l10[1], l10[2], l10[3], h10[0], h10[1], h10[2], h10[3]}, hacc, 0, 0, 0);
                    hacc = __builtin_amdgcn_mfma_f32_32x32x16_bf16(pack8(X1, 1), (bf16x8){l11[0], l11[1], l11[2], l11[3], h11[0], h11[1], h11[2], h11[3]}, hacc, 0, 0, 0);
                }
            }
            if (need_ctx_out || c >= CTXL / 64) {
#pragma unroll
                for (int g4 = 0; g4 < 4; ++g4) { const f32x4 rv = *(const LAS f32x4*)(rden_l + 8 * g4 + 4 * h);
#pragma unroll
                    for (int e = 0; e < 4; ++e) { const int t = 32 * th + 8 * g4 + 4 * h + e; const int row = scan_row(b, dir, c * 64 + t);
                        const float v = hacc[4 * g4 + e] * rv[e]; HO[(size_t)row * DM + ocol] = (bf16_t)(cvtpk(v, v) & 0xffffu); } }
            }
#pragma unroll
            for (int ti = 0; ti < 4; ++ti)
#pragma unroll
                for (int i = 0; i < 16; ++i) C[ti][i] *= e_prev;
            {
                const unsigned nb = (unsigned)(uintptr_t)lds + a_nat;
                const unsigned vb0 = nb ^ (64u * (unsigned)cb), vb1 = vb0 ^ 16u;
                const unsigned kb00 = nb, kb01 = nb ^ 16u, kb10 = nb ^ 64u, kb11 = nb ^ 80u, kb20 = nb ^ 128u, kb21 = nb ^ 144u, kb30 = nb ^ 192u, kb31 = nb ^ 208u;
#define MS_FSTEP(KS) do { \
                    const s16x4 vl = trr<VOFF + 256 * (16 * (KS))>(vb0), vh = trr<VOFF + 256 * (16 * (KS) + 4)>(vb1); \
                    const s16x4 k0l = trr<KOFF + 256 * (16 * (KS))>(kb00), k0h = trr<KOFF + 256 * (16 * (KS) + 4)>(kb01); \
                    const s16x4 k1l = trr<KOFF + 256 * (16 * (KS))>(kb10), k1h = trr<KOFF + 256 * (16 * (KS) + 4)>(kb11); \
                    const s16x4 k2l = trr<KOFF + 256 * (16 * (KS))>(kb20), k2h = trr<KOFF + 256 * (16 * (KS) + 4)>(kb21); \
                    const s16x4 k3l = trr<KOFF + 256 * (16 * (KS))>(kb30), k3h = trr<KOFF + 256 * (16 * (KS) + 4)>(kb31); \
                    const f32x4 w0 = *(const LAS f32x4*)(wg_l + 16 * (KS) + 8 * h), w1 = *(const LAS f32x4*)(wg_l + 16 * (KS) + 8 * h + 4); \
                    MS_LWAIT(); \
                    f32x8 vf; \
                    _Pragma("unroll") for (int e = 0; e < 4; ++e) { vf[e] = bf2f((bf16_t)vl[e]) * w0[e]; vf[4 + e] = bf2f((bf16_t)vh[e]) * w1[e]; } \
                    const bf16x8 vw = __builtin_bit_cast(bf16x8, __builtin_convertvector(vf, bf16x8v)); \
                    C[0] = __builtin_amdgcn_mfma_f32_32x32x16_bf16((bf16x8){k0l[0], k0l[1], k0l[2], k0l[3], k0h[0], k0h[1], k0h[2], k0h[3]}, vw, C[0], 0, 0, 0); \
                    C[1] = __builtin_amdgcn_mfma_f32_32x32x16_bf16((bf16x8){k1l[0], k1l[1], k1l[2], k1l[3], k1h[0], k1h[1], k1h[2], k1h[3]}, vw, C[1], 0, 0, 0); \
                    C[2] = __builtin_amdgcn_mfma_f32_32x32x16_bf16((bf16x8){k2l[0], k2l[1], k2l[2], k2l[3], k2h[0], k2h[1], k2h[2], k2h[3]}, vw, C[2], 0, 0, 0); \
                    C[3] = __builtin_amdgcn_mfma_f32_32x32x16_bf16((bf16x8){k3l[0], k3l[1], k3l[2], k3l[3], k3h[0], k3h[1], k3h[2], k3h[3]}, vw, C[3], 0, 0, 0); } while (0)
                MS_FSTEP(0); MS_FSTEP(1); MS_FSTEP(2); MS_FSTEP(3);
#undef MS_FSTEP
            }
            {
                const unsigned dl = ul & 15, sg = ul >> 4, d = 16u * (unsigned)wave + dl;
                const unsigned nl = cbase + KOFF + 4096u * sg + 16u * (d >> 3) + 2u * (d & 7);
                float acc = 0.f;
#pragma unroll
                for (int ss = 0; ss < 16; ++ss) { const bf16_t kv = *(const LAS bf16_t*)(lds + ((nl ^ (16u * xr16(ss))) + 256u * ss)); acc = fmaf(wg_l[16 * sg + ss], bf2f(kv), acc); }
                acc += __shfl_xor(acc, 16); acc += __shfl_xor(acc, 32);
                if (sg == 0) nnxt[d] = fmaf(e_prev, ncur[d], acc);
            }
            c_ig = g_ig; c_lf = g_lf;
            asm volatile("s_waitcnt vmcnt(0)" ::: "memory");
            __syncthreads();
        }
#undef MS_DMA
    }
}

namespace ms3 {
using namespace ms;
constexpr int SHOFF = NOFF + 1024;
constexpr int WP3OFF = SHOFF + 2048;
}
__device__ __forceinline__ void phase_scan3(const bf16_t* Z, const float* GATE, bf16_t* HF, bf16_t* HB, bool need_ctx_out, LAS unsigned char* lds, int tid, int lane, int wave) {
    using namespace ms; using namespace ms3;
    const int r = lane & 31, h = lane >> 5;
    const bool helper = wave >= 4; const int cb = wave & 3;
    LAS float* sh_colf = (LAS float*)(lds + SHOFF); LAS float* sh_wg = sh_colf + 64; LAS float* sh_ein = sh_colf + 128; LAS float* sh_rowf = sh_colf + 192; LAS float* sh_eneg = sh_colf + 256;
    LAS float* sh_qn = sh_colf + 320; LAS float* sh_scal = sh_colf + 384;
    LAS float* wpv = (LAS float*)(lds + WP3OFF + wave * 1024);
    for (int task = blockIdx.x; task < 256; task += gridDim.x) {
        const int dvh = task & 1, dir = (task >> 1) & 1, hd = (task >> 2) & 7, b = task >> 5;
        bf16_t* HO = dir == 0 ? HF : HB;
        const int ocol = hd * 256 + dvh * 128 + cb * 32 + r;
        const int d_rl = lane >> 4, d_ch = (lane & 15) ^ ((d_rl << 2) | (wave & 3));
        const int d_col0 = hd * 128 + d_ch * 8, d_col1 = 1024 + hd * 128 + d_ch * 8, d_col2 = 2048 + hd * 256 + dvh * 128 + d_ch * 8;
        float g_ig = 0.f, g_lf = 0.f;
#define MS_DMA(c_, buf_) do { _Pragma("unroll") for (int i_ = 0; i_ < 6; ++i_) { const int rg_ = 8 * (i_ & 1) + wave; const int row_ = scan_row(b, dir, (c_) * 64 + 4 * rg_ + d_rl); \
            const int col_ = (i_ >> 1) == 0 ? d_col0 : ((i_ >> 1) == 1 ? d_col1 : d_col2); \
            __builtin_amdgcn_global_load_lds((const unsigned*)(Z + (size_t)row_ * NMI + col_), (LAS unsigned*)(lds + (buf_) * BUFB + (i_ >> 1) * 16384 + 1024 * rg_), 16, 0, 0); } \
            if (helper) { const int row_ = scan_row(b, dir, (c_) * 64 + lane); g_ig = GATE[(size_t)row_ * 32 + (dir * 2) * 8 + hd]; g_lf = GATE[(size_t)row_ * 32 + (dir * 2 + 1) * 8 + hd]; } } while (0)
        f32x16 C[4];
#pragma unroll
        for (int ti = 0; ti < 4; ++ti)
#pragma unroll
            for (int i = 0; i < 16; ++i) C[ti][i] = 0.f;
        float m_prev = 0.f;
        __syncthreads();
        MS_DMA(0, 0);
        if (tid < 128) ((LAS float*)(lds + NOFF))[tid] = 0.f;
        float c_ig = g_ig, c_lf = g_lf;
        asm volatile("s_waitcnt vmcnt(0)" ::: "memory");
        __syncthreads();
        for (int c = 0; c < NCHUNK; ++c) {
            const int cur = c & 1;
            int lane_l = lane; asm volatile("" : "+v"(lane_l));
            const unsigned ul = (unsigned)lane_l, uh = ul >> 5, ublk = (ul >> 4) & 1, uq = (ul & 15) >> 2, up = ul & 3, ur = ul & 31;
            const unsigned cbase = (unsigned)(cur * BUFB);
            const LAS float* ncur = (const LAS float*)(lds + NOFF + cur * 512); LAS float* nnxt = (LAS float*)(lds + NOFF + (cur ^ 1) * 512);
            if (c + 1 < NCHUNK) MS_DMA(c + 1, cur ^ 1);
            if (helper) {
                const int hw = wave - 4;
                const float bsum = scan_incl_add(c_lf, lane);
                const float av = c_ig - bsum;
                const float pm = scan_incl_max(av, lane);
                const float mm = fmaxf(m_prev, pm);
                const float ein = __expf(m_prev - mm), eneg = __expf(-(bsum + mm));
                const float b_end = __shfl(bsum, 63), mm_end = __shfl(mm, 63);
                const float e_prev = __expf(m_prev - mm_end);
                const float wgv = __expf(av - mm_end);
                wpv[lane] = wgv;
                if (hw == 0) { sh_colf[lane] = av; sh_wg[lane] = wgv; sh_ein[lane] = ein; sh_rowf[lane] = -mm; sh_eneg[lane] = eneg; if (lane == 0) sh_scal[0] = e_prev; }
                m_prev = b_end + mm_end;
                {
                    const unsigned rr = ul & 15, dg = ul >> 4, row = 16u * (unsigned)hw + rr;
                    const unsigned qa = cbase + QOFF + 256u * row + 16u * ((4u * dg) ^ xr16(row & 15));
                    float qn = 0.f;
#pragma unroll
                    for (int cc = 0; cc < 4; ++cc) { const u32x4 qv = *(const LAS u32x4*)(lds + (qa ^ (16u * cc)));
                        const f32x4 n0 = *(const LAS f32x4*)(ncur + 32 * dg + 8 * cc), n1 = *(const LAS f32x4*)(ncur + 32 * dg + 8 * cc + 4);
                        qn += bflo(qv.x) * n0[0] + bfhi(qv.x) * n0[1] + bflo(qv.y) * n0[2] + bfhi(qv.y) * n0[3] + bflo(qv.z) * n1[0] + bfhi(qv.z) * n1[1] + bflo(qv.w) * n1[2] + bfhi(qv.w) * n1[3]; }
                    qn += __shfl_xor(qn, 16); qn += __shfl_xor(qn, 32);
                    if (dg == 0) sh_qn[row] = qn;
                }
                asm volatile("s_waitcnt lgkmcnt(0)" ::: "memory");
                __syncthreads();
                {
                    const unsigned dl = ul & 31, sg = ul >> 5, d = 32u * (unsigned)hw + dl;
                    const unsigned nl = cbase + KOFF + 8192u * sg + 16u * (d >> 3) + 2u * (d & 7);
                    float acc = 0.f;
#pragma unroll
                    for (int ss = 0; ss < 32; ++ss) { const bf16_t kv = *(const LAS bf16_t*)(lds + ((nl ^ (16u * xr16(ss & 15))) + 256u * ss)); acc = fmaf(wpv[32 * sg + ss], bf2f(kv), acc); }
                    acc += __shfl_xor(acc, 32);
                    if (sg == 0) nnxt[d] = fmaf(e_prev, ncur[d], acc);
                }
                c_ig = g_ig; c_lf = g_lf;
            } else {
                const unsigned a_nat = cbase + 256u * (8u * uh + uq) + ((64u * uq) | (32u * (ublk ^ uh)) | (16u * (up >> 1))) + 8u * (up & 1);
                const unsigned a_perm = cbase + 256u * (4u * uh + uq) + ((64u * uq) | (32u * ublk) | (16u * ((up >> 1) ^ uh))) + 8u * (up & 1);
                const unsigned a_row = cbase + 256u * ur + ((16u * xr16(ur)) ^ (16u * uh));
                const unsigned a_q64 = cbase + 256u * ur + 16u * xr16(ur) + 8u * uh;
                f32x16 Xa, Xb, Xc;
#pragma unroll
                for (int i = 0; i < 16; ++i) { Xa[i] = 0.f; Xb[i] = 0.f; Xc[i] = 0.f; }
#pragma unroll
                for (int ks = 0; ks < 8; ++ks) {
                    const unsigned ar = a_row ^ (32u * ks);
                    const bf16x8 q0 = *(const LAS bf16x8*)(lds + ar + QOFF), q1 = *(const LAS bf16x8*)(lds + ar + QOFF + 8192);
                    const bf16x8 k0 = *(const LAS bf16x8*)(lds + ar + KOFF), k1 = *(const LAS bf16x8*)(lds + ar + KOFF + 8192);
                    Xa = __builtin_amdgcn_mfma_f32_32x32x16_bf16(k0, q0, Xa, 0, 0, 0);
                    Xb = __builtin_amdgcn_mfma_f32_32x32x16_bf16(k0, q1, Xb, 0, 0, 0);
                    Xc = __builtin_amdgcn_mfma_f32_32x32x16_bf16(k1, q1, Xc, 0, 0, 0);
                }
                __syncthreads();
                const float e_prev = sh_scal[0];
                LAS float* rden_l = wpv;
                {
                    const float rowf0 = sh_rowf[r], rowf1 = sh_rowf[32 + r];
                    float rs0 = 0.f, rs1 = 0.f;
#pragma unroll
                    for (int g4 = 0; g4 < 4; ++g4) { const f32x4 cf0 = *(const LAS f32x4*)(sh_colf + 8 * g4 + 4 * h), cf1 = *(const LAS f32x4*)(sh_colf + 32 + 8 * g4 + 4 * h);
#pragma unroll
                        for (int e = 0; e < 4; ++e) { const int i = 4 * g4 + e; const int srow_ = 8 * g4 + 4 * h + e;
                            const float wa = (srow_ <= r) ? __expf(rowf0 + cf0[e]) : 0.f; Xa[i] *= wa; rs0 += Xa[i];
                            const float wb = __expf(rowf1 + cf0[e]); Xb[i] *= wb; rs1 += Xb[i];
                            const float wc = (srow_ <= r) ? __expf(rowf1 + cf1[e]) : 0.f; Xc[i] *= wc; rs1 += Xc[i]; } }
                    rs0 += __shfl_xor(rs0, 32); rs1 += __shfl_xor(rs1, 32);
                    const float den0 = sh_ein[r] * sh_qn[r] + rs0, den1 = sh_ein[32 + r] * sh_qn[32 + r] + rs1;
                    const float rd0 = 1.0f / fmaxf(fabsf(den0), sh_eneg[r]), rd1 = 1.0f / fmaxf(fabsf(den1), sh_eneg[32 + r]);
                    if (h == 0) { rden_l[r] = rd0; rden_l[32 + r] = rd1; }
                }
                f32x16 h0, h1;
#pragma unroll
                for (int i = 0; i < 16; ++i) { h0[i] = 0.f; h1[i] = 0.f; }
#pragma unroll
                for (int ti = 0; ti < 4; ++ti)
#pragma unroll
                    for (int ks2 = 0; ks2 < 2; ++ks2) {
                        const unsigned qx0 = a_q64 ^ (16u * (4 * ti + 2 * ks2 + 0)), qx1 = a_q64 ^ (16u * (4 * ti + 2 * ks2 + 1));
                        const s16x4 qa0 = *(const LAS s16x4*)(lds + qx0 + QOFF), qb0 = *(const LAS s16x4*)(lds + qx1 + QOFF);
                        const s16x4 qa1 = *(const LAS s16x4*)(lds + qx0 + QOFF + 8192), qb1 = *(const LAS s16x4*)(lds + qx1 + QOFF + 8192);
                        const bf16x8 cp = pack8(C[ti], ks2);
                        h0 = __builtin_amdgcn_mfma_f32_32x32x16_bf16((bf16x8){qa0[0], qa0[1], qa0[2], qa0[3], qb0[0], qb0[1], qb0[2], qb0[3]}, cp, h0, 0, 0, 0);
                        h1 = __builtin_amdgcn_mfma_f32_32x32x16_bf16((bf16x8){qa1[0], qa1[1], qa1[2], qa1[3], qb1[0], qb1[1], qb1[2], qb1[3]}, cp, h1, 0, 0, 0);
                    }
#pragma unroll
                for (int g4 = 0; g4 < 4; ++g4) { const f32x4 e0 = *(const LAS f32x4*)(sh_ein + 8 * g4 + 4 * h), e1 = *(const LAS f32x4*)(sh_ein + 32 + 8 * g4 + 4 * h);
#pragma unroll
                    for (int e = 0; e < 4; ++e) { h0[4 * g4 + e] *= e0[e]; h1[4 * g4 + e] *= e1[e]; } }
                {
                    const unsigned vb = (unsigned)(uintptr_t)lds + (a_perm ^ (64u * (unsigned)cb)); const unsigned vb1 = vb ^ 32u;
                    const s16x4 l00 = trr<VOFF + 256 * 0>(vb), h00 = trr<VOFF + 256 * 8>(vb1), l01 = trr<VOFF + 256 * 16>(vb), h01 = trr<VOFF + 256 * 24>(vb1);
                    const s16x4 l10 = trr<VOFF + 256 * 32>(vb), h10 = trr<VOFF + 256 * 40>(vb1), l11 = trr<VOFF + 256 * 48>(vb), h11 = trr<VOFF + 256 * 56>(vb1);
                    MS_LWAIT();
                    const bf16x8 v00 = {l00[0], l00[1], l00[2], l00[3], h00[0], h00[1], h00[2], h00[3]}, v01 = {l01[0], l01[1], l01[2], l01[3], h01[0], h01[1], h01[2], h01[3]};
                    const bf16x8 v10 = {l10[0], l10[1], l10[2], l10[3], h10[0], h10[1], h10[2], h10[3]}, v11 = {l11[0], l11[1], l11[2], l11[3], h11[0], h11[1], h11[2], h11[3]};
                    h0 = __builtin_amdgcn_mfma_f32_32x32x16_bf16(pack8(Xa, 0), v00, h0, 0, 0, 0);
                    h0 = __builtin_amdgcn_mfma_f32_32x32x16_bf16(pack8(Xa, 1), v01, h0, 0, 0, 0);
                    h1 = __builtin_amdgcn_mfma_f32_32x32x16_bf16(pack8(Xb, 0), v00, h1, 0, 0, 0);
                    h1 = __builtin_amdgcn_mfma_f32_32x32x16_bf16(pack8(Xb, 1), v01, h1, 0, 0, 0);
                    h1 = __builtin_amdgcn_mfma_f32_32x32x16_bf16(pack8(Xc, 0), v10, h1, 0, 0, 0);
                    h1 = __builtin_amdgcn_mfma_f32_32x32x16_bf16(pack8(Xc, 1), v11, h1, 0, 0, 0);
                }
                if (need_ctx_out || c >= CTXL / 64) {
#pragma unroll
                    for (int g4 = 0; g4 < 4; ++g4) { const f32x4 r0 = *(const LAS f32x4*)(rden_l + 8 * g4 + 4 * h), r1 = *(const LAS f32x4*)(rden_l + 32 + 8 * g4 + 4 * h);
#pragma unroll
                        for (int e = 0; e < 4; ++e) { const int t = 8 * g4 + 4 * h + e;
                            const int row0 = scan_row(b, dir, c * 64 + t), row1 = scan_row(b, dir, c * 64 + 32 + t);
                            const float v0 = h0[4 * g4 + e] * r0[e], v1 = h1[4 * g4 + e] * r1[e];
                            HO[(size_t)row0 * DM + ocol] = (bf16_t)(cvtpk(v0, v0) & 0xffffu); HO[(size_t)row1 * DM + ocol] = (bf16_t)(cvtpk(v1, v1) & 0xffffu); } }
                }
#pragma unroll
                for (int ti = 0; ti < 4; ++ti)
#pragma unroll
                    for (int i = 0; i < 16; ++i) C[ti][i] *= e_prev;
                {
                    const unsigned nb = (unsigned)(uintptr_t)lds + a_nat;
                    const unsigned vb0 = nb ^ (64u * (unsigned)cb), vb1 = vb0 ^ 16u;
                    const unsigned kb00 = nb, kb01 = nb ^ 16u, kb10 = nb ^ 64u, kb11 = nb ^ 80u, kb20 = nb ^ 128u, kb21 = nb ^ 144u, kb30 = nb ^ 192u, kb31 = nb ^ 208u;
#define MS_FSTEP(KS) do { \
                        const s16x4 vl = trr<VOFF + 256 * (16 * (KS))>(vb0), vh = trr<VOFF + 256 * (16 * (KS) + 4)>(vb1); \
                        const s16x4 k0l = trr<KOFF + 256 * (16 * (KS))>(kb00), k0h = trr<KOFF + 256 * (16 * (KS) + 4)>(kb01); \
                        const s16x4 k1l = trr<KOFF + 256 * (16 * (KS))>(kb10), k1h = trr<KOFF + 256 * (16 * (KS) + 4)>(kb11); \
                        const s16x4 k2l = trr<KOFF + 256 * (16 * (KS))>(kb20), k2h = trr<KOFF + 256 * (16 * (KS) + 4)>(kb21); \
                        const s16x4 k3l = trr<KOFF + 256 * (16 * (KS))>(kb30), k3h = trr<KOFF + 256 * (16 * (KS) + 4)>(kb31); \
                        const f32x4 w0 = *(const LAS f32x4*)(sh_wg + 16 * (KS) + 8 * h), w1 = *(const LAS f32x4*)(sh_wg + 16 * (KS) + 8 * h + 4); \
                        MS_LWAIT(); \
                        f32x8 vf; \
                        _Pragma("unroll") for (int e = 0; e < 4; ++e) { vf[e] = bf2f((bf16_t)vl[e]) * w0[e]; vf[4 + e] = bf2f((bf16_t)vh[e]) * w1[e]; } \
                        const bf16x8 vw = __builtin_bit_cast(bf16x8, __builtin_convertvector(vf, bf16x8v)); \
                        C[0] = __builtin_amdgcn_mfma_f32_32x32x16_bf16((bf16x8){k0l[0], k0l[1], k0l[2], k0l[3], k0h[0], k0h[1], k0h[2], k0h[3]}, vw, C[0], 0, 0, 0); \
                        C[1] = __builtin_amdgcn_mfma_f32_32x32x16_bf16((bf16x8){k1l[0], k1l[1], k1l[2], k1l[3], k1h[0], k1h[1], k1h[2], k1h[3]}, vw, C[1], 0, 0, 0); \
                        C[2] = __builtin_amdgcn_mfma_f32_32x32x16_bf16((bf16x8){k2l[0], k2l[1], k2l[2], k2l[3], k2h[0], k2h[1], k2h[2], k2h[3]}, vw, C[2], 0, 0, 0); \
                        C[3] = __builtin_amdgcn_mfma_f32_32x32x16_bf16((bf16x8){k3l[0], k3l[1], k3l[2], k3l[3], k3h[0], k3h[1], k3h[2], k3h[3]}, vw, C[3], 0, 0, 0); } while (0)
                    MS_FSTEP(0); MS_FSTEP(1); MS_FSTEP(2); MS_FSTEP(3);
#undef MS_FSTEP
                }
            }
            asm volatile("s_waitcnt vmcnt(0)" ::: "memory");
            __syncthreads();
        }
#undef MS_DMA
    }
}

namespace ms4 {
using namespace ms;
constexpr int GOFF = NOFF + 1024;
constexpr int GBUF = 6 * 64 * 4;
constexpr int POFF = GOFF + 2 * GBUF;
constexpr int RSOFF = POFF + 6144;
constexpr int WP4OFF = RSOFF + 1024;
}
__device__ __forceinline__ void phase_scan4(const bf16_t* Z, const float* GATE, bf16_t* HF, bf16_t* HB, bool need_ctx_out, LAS unsigned char* lds, int tid, int lane, int wave) {
    using namespace ms; using namespace ms4;
    const int r = lane & 31, h = lane >> 5;
    const bool score = wave >= 4; const int cb = wave & 3, T = wave - 4;
    LAS float* rsA = (LAS float*)(lds + RSOFF); LAS float* sh_qn = rsA + 96;
    LAS float* wpv = (LAS float*)(lds + WP4OFF + wave * 512);
    for (int task = blockIdx.x; task < 256; task += gridDim.x) {
        const int dvh = task & 1, dir = (task >> 1) & 1, hd = (task >> 2) & 7, b = task >> 5;
        bf16_t* HO = dir == 0 ? HF : HB;
        const int ocol0 = hd * 256 + dvh * 128 + cb * 32;
        const int d_rl = lane >> 4, d_ch = (lane & 15) ^ ((d_rl << 2) | (wave & 3));
        const int d_col0 = hd * 128 + d_ch * 8, d_col1 = 1024 + hd * 128 + d_ch * 8, d_col2 = 2048 + hd * 256 + dvh * 128 + d_ch * 8;
        float g_ig = 0.f, g_lf = 0.f;
        const int rstep = dir == 0 ? 1 : -1;
#define MS_DMA(c_, buf_) do { const int rb_ = scan_row(b, dir, (c_) * 64); _Pragma("unroll") for (int i_ = 0; i_ < 6; ++i_) { const int rg_ = 8 * (i_ & 1) + wave; const int row_ = rb_ + rstep * (4 * rg_ + d_rl); \
            const int col_ = (i_ >> 1) == 0 ? d_col0 : ((i_ >> 1) == 1 ? d_col1 : d_col2); \
            __builtin_amdgcn_global_load_lds((const unsigned*)(Z + (size_t)row_ * NMI + col_), (LAS unsigned*)(lds + (buf_) * BUFB + (i_ >> 1) * 16384 + 1024 * rg_), 16, 0, 0); } } while (0)
#define MS_GLOAD(c_) do { const int row_ = scan_row(b, dir, (c_) * 64) + rstep * lane; g_ig = GATE[(size_t)row_ * 32 + (dir * 2) * 8 + hd]; g_lf = GATE[(size_t)row_ * 32 + (dir * 2 + 1) * 8 + hd]; } while (0)
#define MS_GATES(gb_) do { \
            const float bsum_ = scan_incl_add(g_lf, lane); const float av_ = g_ig - bsum_; const float pm_ = scan_incl_max(av_, lane); const float mm_ = fmaxf(m_prev, pm_); \
            const float b_end_ = __shfl(bsum_, 63), mm_end_ = __shfl(mm_, 63); \
            if (T == 3) { LAS float* gp_ = (LAS float*)(lds + GOFF + (gb_) * GBUF); gp_[lane] = av_; gp_[64 + lane] = __expf(av_ - mm_end_); gp_[128 + lane] = __expf(m_prev - mm_); \
                gp_[192 + lane] = -mm_; gp_[256 + lane] = __expf(-(bsum_ + mm_)); if (lane == 0) gp_[320] = __expf(m_prev - mm_end_); } \
            m_prev = b_end_ + mm_end_; } while (0)
        f32x16 C[4];
#pragma unroll
        for (int ti = 0; ti < 4; ++ti)
#pragma unroll
            for (int i = 0; i < 16; ++i) C[ti][i] = 0.f;
        float m_prev = 0.f;
        __syncthreads();
        MS_DMA(0, 0);
        if (tid < 128) ((LAS float*)(lds + NOFF))[tid] = 0.f;
        if (score) { MS_GLOAD(0); MS_GATES(0); }
        asm volatile("s_waitcnt vmcnt(0) lgkmcnt(0)" ::: "memory");
        __syncthreads();
        for (int c = 0; c < NCHUNK; ++c) {
            const int cur = c & 1;
            int lane_l = lane; asm volatile("" : "+v"(lane_l));
            const unsigned ul = (unsigned)lane_l, uh = ul >> 5, ublk = (ul >> 4) & 1, uq = (ul & 15) >> 2, up = ul & 3, ur = ul & 31;
            const unsigned cbase = (unsigned)(cur * BUFB);
            const LAS float* ncur = (const LAS float*)(lds + NOFF + cur * 512); LAS float* nnxt = (LAS float*)(lds + NOFF + (cur ^ 1) * 512);
            const LAS float* gcur = (const LAS float*)(lds + GOFF + cur * GBUF);
            if (score) {
                if (c + 1 < NCHUNK) MS_GLOAD(c + 1);
                if (T < 3) {
                    const unsigned a_row = cbase + 256u * ur + ((16u * xr16(ur)) ^ (16u * uh));
                    const unsigned qoff = QOFF + (T == 0 ? 0u : 8192u), koff = KOFF + (T == 2 ? 8192u : 0u);
                    f32x16 X;
#pragma unroll
                    for (int i = 0; i < 16; ++i) X[i] = 0.f;
#pragma unroll
                    for (int ks = 0; ks < 8; ++ks) { const unsigned ar = a_row ^ (32u * ks);
                        X = __builtin_amdgcn_mfma_f32_32x32x16_bf16(*(const LAS bf16x8*)(lds + ar + koff), *(const LAS bf16x8*)(lds + ar + qoff), X, 0, 0, 0); }
                    const float rowf = gcur[192 + (T == 0 ? 0 : 32) + r];
                    const LAS float* cfp = gcur + (T == 2 ? 32 : 0);
                    float rs = 0.f;
#pragma unroll
                    for (int g4 = 0; g4 < 4; ++g4) { const f32x4 cf = *(const LAS f32x4*)(cfp + 8 * g4 + 4 * h);
#pragma unroll
                        for (int e = 0; e < 4; ++e) { const int i = 4 * g4 + e; const int srow_ = 8 * g4 + 4 * h + e;
                            const float w = (T == 1 || srow_ <= r) ? __expf(rowf + cf[e]) : 0.f; X[i] *= w; rs += X[i]; } }
                    rs += __shfl_xor(rs, 32);
                    if (h == 0) rsA[32 * T + r] = rs;
                    *(LAS bf16x8*)(lds + POFF + ((T * 2 + 0) * 64 + lane) * 16) = pack8(X, 0);
                    *(LAS bf16x8*)(lds + POFF + ((T * 2 + 1) * 64 + lane) * 16) = pack8(X, 1);
                }
                {
                    const unsigned rr = ul & 15, dg = ul >> 4, row = 16u * (unsigned)T + rr;
                    const unsigned qa = cbase + QOFF + 256u * row + 16u * ((4u * dg) ^ xr16(row & 15));
                    float qn = 0.f;
#pragma unroll
                    for (int cc = 0; cc < 4; ++cc) { const u32x4 qv = *(const LAS u32x4*)(lds + (qa ^ (16u * cc)));
                        const f32x4 n0 = *(const LAS f32x4*)(ncur + 32 * dg + 8 * cc), n1 = *(const LAS f32x4*)(ncur + 32 * dg + 8 * cc + 4);
                        qn += bflo(qv.x) * n0[0] + bfhi(qv.x) * n0[1] + bflo(qv.y) * n0[2] + bfhi(qv.y) * n0[3] + bflo(qv.z) * n1[0] + bfhi(qv.z) * n1[1] + bflo(qv.w) * n1[2] + bfhi(qv.w) * n1[3]; }
                    qn += __shfl_xor(qn, 16); qn += __shfl_xor(qn, 32);
                    if (dg == 0) sh_qn[row] = qn;
                }
                asm volatile("s_waitcnt lgkmcnt(0)" ::: "memory");
                __builtin_amdgcn_s_barrier(); asm volatile("" ::: "memory");
                asm volatile("" : "+v"(g_ig), "+v"(g_lf));
                if (c + 1 < NCHUNK) MS_DMA(c + 1, cur ^ 1);
                {
                    const float e_prev = gcur[320];
                    const unsigned dl = ul & 31, sg = ul >> 5, d = 32u * (unsigned)T + dl;
                    const unsigned nl = cbase + KOFF + 8192u * sg + 16u * (d >> 3) + 2u * (d & 7);
                    float acc = 0.f;
#pragma unroll
                    for (int ss = 0; ss < 32; ++ss) { const bf16_t kv = *(const LAS bf16_t*)(lds + ((nl ^ (16u * xr16(ss & 15))) + 256u * ss)); acc = fmaf(gcur[64 + 32 * sg + ss], bf2f(kv), acc); }
                    acc += __shfl_xor(acc, 32);
                    if (sg == 0) nnxt[d] = fmaf(e_prev, ncur[d], acc);
                }
                if (c + 1 < NCHUNK) MS_GATES(cur ^ 1);
            } else {
                const unsigned a_nat = cbase + 256u * (8u * uh + uq) + ((64u * uq) | (32u * (ublk ^ uh)) | (16u * (up >> 1))) + 8u * (up & 1);
                const unsigned a_perm = cbase + 256u * (4u * uh + uq) + ((64u * uq) | (32u * ublk) | (16u * ((up >> 1) ^ uh))) + 8u * (up & 1);
                const unsigned a_q64 = cbase + 256u * ur + 16u * xr16(ur) + 8u * uh;
                f32x16 h0, h1;
#pragma unroll
                for (int i = 0; i < 16; ++i) { h0[i] = 0.f; h1[i] = 0.f; }
#pragma unroll
                for (int ti = 0; ti < 4; ++ti)
#pragma unroll
                    for (int ks2 = 0; ks2 < 2; ++ks2) {
                        const unsigned qx0 = a_q64 ^ (16u * (4 * ti + 2 * ks2 + 0)), qx1 = a_q64 ^ (16u * (4 * ti + 2 * ks2 + 1));
                        const s16x4 qa0 = *(const LAS s16x4*)(lds + qx0 + QOFF), qb0 = *(const LAS s16x4*)(lds + qx1 + QOFF);
                        const s16x4 qa1 = *(const LAS s16x4*)(lds + qx0 + QOFF + 8192), qb1 = *(const LAS s16x4*)(lds + qx1 + QOFF + 8192);
                        const bf16x8 cp = pack8(C[ti], ks2);
                        h0 = __builtin_amdgcn_mfma_f32_32x32x16_bf16(cp, (bf16x8){qa0[0], qa0[1], qa0[2], qa0[3], qb0[0], qb0[1], qb0[2], qb0[3]}, h0, 0, 0, 0);
                        h1 = __builtin_amdgcn_mfma_f32_32x32x16_bf16(cp, (bf16x8){qa1[0], qa1[1], qa1[2], qa1[3], qb1[0], qb1[1], qb1[2], qb1[3]}, h1, 0, 0, 0);
                    }
                const float ein0 = gcur[128 + r], ein1 = gcur[128 + 32 + r];
#pragma unroll
                for (int i = 0; i < 16; ++i) { h0[i] *= ein0; h1[i] *= ein1; }
                if (c + 1 < NCHUNK) MS_DMA(c + 1, cur ^ 1);
                asm volatile("s_waitcnt lgkmcnt(0)" ::: "memory"); __builtin_amdgcn_s_barrier(); asm volatile("" ::: "memory");
                const float e_prev = gcur[320];
                const float den0 = ein0 * sh_qn[r] + rsA[r], den1 = ein1 * sh_qn[32 + r] + rsA[32 + r] + rsA[64 + r];
                const float rd0 = __builtin_amdgcn_rcpf(fmaxf(fabsf(den0), gcur[256 + r])), rd1 = __builtin_amdgcn_rcpf(fmaxf(fabsf(den1), gcur[256 + 32 + r]));
                {
                    const unsigned vb = (unsigned)(uintptr_t)lds + (a_perm ^ (64u * (unsigned)cb)); const unsigned vb1 = vb ^ 32u;
                    const s16x4 l00 = trr<VOFF + 256 * 0>(vb), h00 = trr<VOFF + 256 * 8>(vb1), l01 = trr<VOFF + 256 * 16>(vb), h01 = trr<VOFF + 256 * 24>(vb1);
                    const s16x4 l10 = trr<VOFF + 256 * 32>(vb), h10 = trr<VOFF + 256 * 40>(vb1), l11 = trr<VOFF + 256 * 48>(vb), h11 = trr<VOFF + 256 * 56>(vb1);
                    const LAS bf16x8* pf = (const LAS bf16x8*)(lds + POFF) + lane;
                    const bf16x8 pa0 = pf[0 * 64], pa1 = pf[1 * 64], pb0 = pf[2 * 64], pb1 = pf[3 * 64], pc0 = pf[4 * 64], pc1 = pf[5 * 64];
                    MS_LWAIT();
                    const bf16x8 v00 = {l00[0], l00[1], l00[2], l00[3], h00[0], h00[1], h00[2], h00[3]}, v01 = {l01[0], l01[1], l01[2], l01[3], h01[0], h01[1], h01[2], h01[3]};
                    const bf16x8 v10 = {l10[0], l10[1], l10[2], l10[3], h10[0], h10[1], h10[2], h10[3]}, v11 = {l11[0], l11[1], l11[2], l11[3], h11[0], h11[1], h11[2], h11[3]};
                    h0 = __builtin_amdgcn_mfma_f32_32x32x16_bf16(v00, pa0, h0, 0, 0, 0);
                    h0 = __builtin_amdgcn_mfma_f32_32x32x16_bf16(v01, pa1, h0, 0, 0, 0);
                    h1 = __builtin_amdgcn_mfma_f32_32x32x16_bf16(v00, pb0, h1, 0, 0, 0);
                    h1 = __builtin_amdgcn_mfma_f32_32x32x16_bf16(v01, pb1, h1, 0, 0, 0);
                    h1 = __builtin_amdgcn_mfma_f32_32x32x16_bf16(v10, pc0, h1, 0, 0, 0);
                    h1 = __builtin_amdgcn_mfma_f32_32x32x16_bf16(v11, pc1, h1, 0, 0, 0);
                }
                if (need_ctx_out || c >= CTXL / 64) {
                    const long es = (long)rstep * DM;
                    bf16_t* hp0 = HO + (size_t)scan_row(b, dir, c * 64) * DM + ocol0 + 8 * h + (long)r * es;
                    bf16_t* hp1 = hp0 + 32 * es;
#pragma unroll
                    for (int gp = 0; gp < 2; ++gp) { const int ib = 8 * gp;
                        { const unsigned a0 = cvtpk(h0[ib + 0] * rd0, h0[ib + 1] * rd0), a1 = cvtpk(h0[ib + 2] * rd0, h0[ib + 3] * rd0), b0 = cvtpk(h0[ib + 4] * rd0, h0[ib + 5] * rd0), b1 = cvtpk(h0[ib + 6] * rd0, h0[ib + 7] * rd0);
                          auto s0 = __builtin_amdgcn_permlane32_swap(a0, b0, false, false); auto s1 = __builtin_amdgcn_permlane32_swap(a1, b1, false, false);
                          *(u32x4*)(hp0 + 16 * gp) = (u32x4){s0[0], s1[0], s0[1], s1[1]}; }
                        { const unsigned a0 = cvtpk(h1[ib + 0] * rd1, h1[ib + 1] * rd1), a1 = cvtpk(h1[ib + 2] * rd1, h1[ib + 3] * rd1), b0 = cvtpk(h1[ib + 4] * rd1, h1[ib + 5] * rd1), b1 = cvtpk(h1[ib + 6] * rd1, h1[ib + 7] * rd1);
                          auto s0 = __builtin_amdgcn_permlane32_swap(a0, b0, false, false); auto s1 = __builtin_amdgcn_permlane32_swap(a1, b1, false, false);
                          *(u32x4*)(hp1 + 16 * gp) = (u32x4){s0[0], s1[0], s0[1], s1[1]}; } }
                }
#pragma unroll
                for (int ti = 0; ti < 4; ++ti)
#pragma unroll
                    for (int i = 0; i < 16; ++i) C[ti][i] *= e_prev;
                {
                    const unsigned nb = (unsigned)(uintptr_t)lds + a_nat;
                    const unsigned vb0 = nb ^ (64u * (unsigned)cb), vb1 = vb0 ^ 16u;
                    const unsigned kb00 = nb, kb01 = nb ^ 16u, kb10 = nb ^ 64u, kb11 = nb ^ 80u, kb20 = nb ^ 128u, kb21 = nb ^ 144u, kb30 = nb ^ 192u, kb31 = nb ^ 208u;
#define MS_FSTEP(KS) do { \
                        const s16x4 vl = trr<VOFF + 256 * (16 * (KS))>(vb0), vh = trr<VOFF + 256 * (16 * (KS) + 4)>(vb1); \
                        const s16x4 k0l = trr<KOFF + 256 * (16 * (KS))>(kb00), k0h = trr<KOFF + 256 * (16 * (KS) + 4)>(kb01); \
                        const s16x4 k1l = trr<KOFF + 256 * (16 * (KS))>(kb10), k1h = trr<KOFF + 256 * (16 * (KS) + 4)>(kb11); \
                        const s16x4 k2l = trr<KOFF + 256 * (16 * (KS))>(kb20), k2h = trr<KOFF + 256 * (16 * (KS) + 4)>(kb21); \
                        const s16x4 k3l = trr<KOFF + 256 * (16 * (KS))>(kb30), k3h = trr<KOFF + 256 * (16 * (KS) + 4)>(kb31); \
                        const f32x4 w0 = *(const LAS f32x4*)(gcur + 64 + 16 * (KS) + 8 * h), w1 = *(const LAS f32x4*)(gcur + 64 + 16 * (KS) + 8 * h + 4); \
                        MS_LWAIT(); \
                        f32x8 vf; \
                        _Pragma("unroll") for (int e = 0; e < 4; ++e) { vf[e] = bf2f((bf16_t)vl[e]) * w0[e]; vf[4 + e] = bf2f((bf16_t)vh[e]) * w1[e]; } \
                        const bf16x8 vw = __builtin_bit_cast(bf16x8, __builtin_convertvector(vf, bf16x8v)); \
                        C[0] = __builtin_amdgcn_mfma_f32_32x32x16_bf16((bf16x8){k0l[0], k0l[1], k0l[2], k0l[3], k0h[0], k0h[1], k0h[2], k0h[3]}, vw, C[0], 0, 0, 0); \
                        C[1] = __builtin_amdgcn_mfma_f32_32x32x16_bf16((bf16x8){k1l[0], k1l[1], k1l[2], k1l[3], k1h[0], k1h[1], k1h[2], k1h[3]}, vw, C[1], 0, 0, 0); \
                        C[2] = __builtin_amdgcn_mfma_f32_32x32x16_bf16((bf16x8){k2l[0], k2l[1], k2l[2], k2l[3], k2h[0], k2h[1], k2h[2], k2h[3]}, vw, C[2], 0, 0, 0); \
                        C[3] = __builtin_amdgcn_mfma_f32_32x32x16_bf16((bf16x8){k3l[0], k3l[1], k3l[2], k3l[3], k3h[0], k3h[1], k3h[2], k3h[3]}, vw, C[3], 0, 0, 0); } while (0)
                    MS_FSTEP(0); MS_FSTEP(1); MS_FSTEP(2); MS_FSTEP(3);
#undef MS_FSTEP
                }
            }
            if (!score && (need_ctx_out || c >= CTXL / 64)) asm volatile("s_waitcnt vmcnt(4) lgkmcnt(0)" ::: "memory");
            else asm volatile("s_waitcnt vmcnt(0) lgkmcnt(0)" ::: "memory");
            __syncthreads();
        }
#undef MS_DMA
#undef MS_GLOAD
#undef MS_GATES
    }
}

__device__ __forceinline__ void phase_mfinish(const bf16_t* Z, const bf16_t* HF, const bf16_t* HB, const float* ghead, bf16_t* H, int row_end, int lane, int wave) {
    const int gw = blockIdx.x * NWAVES + wave, NGW = gridDim.x * NWAVES;
    const int lcol = (lane >> 5) * 256 + (lane & 31) * 8;
    f32x4 gh[8];
#pragma unroll
    for (int j = 0; j < 4; ++j) { gh[2 * j] = *(const f32x4*)(ghead + lcol + 512 * j); gh[2 * j + 1] = *(const f32x4*)(ghead + lcol + 512 * j + 4); }
    const bool fast = NGW == 2048; const int b = gw & 7, w8 = gw >> 3;
    const int n_it = fast ? 8 + (MX + gw < row_end ? 1 : 0) : (gw < row_end ? (row_end - gw + 2 * NGW - 1) / (2 * NGW) : 0);
    for (int it = 0; it < n_it; ++it) {
        int r, r2;
        if (fast) { if (it < 8) { r = b * SEQ + w8 + 256 * (15 - it); r2 = b * SEQ + w8 + 256 * it; } else { r = MX + gw; r2 = r; } }
        else { r = gw + 2 * NGW * it; r2 = (r + NGW < row_end) ? r + NGW : r; }
        u32x4 fa[4], ba[4], oa[4], fb[4], bb[4], ob[4];
#pragma unroll
        for (int j = 0; j < 4; ++j) { const int col = lcol + 512 * j;
            fa[j] = *(const u32x4*)(HF + (size_t)r * DM + col); ba[j] = *(const u32x4*)(HB + (size_t)r * DM + col); oa[j] = *(const u32x4*)(Z + (size_t)r * NMI + 4096 + col);
            fb[j] = *(const u32x4*)(HF + (size_t)r2 * DM + col); bb[j] = *(const u32x4*)(HB + (size_t)r2 * DM + col); ob[j] = *(const u32x4*)(Z + (size_t)r2 * NMI + 4096 + col); }
#pragma unroll
        for (int j = 0; j < 4; ++j) { const int col = lcol + 512 * j;
            float sa[8] = {bflo(fa[j].x) + bflo(ba[j].x), bfhi(fa[j].x) + bfhi(ba[j].x), bflo(fa[j].y) + bflo(ba[j].y), bfhi(fa[j].y) + bfhi(ba[j].y),
                           bflo(fa[j].z) + bflo(ba[j].z), bfhi(fa[j].z) + bfhi(ba[j].z), bflo(fa[j].w) + bflo(ba[j].w), bfhi(fa[j].w) + bfhi(ba[j].w)};
            float sb[8] = {bflo(fb[j].x) + bflo(bb[j].x), bfhi(fb[j].x) + bfhi(bb[j].x), bflo(fb[j].y) + bflo(bb[j].y), bfhi(fb[j].y) + bfhi(bb[j].y),
                           bflo(fb[j].z) + bflo(bb[j].z), bfhi(fb[j].z) + bfhi(bb[j].z), bflo(fb[j].w) + bflo(bb[j].w), bfhi(fb[j].w) + bfhi(bb[j].w)};
            float qa = 0.f, qb = 0.f;
#pragma unroll
            for (int e = 0; e < 8; ++e) { qa += sa[e] * sa[e]; qb += sb[e] * sb[e]; }
#pragma unroll
            for (int o = 1; o < 32; o <<= 1) { qa += __shfl_xor(qa, o); qb += __shfl_xor(qb, o); }
            const float ra = 1.0f / sqrtf(qa * (1.0f / 256.0f) + RMS_EPS), rb = 1.0f / sqrtf(qb * (1.0f / 256.0f) + RMS_EPS);
            const float oav[8] = {bflo(oa[j].x), bfhi(oa[j].x), bflo(oa[j].y), bfhi(oa[j].y), bflo(oa[j].z), bfhi(oa[j].z), bflo(oa[j].w), bfhi(oa[j].w)};
            const float obv[8] = {bflo(ob[j].x), bfhi(ob[j].x), bflo(ob[j].y), bfhi(ob[j].y), bflo(ob[j].z), bfhi(ob[j].z), bflo(ob[j].w), bfhi(ob[j].w)};
            float ya[8], yb[8];
#pragma unroll
            for (int e = 0; e < 8; ++e) { const float gg = e < 4 ? gh[2 * j][e] : gh[2 * j + 1][e - 4]; ya[e] = sigmoid_f(oav[e]) * (sa[e] * ra) * gg; yb[e] = sigmoid_f(obv[e]) * (sb[e] * rb) * gg; }
            *(u32x4*)(H + (size_t)r * DM + col) = (u32x4){cvtpk(ya[0], ya[1]), cvtpk(ya[2], ya[3]), cvtpk(ya[4], ya[5]), cvtpk(ya[6], ya[7])};
            *(u32x4*)(H + (size_t)r2 * DM + col) = (u32x4){cvtpk(yb[0], yb[1]), cvtpk(yb[2], yb[3]), cvtpk(yb[4], yb[5]), cvtpk(yb[6], yb[7])}; }
    }
}

#ifndef STAGGER_TICKS
#define STAGGER_TICKS 125
#endif
__device__ __forceinline__ void gemm_stagger(int bx) {
    const unsigned long long d = (unsigned long long)((bx >> 3) & 7) * STAGGER_TICKS;
    if (d) { const unsigned long long t0 = __builtin_amdgcn_s_memrealtime(); while (__builtin_amdgcn_s_memrealtime() - t0 < d) __builtin_amdgcn_s_sleep(8); }
}
#ifndef PROBE_KIND
#define PROBE_KIND 0
#endif
#ifndef PROBE_WG
#define PROBE_WG 5
#endif
#ifndef PROBE_SITE
#define PROBE_SITE 0
#endif
#ifndef PROBE_N
#define PROBE_N 16
#endif
#ifndef BG_BUDGET
#define BG_BUDGET 3
#endif
#define BG_TAIL(nunits_, cidx_) do { const int rem_ = (nunits_) % G; if (i < 3 && rem_ != 0 && bx >= rem_) { TL bg_run(a, lds, i + 1, 3, 1 << 30, (const unsigned*)(a.ws + WS_CTL) + CW_DONE + 64 * (cidx_), (unsigned)(nunits_), tid, lane, wave); } } while (0)
constexpr int CW_DONE = 3584;
constexpr int N_PHASES = 38;
#define REP(bit) for (int rep_ = 0; rep_ < (((DUP_MASK) >> (bit)) & 1) + 1; ++rep_)
#ifndef EN_PRO
#define EN_PRO 1
#endif
#ifndef EN_NORM
#define EN_NORM 1
#endif
#ifndef EN_ROPE
#define EN_ROPE 1
#endif
#ifndef EN_ATTN
#define EN_ATTN 1
#endif
#ifndef EN_SCAN
#define EN_SCAN 1
#endif
#ifndef EN_MFIN
#define EN_MFIN 1
#endif
#ifndef EN_CONV
#define EN_CONV 1
#endif
#ifndef EN_FINAL
#define EN_FINAL 1
#endif
#ifndef EN_G1
#define EN_G1 1
#endif
#ifndef EN_G2
#define EN_G2 1
#endif
#ifndef EN_G3
#define EN_G3 1
#endif
#ifndef EN_G4
#define EN_G4 1
#endif
#ifndef EN_G5
#define EN_G5 1
#endif
#ifndef EN_G6
#define EN_G6 1
#endif
__global__ void __launch_bounds__(NTHREADS, 2) fwd(Args a) {
    extern __shared__ __attribute__((aligned(16))) unsigned char lds_raw[];
    LAS unsigned char* lds = (LAS unsigned char*)lds_raw;
    volatile LAS unsigned* MISC = (volatile LAS unsigned*)(lds + MISC_OFF);
    if (threadIdx.x < 32) MISC[threadIdx.x] = 0u;
    __syncthreads();
    unsigned* ctl = (unsigned*)(a.ws + WS_CTL);
    XcdBarrier bar = xcd_barrier_post(ctl + CW_BAR + a.li * XCD_BAR_WORDS, MISC + 8);
    const int G = gridDim.x, bx = blockIdx.x;
    const int lo = a.ph_lo, hi = a.ph_hi;
#define IN(k) (lo <= (k) && (k) < hi)
#define TL int tid = threadIdx.x; asm volatile("" : "+v"(tid)); const int lane = tid & 63, wave = __builtin_amdgcn_readfirstlane(tid >> 6); (void)lane; (void)wave;
#define SEAM(k) do { if (IN(k) && IN((k) + 1)) xcd_barrier(bar); } while (0)
    unsigned char* ws = a.ws;
    bf16_t* X = (bf16_t*)(ws + WS_X); bf16_t* H = (bf16_t*)(ws + WS_H); bf16_t* Z = (bf16_t*)(ws + WS_Z);
    float* GATE = (float*)(ws + WS_GATE); bf16_t* HF = (bf16_t*)(ws + WS_HF); bf16_t* HB = (bf16_t*)(ws + WS_HB);
    const float* mod = (const float*)(ws + WS_MOD);
    float* PART = (float*)(ws + WS_HB);

    if (EN_PRO && IN(0)) REP(0) { TL phase_prologue(a, lds, tid, lane, wave); }
    SEAM(0);

    for (int i = 0; i < 4; ++i) {
        const int P = 1 + 9 * i, j = i >> 1; const bool last = (i == 3);
        const float* modl = mod + (size_t)i * 9 * MODW;
        const float* xin32 = a.in[I_X]; const float* cin32 = a.in[I_CTX] - (size_t)MX * DM;
        const int pm_hi_mix = last ? MX / 256 : MT / 256;
        if (EN_NORM && IN(P + 0)) REP(1) { TL phase_norm(i == 0 ? (const void*)xin32 : (const void*)X, i == 0, i == 0 ? (const void*)cin32 : (const void*)X, i == 0, a.in[I_GMIX] + (size_t)i * DM, modl, 0, DM, H, MT, i > 0 ? PART : (const float*)nullptr, X, lane, wave); }
        SEAM(P + 0);
        if ((i & 1) == 0) {
            if (EN_G1 && IN(P + 1)) REP(2) { pg8::Gemm g{H, (const bf16_t*)(ws + WS_WQKV) + (size_t)j * NQKV * DM, MT, NQKV, DM, DM}; RangeOrder S; S.init(0, MT / 256, NQKV, G, bx);
                EpiQKV E{Z, (const float*)(ws + WS_ROPE), (const float*)(ws + WS_ROPE + 1 * MiB)};
#if PROBE_KIND
                if (PROBE_SITE == 2 && i == 2) pg8::gemm_phase<EpiQKV, RangeOrder, true>(lds, g, S, E, (unsigned long long*)(ws + 512 * 1024) + 64 * bx); else
#endif
                S.donectr = (unsigned*)(ws + WS_CTL) + CW_DONE + 64 * (2 * i);
                pg8::gemm_phase<EpiQKV, RangeOrder>(lds, g, S, E, nullptr);
                BG_TAIL((MT / 256) * (NQKV / 256), 2 * i); }
            SEAM(P + 1);
            if (EN_ATTN && IN(P + 3)) REP(3) { phase_attn(Z, H, a.in[I_SINK] + (size_t)j * 16, (char*)lds_raw); }
            SEAM(P + 3);
            if (EN_G2 && IN(P + 4)) { const bf16_t* Wt = (const bf16_t*)(ws + WS_WAO) + (size_t)j * DM * DM;
                { pg8::Gemm g{H, Wt, MT, DM, DM, DM}; RangeOrder S; S.init(0, MX / 256, DM, G, bx);
                  EpiRes E{xin32, i == 0 ? (const bf16_t*)nullptr : X, X, modl + 2 * DM}; pg8::gemm_phase<EpiRes, RangeOrder>(lds, g, S, E, nullptr); }
                { pg8::Gemm g{H, Wt, MT, DM, DM / 4, DM}; SplitOrder S; S.init(DM, DM, G, bx);
                  EpiPart E{PART, modl + 2 * DM, DM / 4}; pg8::gemm_phase<EpiPart, SplitOrder>(lds, g, S, E, nullptr); } }
            SEAM(P + 4);
        } else {
            if (EN_G3 && IN(P + 1)) REP(4) { pg8::Gemm g{H, (const bf16_t*)(ws + WS_WMI) + (size_t)j * NMI_PAD * DM, MT, NMI, DM, DM}; RangeOrder S; S.init(0, MT / 256, NMI, G, bx);
                EpiMI E{Z, GATE, a.in[I_BMI] + (size_t)j * NMI_RAW}; pg8::gemm_phase<EpiMI, RangeOrder>(lds, g, S, E, nullptr);
                { TL gate_run(a, lds, H, (const bf16_t*)(ws + WS_WMI) + (size_t)j * NMI_PAD * DM + (size_t)NMI * DM, a.in[I_BMI] + (size_t)j * NMI_RAW + NMI, GATE, j, tid, lane, wave); } }
            SEAM(P + 1);
            if (EN_SCAN && IN(P + 2)) REP(5) { TL phase_scan4(Z, GATE, HF, HB, !last, lds, tid, lane, wave); }
            SEAM(P + 2);
            if (EN_MFIN && IN(P + 3)) REP(6) { TL phase_mfinish(Z, HF, HB, a.in[I_GHEAD] + (size_t)j * DM, H, last ? MX : MT, lane, wave); }
            SEAM(P + 3);
            if (EN_G4 && IN(P + 4)) { const bf16_t* Wt = (const bf16_t*)(ws + WS_WMO) + (size_t)j * DM * DM;
                { pg8::Gemm g{H, Wt, MT, DM, DM, DM}; RangeOrder S; S.init(0, MX / 256, DM, G, bx);
                  EpiRes E{xin32, i == 0 ? (const bf16_t*)nullptr : X, X, modl + 2 * DM}; pg8::gemm_phase<EpiRes, RangeOrder>(lds, g, S, E, nullptr); }
                if (!last) { pg8::Gemm g{H, Wt, MT, DM, DM / 4, DM}; SplitOrder S; S.init(DM, DM, G, bx);
                  EpiPart E{PART, modl + 2 * DM, DM / 4}; pg8::gemm_phase<EpiPart, SplitOrder>(lds, g, S, E, nullptr); } }
            SEAM(P + 4);
        }
        if (EN_NORM && IN(P + 5)) REP(1) { TL phase_norm((const void*)X, false, i == 0 ? (const void*)cin32 : (const void*)X, i == 0, a.in[I_GFFN] + (size_t)i * DM, modl, 3 * DM, 4 * DM, H, last ? MX : MT, last ? (const float*)nullptr : PART, X, lane, wave); }
        SEAM(P + 5);
        {
            const int pm_hi = last ? MX / 256 : MT / 256;
            bf16_t* Gb = (bf16_t*)(ws + WS_Z); float* EA = (float*)(ws + WS_HF); float* EB = (float*)(ws + WS_HF + 16 * MiB);
            const float* cwp = a.in[I_CONVW] + (size_t)i * 3 * NUP; const float* cbp = a.in[I_CONVB] + (size_t)i * NUP;
            if (EN_G5 && IN(P + 6)) REP(7) { pg8::Gemm g{H, (const bf16_t*)(ws + WS_WUP) + (size_t)i * NUP * DM, MT, NUP, DM, DM}; RangeOrder S; S.init(0, pm_hi, NUP, G, bx);
                EpiUpConv E{Gb, EA, EB, cwp, cbp, (LAS float*)(lds + 132096)}; S.donectr = (unsigned*)(ws + WS_CTL) + CW_DONE + 64 * (2 * i + 1);
#if PROBE_KIND
                if (PROBE_SITE == 0 && i == 2) pg8::gemm_phase<EpiUpConv, RangeOrder, true>(lds, g, S, E, (unsigned long long*)(ws + 512 * 1024) + 64 * bx); else
#endif
                pg8::gemm_phase<EpiUpConv, RangeOrder>(lds, g, S, E, nullptr);
                BG_TAIL(pm_hi * (NUP / 256), 2 * i + 1); }
            SEAM(P + 6);
            if (EN_CONV && IN(P + 7)) REP(8) { TL phase_ffn_fix(Gb, EA, EB, cwp, cbp, pm_hi, tid); }
            SEAM(P + 7);
            if (EN_G6 && IN(P + 8)) { const bf16_t* Wt = (const bf16_t*)(ws + WS_WDN) + (size_t)i * DM * DFF;
                if (!last) { TL bg_run(a, lds, i + 1, i + 1, 1 << 30, (const unsigned*)nullptr, 0u, tid, lane, wave); __syncthreads(); }
                pg8::Gemm g{Gb, Wt, MT, DM, DFF, DFF}; RangeOrder S; S.init(0, MX / 256, DM, G, bx);
                EpiRes E{(const float*)nullptr, X, X, modl + 5 * DM};
#if PROBE_KIND
                if (PROBE_SITE == 1 && i == 2) pg8::gemm_phase<EpiRes, RangeOrder, true>(lds, g, S, E, (unsigned long long*)(ws + 512 * 1024) + 64 * bx); else
#endif
                pg8::gemm_phase<EpiRes, RangeOrder>(lds, g, S, E, nullptr);
                if (!last) { pg8::Gemm g2{Gb, Wt, MT, DM, DFF / 4, DFF}; SplitOrder S2; S2.init(DM, DFF, G, bx);
                  EpiPart E2{PART, modl + 5 * DM, DFF / 4}; pg8::gemm_phase<EpiPart, SplitOrder>(lds, g2, S2, E2, nullptr); }
                }
            SEAM(P + 8);
        }
    }
    if (EN_FINAL && IN(37)) { TL phase_final(X, a.in[I_GFINAL], a.out, lane, wave); }
#if PROBE_KIND
    __syncthreads();
    if (blockIdx.x == 0 && threadIdx.x == 0) {
        const unsigned long long* st = (const unsigned long long*)(ws + 512 * 1024) + 64 * PROBE_WG;
        double kl = 0, ep = 0; const int n = PROBE_N;
        for (int u = 1; u < 1 + n; ++u) { kl += (double)(st[2 + 2 * u] - st[3 + 2 * (u - 1)]); ep += (double)(st[3 + 2 * u] - st[2 + 2 * u]); }
        const double cyc = (double)(st[3 + 2 * 20] - st[3 + 2 * 1]), tk = 0;
        float v = 0.f;
        if (PROBE_KIND == 1) v = (float)(kl / n / 100.0);
        if (PROBE_KIND == 2) v = (float)(ep / n / 100.0);
        if (PROBE_KIND == 3) v = (float)((double)(st[63] - st[62]) / 10.0);
        if (PROBE_KIND == 4) v = (float)(cyc / 19.0 / 100.0);
        a.out[0] = v;
    }
#endif
#undef IN
#undef SEAM
}

#ifndef MK_N_LAUNCHES
#define MK_N_LAUNCHES 1
#endif
extern "C" void kernel_launch(void* const* d_in, const int* in_sizes, int n_in, void* d_out, int out_size, void* d_ws, size_t ws_size, hipStream_t stream) {
    static int grid = 0;
    if (grid == 0) {
        if (n_in != 20 || in_sizes[0] != MX * DM || out_size != MX * DM || ws_size < WS_END) {
            fprintf(stderr, "kernel_launch: shape mismatch (n_in %d, in0 %d, out %d, ws %zu, need ws >= %zu); nothing launched\n", n_in, n_in > 0 ? in_sizes[0] : -1, out_size, ws_size, (size_t)WS_END); grid = -1; return; }
        int dev = 0, cus = 0, per_cu = 0;
        if (hipGetDevice(&dev) != hipSuccess || hipDeviceGetAttribute(&cus, hipDeviceAttributeMultiprocessorCount, dev) != hipSuccess) { fprintf(stderr, "kernel_launch: device query failed\n"); grid = -1; return; }
        if (hipFuncSetAttribute((const void*)fwd, hipFuncAttributeMaxDynamicSharedMemorySize, LDS_BYTES) != hipSuccess) { fprintf(stderr, "kernel_launch: hipFuncSetAttribute failed\n"); grid = -1; return; }
        if (hipOccupancyMaxActiveBlocksPerMultiprocessor(&per_cu, (const void*)fwd, NTHREADS, LDS_BYTES) != hipSuccess || per_cu < 1) {
            fprintf(stderr, "kernel_launch: occupancy query reports %d workgroups per CU; nothing launched\n", per_cu); (void)hipGetLastError(); grid = -1; return; }
        grid = cus;
    }
    if (grid < 0) return;
    if (hipMemsetAsync((char*)d_ws + WS_CTL, 0, CTL_ZERO_BYTES, stream) != hipSuccess) { fprintf(stderr, "kernel_launch: memset failed\n"); return; }
    Args a{};
    for (int i = 0; i < 20; ++i) a.in[i] = (const float*)d_in[i];
    a.out = (float*)d_out; a.ws = (unsigned char*)d_ws; a.pad = 0;
    constexpr int NL = MK_N_LAUNCHES;
    for (int li = 0; li < NL; ++li) {
        a.ph_lo = (int)((long)li * N_PHASES / NL); a.ph_hi = (int)((long)(li + 1) * N_PHASES / NL); a.li = li;
        hipLaunchKernelGGL(fwd, dim3(grid), dim3(NTHREADS), LDS_BYTES, stream, a);
        const hipError_t le = hipPeekAtLastError();
        if (le != hipSuccess) { fprintf(stderr, "kernel_launch: launch %d failed: %s\n", li, hipGetErrorName(le)); break; }
    }
}
```

```cpp
#include <hip/hip_runtime.h>
namespace pg8 {
#define PG8_LAS __attribute__((address_space(3)))
typedef unsigned short bf16_t;
typedef short bf16x8 __attribute__((ext_vector_type(8)));
typedef float f32x4 __attribute__((ext_vector_type(4)));
typedef unsigned u32x4 __attribute__((ext_vector_type(4)));
constexpr int BM = 256, BK = 64, HALF = 128, HTB = HALF * BK * 2  , STAGE_BYTES = 8 * HTB, NXCD = 8, WGM = 4;

__host__ __device__ __forceinline__ int lds_byte(int r, int c) { const int st = (r >> 4) * 2 + (c >> 5), rr = r & 15, cc = c & 31, ob = rr * 64 + cc * 2; return st * 1024 + (ob ^ (((ob >> 9) & 1) << 5)); }
__host__ __device__ __forceinline__ void stage_rc(int b, int& R, int& C) { const int st = b / 1024, sb = b % 1024, swz = sb ^ (((sb >> 9) & 1) << 5); R = (st >> 1) * 16 + swz / 64; C = (st & 1) * 32 + (swz % 64) / 2; }
__host__ __device__ __forceinline__ int perm32(int rho) { const int n = rho >> 4, i = rho & 15; return 8 * (i >> 2) + 4 * n + (i & 3); }

struct Unit { int pm, pn, k0; };
struct Gemm { const bf16_t* A; const bf16_t* Bt; int M, N, K, ld; };

struct StaticOrder {
    int nM, nN, nwg, G, c;
    __host__ __device__ void init(int M, int N, int G_, int c_) { nM = M / BM; nN = N / BM; nwg = nM * nN; G = G_; c = c_; }
    __host__ __device__ bool next(int i, Unit& u) const {
        const long L = (long)i * G + c; if (L >= nwg) return false;
        int wgid = (int)L; { const int q = nwg / NXCD, r = nwg % NXCD, xcd = wgid % NXCD, off = wgid / NXCD; wgid = (xcd < r ? xcd * (q + 1) : r * (q + 1) + (xcd - r) * q) + off; }
        const int nig = WGM * nN, gid = wgid / nig, fm = gid * WGM, gsz = (nM - fm) < WGM ? (nM - fm) : WGM;
        u.pm = fm + ((wgid % nig) % gsz); u.pn = (wgid % nig) / gsz; u.k0 = 0; return true;
    }
    __device__ __forceinline__ void a_ready(const Unit&) const {}
    __device__ __forceinline__ void done(const Unit&) const {}
};
struct CountedOrder : StaticOrder {
    const unsigned* ready; unsigned need; unsigned* tmo;
    __device__ __forceinline__ void a_ready(const Unit& u) const {
        if (threadIdx.x < 64) {
            const unsigned long long t0 = __builtin_amdgcn_s_memrealtime(); unsigned polls = 0;
            while ((unsigned)__builtin_amdgcn_readfirstlane(__hip_atomic_load(ready + 64 * u.pm, __ATOMIC_RELAXED, __HIP_MEMORY_SCOPE_AGENT)) < need) {
                if ((++polls & 255u) == 0u && __builtin_amdgcn_readfirstlane(__hip_atomic_load(tmo, __ATOMIC_RELAXED, __HIP_MEMORY_SCOPE_AGENT)) != 0u) break;
                if (__builtin_amdgcn_s_memrealtime() - t0 > 2000000ull) {
                    if (threadIdx.x == 0) { unsigned expect = 0u; __hip_atomic_compare_exchange_strong(tmo + 1, &expect, 0x600u | (unsigned)(u.pm & 0xff), __ATOMIC_RELAXED, __ATOMIC_RELAXED, __HIP_MEMORY_SCOPE_AGENT); __hip_atomic_store(tmo, 1u, __ATOMIC_RELAXED, __HIP_MEMORY_SCOPE_AGENT); }
                    break; }
                __builtin_amdgcn_s_sleep(2); }
            __builtin_amdgcn_fence(__ATOMIC_ACQUIRE, "agent");
            asm volatile("s_waitcnt vmcnt(0)" ::: "memory");
        }
#if !defined(BROKEN_HOOK_NO_BARRIER)
        asm volatile("" ::: "memory"); __builtin_amdgcn_s_barrier(); asm volatile("" ::: "memory");
#endif
    }
};

template <class Epi, class Sched, bool STAMP = false>
__device__ __forceinline__ void gemm_phase(PG8_LAS unsigned char* lds, const Gemm g, const Sched& S, const Epi& E, unsigned long long* stamps) {
    int tid_l = threadIdx.x; asm volatile("" : "+v"(tid_l));
    const int tid = tid_l, wid = __builtin_amdgcn_readfirstlane(tid >> 6), lane = tid & 63, wr = wid >> 2, wc = wid & 3, fr = lane & 15, fq = lane >> 4;
    const int K = g.ld, nt = g.K / BK;
    int ts_lo = 0, ts_hi = 0, nts = 0; const unsigned long long rt_entry = STAMP ? (unsigned long long)wall_clock64() : 0ull;
#define PG8_STAMP() do { if (STAMP && wid == 0 && nts < 64) { const unsigned long long _c = (unsigned long long)clock64(); \
        ts_lo = (lane == nts) ? (int)(unsigned)_c : ts_lo; ts_hi = (lane == nts) ? (int)(unsigned)(_c >> 32) : ts_hi; ++nts; } } while (0)
    PG8_STAMP();
    unsigned voffA[2], voffB[2];
#pragma unroll
    for (int i = 0; i < 2; ++i) { int R, C; stage_rc(tid * 16 + i * 8192, R, C); const int Rb = Epi::PERM ? ((R & ~31) + perm32(R & 31)) : R;
        voffA[i] = (unsigned)(R * K + C) * 2u; voffB[i] = (unsigned)(Rb * K + C) * 2u; }
    const size_t kstep = (size_t)(BK * 2);
    const size_t hstep = (size_t)HALF * K * 2;
    const size_t tstep = 2 * hstep;
    const unsigned ldsw = (unsigned)wid * 1024u;
    const int aoff = lds_byte(wr * 64 + fr, fq * 8), boff = lds_byte(wc * 32 + fr, fq * 8);
#define PG8_SA(b, h) (((b) * 2 + (h)) * HTB)
#define PG8_SB(b, h) ((4 + (b) * 2 + (h)) * HTB)
#define PG8_STAGE(bufoff, gbase, voff) do { _Pragma("unroll") for (int _i = 0; _i < 2; ++_i) \
        __builtin_amdgcn_global_load_lds((const unsigned*)((const char*)(gbase) + (voff)[_i]), (PG8_LAS unsigned*)(lds + (bufoff) + ldsw + _i * 8192), 16, 0, 0); } while (0)
#define PG8_LDA(dst, b, h) do { _Pragma("unroll") for (int m = 0; m < 4; ++m) _Pragma("unroll") for (int k = 0; k < 2; ++k) dst[m][k] = *(const PG8_LAS bf16x8*)(lds + PG8_SA(b, h) + aoff + m * 2048 + k * 1024); } while (0)
#define PG8_LDB(dst, b, h) do { _Pragma("unroll") for (int n = 0; n < 2; ++n) _Pragma("unroll") for (int k = 0; k < 2; ++k) dst[n][k] = *(const PG8_LAS bf16x8*)(lds + PG8_SB(b, h) + boff + n * 2048 + k * 1024); } while (0)
#define PG8_MMA(ai, bj, At, Bt) do { __builtin_amdgcn_s_setprio(1); _Pragma("unroll") for (int m = 0; m < 4; ++m) _Pragma("unroll") for (int n = 0; n < 2; ++n) _Pragma("unroll") for (int k = 0; k < 2; ++k) \
        acc[ai][bj][m][n] = __builtin_amdgcn_mfma_f32_16x16x32_bf16(Bt[n][k], At[m][k], acc[ai][bj][m][n], 0, 0, 0); __builtin_amdgcn_s_setprio(0); } while (0)
#define PG8_WAIT_V(n) asm volatile("s_waitcnt vmcnt(" #n ")" ::: "memory")
#define PG8_WAIT_L(n) asm volatile("s_waitcnt lgkmcnt(" #n ")" ::: "memory")
#define PG8_BAR __builtin_amdgcn_s_barrier()
#define PG8_SCHED __builtin_amdgcn_sched_barrier(0)
    Unit cur, nxt; int ui = 0;
    if (!S.next(0, cur)) return;
    f32x4 acc[2][2][4][2];
#pragma unroll
    for (int a = 0; a < 2; ++a)
#pragma unroll
        for (int b = 0; b < 2; ++b)
#pragma unroll
            for (int m = 0; m < 4; ++m)
#pragma unroll
                for (int n = 0; n < 2; ++n) acc[a][b][m][n] = (f32x4){0.f, 0.f, 0.f, 0.f};
    bf16x8 At[4][2], B0[2][2], B1[2][2];
    const char* cA = (const char*)g.A + (size_t)cur.pm * tstep + (size_t)cur.k0 * 2; const char* cB = (const char*)g.Bt + (size_t)cur.pn * tstep + (size_t)cur.k0 * 2;
    S.a_ready(cur);
    PG8_STAGE(PG8_SB(0, 0), cB, voffB); PG8_STAGE(PG8_SA(0, 0), cA, voffA); PG8_STAGE(PG8_SB(0, 1), cB + hstep, voffB); PG8_STAGE(PG8_SA(0, 1), cA + hstep, voffA);
    if (wr == 1) PG8_BAR;
    PG8_WAIT_V(4); PG8_BAR;
    PG8_STAGE(PG8_SB(1, 0), cB + kstep, voffB); PG8_STAGE(PG8_SA(1, 0), cA + kstep, voffA); PG8_STAGE(PG8_SB(1, 1), cB + hstep + kstep, voffB);
    PG8_WAIT_V(6); PG8_BAR;
    PG8_STAMP();
    for (;;) {
        const bool has_next = S.next(ui + 1, nxt);
        const char* nA = has_next ? (const char*)g.A + (size_t)nxt.pm * tstep + (size_t)nxt.k0 * 2 : cA; const char* nB = has_next ? (const char*)g.Bt + (size_t)nxt.pn * tstep + (size_t)nxt.k0 * 2 : cB;
        for (int t = 0; t < nt; t += 2) {
            const bool last = (t == nt - 2);
            const char* a1 = cA + (size_t)(t + 1) * kstep;
            const char* a2 = last ? nA : cA + (size_t)(t + 2) * kstep; const char* b2 = last ? nB : cB + (size_t)(t + 2) * kstep;
            const char* a3 = a2 + kstep; const char* b3 = b2 + kstep;
            if (last && has_next) S.a_ready(nxt);
            PG8_LDB(B0, 0, 0); PG8_SCHED; PG8_LDA(At, 0, 0); PG8_STAGE(PG8_SA(1, 1), a1 + hstep, voffA);
            PG8_WAIT_L(8); PG8_BAR; PG8_WAIT_L(0); PG8_MMA(0, 0, At, B0); PG8_BAR; PG8_SCHED;
            PG8_LDB(B1, 0, 1); PG8_STAGE(PG8_SB(0, 0), b2, voffB);
            PG8_BAR; PG8_WAIT_L(0); PG8_MMA(0, 1, At, B1); PG8_BAR;
            PG8_LDA(At, 0, 1); PG8_STAGE(PG8_SA(0, 0), a2, voffA);
            PG8_BAR; PG8_WAIT_L(0); PG8_MMA(1, 0, At, B0); PG8_BAR; PG8_SCHED;
            PG8_STAGE(PG8_SB(0, 1), b2 + hstep, voffB);
            PG8_WAIT_V(6); PG8_BAR; PG8_MMA(1, 1, At, B1); PG8_BAR;
            PG8_LDB(B0, 1, 0); PG8_SCHED; PG8_LDA(At, 1, 0); PG8_STAGE(PG8_SA(0, 1), a2 + hstep, voffA);
            PG8_WAIT_L(8); PG8_BAR; PG8_WAIT_L(0); PG8_MMA(0, 0, At, B0); PG8_BAR; PG8_SCHED;
            PG8_LDB(B1, 1, 1); PG8_STAGE(PG8_SB(1, 0), b3, voffB);
            PG8_BAR; PG8_WAIT_L(0); PG8_MMA(0, 1, At, B1); PG8_BAR;
            PG8_LDA(At, 1, 1); PG8_STAGE(PG8_SA(1, 0), a3, voffA);
            PG8_BAR; PG8_WAIT_L(0); PG8_MMA(1, 0, At, B0); PG8_BAR; PG8_SCHED;
            PG8_STAGE(PG8_SB(1, 1), b3 + hstep, voffB);
            PG8_WAIT_V(6); PG8_BAR; PG8_MMA(1, 1, At, B1); PG8_BAR;
        }
        PG8_STAMP();
        if constexpr (!Epi::AFTER_DRAIN) { E(acc, cur, wr, wc, fr, fq); S.done(cur); }
        PG8_STAMP();
        if (!has_next) break;
#pragma unroll
        for (int a = 0; a < 2; ++a)
#pragma unroll
            for (int b = 0; b < 2; ++b)
#pragma unroll
                for (int m = 0; m < 4; ++m)
#pragma unroll
                    for (int n = 0; n < 2; ++n) acc[a][b][m][n] = (f32x4){0.f, 0.f, 0.f, 0.f};
        cur = nxt; cA = nA; cB = nB; ++ui;
    }
    PG8_WAIT_V(0);
    if (wr == 0) PG8_BAR;
    PG8_BAR;
    if constexpr (Epi::AFTER_DRAIN) { E.fused(acc, cur, wr, wc, fr, fq, lds, wid, lane); S.done(cur); }
    PG8_STAMP();
    if (STAMP && wid == 0) { stamps[lane] = lane < nts ? (((unsigned long long)(unsigned)ts_hi << 32) | (unsigned)ts_lo) : 0ull;
        if (lane == 62) stamps[62] = rt_entry; if (lane == 63) stamps[63] = (unsigned long long)wall_clock64(); }
#undef PG8_STAMP
#undef PG8_SA
#undef PG8_SB
#undef PG8_STAGE
#undef PG8_LDA
#undef PG8_LDB
#undef PG8_MMA
#undef PG8_WAIT_V
#undef PG8_WAIT_L
#undef PG8_BAR
#undef PG8_SCHED
}
}
#ifndef DUP_MASK
#define DUP_MASK 0
#endif

#include <cstdio>
#include <cstdint>
#define LAS __attribute__((address_space(3)))
typedef unsigned short bf16_t;
typedef short bf16x8 __attribute__((ext_vector_type(8)));
typedef short s16x4 __attribute__((ext_vector_type(4)));
typedef float f32x4 __attribute__((ext_vector_type(4)));
typedef float f32x8 __attribute__((ext_vector_type(8)));
typedef float f32x16 __attribute__((ext_vector_type(16)));
typedef unsigned u32x4 __attribute__((ext_vector_type(4)));
typedef unsigned u32x2 __attribute__((ext_vector_type(2)));

constexpr int DM = 2048, NBATCH = 8, SEQ = 4096, CTXL = 256;
constexpr int MX = NBATCH * SEQ, MC = NBATCH * CTXL, MT = MX + MC;
constexpr int NQKV = 3072, NMI = 6144, NMI_RAW = 6176, NMI_PAD = 6400, DFF = 5632, NUP = 2 * DFF;
constexpr int MODW = 6 * DM;
constexpr float RMS_EPS = 1e-6f;
constexpr int NTHREADS = 512, NWAVES = 8;

constexpr size_t MiB = 1u << 20;
constexpr size_t WS_CTL = 0, CTL_ZERO_BYTES = 1 * MiB;
constexpr size_t WS_MOD = 1 * MiB;
constexpr size_t WS_ROPE = 3 * MiB;
constexpr size_t WS_WQKV = 8 * MiB;
constexpr size_t WS_WAO = 32 * MiB;
constexpr size_t WS_WMI = 48 * MiB;
constexpr size_t WS_WMO = 98 * MiB;
constexpr size_t WS_WUP = 114 * MiB;
constexpr size_t WS_WDN = 290 * MiB;
constexpr size_t WS_X = 378 * MiB;
constexpr size_t WS_H = 650 * MiB;
constexpr size_t WS_Z = 786 * MiB;
constexpr size_t WS_GATE = 1194 * MiB;
constexpr size_t WS_HF = 1200 * MiB;
constexpr size_t WS_HB = 1336 * MiB;
constexpr size_t WS_END = 1472 * MiB;
constexpr int CW_TMO = 0;
constexpr int CW_BAR = 4096;

constexpr int LDS_BYTES = 147456;
constexpr int MISC_OFF = LDS_BYTES - 256;

#define XB_TMO      128
#define XB_XCNT(j)  (256  + 64 * (j))
#define XB_XSUB(j)  (1280 + 64 * (j))
#define XB_XGEN(j)  (2304 + 64 * (j))
#define XB_TOP      3328
#define XB_TOPGEN   3392
#define XCD_BAR_WORDS 3456
#define XB_SPIN_CAP (1u << 18)

__device__ __forceinline__ unsigned xb_ld(unsigned* p)              { return __hip_atomic_load(p, __ATOMIC_RELAXED, __HIP_MEMORY_SCOPE_AGENT); }
__device__ __forceinline__ unsigned xb_add(unsigned* p, unsigned v) { return __hip_atomic_fetch_add(p, v, __ATOMIC_RELAXED, __HIP_MEMORY_SCOPE_AGENT); }
__device__ __forceinline__ unsigned xb_xcc_id() { return (unsigned)__builtin_amdgcn_s_getreg((3 << 11) | 20) & 0xFu; }
#define XB_SPIN(cond, bar) do { unsigned _sp = 0; while (cond) { __builtin_amdgcn_s_sleep(1); \
    if ((++_sp & 255u) == 0u) { if (xb_ld(&(bar)[XB_TMO])) break; if (_sp > XB_SPIN_CAP) { atomicAdd(&(bar)[XB_TMO], 1u); break; } } } } while (0)

struct XcdBarrier { unsigned* bar; unsigned x; volatile LAS unsigned* st; };

__device__ __forceinline__ XcdBarrier xcd_barrier_post(unsigned* bar, volatile LAS unsigned* st) {
    XcdBarrier b; b.bar = bar; b.x = xb_xcc_id(); b.st = st;
    if (threadIdx.x == 0) (void)xb_add(&bar[XB_XCNT(b.x)], 1u);
    return b;
}
__device__ __forceinline__ void xcd_barrier_complete(unsigned* bar, unsigned x, unsigned& nloc, unsigned& nx) {
    const unsigned G = gridDim.x * gridDim.y * gridDim.z;
    unsigned sum, cnt, mine, sp = 0u;
    for (;;) {
        sum = 0u; cnt = 0u; mine = 0u;
#pragma unroll
        for (unsigned j = 0; j < 16; ++j) { const unsigned c = xb_ld(&bar[XB_XCNT(j)]); sum += c; cnt += (c > 0u) ? 1u : 0u; mine = (j == x) ? c : mine; }
        if (sum == G) break;
        __builtin_amdgcn_s_sleep(1);
        if ((++sp & 255u) == 0u) { if (xb_ld(&bar[XB_TMO])) break; if (sp > XB_SPIN_CAP) { atomicAdd(&bar[XB_TMO], 1u); break; } }
    }
    nloc = mine > 0u ? mine : 1u; nx = cnt > 0u ? cnt : 1u;
}
__device__ __forceinline__ void xcd_barrier(const XcdBarrier& b) {
    asm volatile("s_waitcnt vmcnt(0)" ::: "memory");
    __syncthreads();
    if (threadIdx.x == 0) {
        unsigned* bar = b.bar;
        __builtin_amdgcn_s_waitcnt(0);
        unsigned nloc = b.st[0], nx = b.st[1];
        if (nloc == 0u) { xcd_barrier_complete(bar, b.x, nloc, nx); b.st[0] = nloc; b.st[1] = nx; }
        const unsigned old = xb_add(&bar[XB_XSUB(b.x)], 1u);
        const unsigned gen = old / nloc;
        if (old + 1u == (gen + 1u) * nloc) {
            __builtin_amdgcn_fence(__ATOMIC_RELEASE, "agent");
            asm volatile("s_waitcnt vmcnt(0)" ::: "memory");
            const unsigned og = xb_add(&bar[XB_TOP], 1u);
            const unsigned tg = og / nx;
            if (og + 1u == (tg + 1u) * nx) xb_add(&bar[XB_TOPGEN], 1u);
            else XB_SPIN(xb_ld(&bar[XB_TOPGEN]) == tg, bar);
            __builtin_amdgcn_fence(__ATOMIC_ACQUIRE, "agent");
            xb_add(&bar[XB_XGEN(b.x)], 1u);
            asm volatile("s_waitcnt vmcnt(0)" ::: "memory");
        } else {
            XB_SPIN(xb_ld(&bar[XB_XGEN(b.x)]) == gen, bar);
            __builtin_amdgcn_fence(__ATOMIC_ACQUIRE, "agent");
            asm volatile("s_waitcnt vmcnt(0)" ::: "memory");
        }
    }
    __syncthreads();
}

#define LDS_WAIT() asm volatile("s_waitcnt lgkmcnt(0)" ::: "memory")
__device__ __forceinline__ unsigned cvtpk(float lo, float hi) { unsigned r; asm volatile("v_cvt_pk_bf16_f32 %0, %1, %2" : "=v"(r) : "v"(lo), "v"(hi)); return r; }
__device__ __forceinline__ float bf2f(bf16_t b) { return __uint_as_float(((unsigned)b) << 16); }
__device__ __forceinline__ float bflo(unsigned w) { return __uint_as_float(w << 16); }
__device__ __forceinline__ float bfhi(unsigned w) { return __uint_as_float(w & 0xffff0000u); }
__device__ __forceinline__ float wave_sum(float v) {
#pragma unroll
    for (int o = 1; o < 64; o <<= 1) v += __shfl_xor(v, o);
    return v;
}
__device__ __forceinline__ float silu_f(float v) { return v * __builtin_amdgcn_rcpf(1.0f + __expf(-v)); }
__device__ __forceinline__ float sigmoid_f(float v) { return __builtin_amdgcn_rcpf(1.0f + __expf(-v)); }
__device__ __forceinline__ float log_sigmoid_f(float v) { return v < 0.f ? v - log1pf(expf(v)) : -log1pf(expf(-v)); }

struct Args { const float* in[20]; float* out; unsigned char* ws; int ph_lo, ph_hi; int li, pad; };
enum { I_X = 0, I_C, I_CTX, I_CCTX, I_WMOD, I_BMOD, I_GMIX, I_GFFN, I_WQKV, I_SINK, I_WAO, I_WMI, I_BMI, I_GHEAD, I_WMO, I_WUP, I_CONVW, I_CONVB, I_WDN, I_GFINAL };

__device__ __forceinline__ void p0_transpose_item(const float* W, int K, int N, bf16_t* WT, LAS float* scr, int item, int lane, int mapkind) {
    const int nblk = (N + 63) / 64, kb = item / nblk, nb = item % nblk, k0 = 64 * kb, n0 = 64 * nb;
    f32x4 v[16];
    const int nn = (lane & 15) * 4; const bool nok = n0 + nn < N;
#pragma unroll
    for (int i = 0; i < 16; ++i) { const int kk = 4 * i + (lane >> 4); v[i] = nok ? __builtin_nontemporal_load((const f32x4*)(W + (size_t)(k0 + kk) * N + n0 + nn)) : (f32x4){0.f, 0.f, 0.f, 0.f}; }
#pragma unroll
    for (int i = 0; i < 16; ++i) { const int kk = 4 * i + (lane >> 4); LAS float* d = scr + kk * 65 + nn; d[0] = v[i][0]; d[1] = v[i][1]; d[2] = v[i][2]; d[3] = v[i][3]; }
    LDS_WAIT(); asm volatile("" ::: "memory");
    const int c = lane & 7;
#pragma unroll
    for (int j = 0; j < 8; ++j) { const int n = (lane >> 3) + 8 * j, nc = n0 + n;
        int row = nc;
        if (mapkind == 1) row = nc < DFF ? 256 * (nc / 128) + (nc % 128) : 256 * ((nc - DFF) / 128) + 128 + ((nc - DFF) % 128);
        if (mapkind == 2 && nc < 2560) { const int d0 = nc % 128; row = (nc - d0) + 2 * (d0 % 64) + d0 / 64; }
        const LAS float* s = scr + (8 * c) * 65 + n;
        u32x4 o; o.x = cvtpk(s[0 * 65], s[1 * 65]); o.y = cvtpk(s[2 * 65], s[3 * 65]); o.z = cvtpk(s[4 * 65], s[5 * 65]); o.w = cvtpk(s[6 * 65], s[7 * 65]);
        if (nc < N) *(u32x4*)(WT + (size_t)row * K + k0 + 8 * c) = o; }
    LDS_WAIT(); asm volatile("" ::: "memory");
}
__device__ __forceinline__ void get_mat(const Args& a, int m, const float*& W, bf16_t*& WT, int& K, int& N) {
    unsigned char* ws = a.ws;
    if (m < 2)       { K = DM;  N = NQKV;    W = a.in[I_WQKV] + (size_t)m * DM * NQKV;          WT = (bf16_t*)(ws + WS_WQKV) + (size_t)m * NQKV * DM; }
    else if (m < 4)  { K = DM;  N = DM;      W = a.in[I_WAO] + (size_t)(m - 2) * DM * DM;       WT = (bf16_t*)(ws + WS_WAO) + (size_t)(m - 2) * DM * DM; }
    else if (m < 6)  { K = DM;  N = NMI_RAW; W = a.in[I_WMI] + (size_t)(m - 4) * DM * NMI_RAW;  WT = (bf16_t*)(ws + WS_WMI) + (size_t)(m - 4) * NMI_PAD * DM; }
    else if (m < 8)  { K = DM;  N = DM;      W = a.in[I_WMO] + (size_t)(m - 6) * DM * DM;       WT = (bf16_t*)(ws + WS_WMO) + (size_t)(m - 6) * DM * DM; }
    else if (m < 12) { K = DM;  N = NUP;     W = a.in[I_WUP] + (size_t)(m - 8) * DM * NUP;      WT = (bf16_t*)(ws + WS_WUP) + (size_t)(m - 8) * NUP * DM; }
    else             { K = DFF; N = DM;      W = a.in[I_WDN] + (size_t)(m - 12) * DFF * DM;     WT = (bf16_t*)(ws + WS_WDN) + (size_t)(m - 12) * DM * DFF; }
}
constexpr int CW_BG = 2048;
__device__ __forceinline__ int bg_mat(int L, int q) {
    return q == 0 ? ((L & 1) ? 4 + (L >> 1) : (L >> 1)) : (q == 1 ? ((L & 1) ? 6 + (L >> 1) : 2 + (L >> 1)) : (q == 2 ? 8 + L : 12 + L));
}
__device__ __forceinline__ int bg_items(int m) { const int K = m >= 12 ? DFF : DM, N = m < 2 ? NQKV : (m < 4 ? DM : (m < 6 ? NMI_RAW : (m < 8 ? DM : (m < 12 ? NUP : DM)))); return (K / 64) * ((N + 63) / 64); }
__device__ __forceinline__ void bg_run(const Args& a, LAS unsigned char* lds, int L_lo, int L_hi, int max_claims, const unsigned* donectr, unsigned done_total, int tid, int lane, int wave) {
    unsigned* ctr = (unsigned*)(a.ws + WS_CTL) + CW_BG;
    LAS unsigned* slot = (LAS unsigned*)(lds + 8 * 17408);
    LAS float* scr = (LAS float*)(lds + wave * 17408);
    int claims = 0;
    for (int L = L_lo; L <= L_hi; ++L) {
        const int n0 = bg_items(bg_mat(L, 0)), n1 = n0 + bg_items(bg_mat(L, 1)), n2 = n1 + bg_items(bg_mat(L, 2)), total = n2 + bg_items(bg_mat(L, 3));
        for (;;) {
            if (claims >= max_claims) return;
            __syncthreads();
            if (tid == 0) { unsigned v = 0x7fffffffu;
                if (donectr == nullptr || __hip_atomic_load(donectr, __ATOMIC_RELAXED, __HIP_MEMORY_SCOPE_AGENT) < done_total) v = __hip_atomic_fetch_add(ctr + 64 * L, 8u, __ATOMIC_RELAXED, __HIP_MEMORY_SCOPE_AGENT);
                *slot = v; }
            __syncthreads();
            const int base = (int)*slot;
            if (base == 0x7fffffff) return;
            if (base >= total) break;
            ++claims;
            const int it = base + wave;
            if (it < total) {
                const int q = it < n0 ? 0 : (it < n1 ? 1 : (it < n2 ? 2 : 3)); const int m = bg_mat(L, q); const int loc = it - (q == 0 ? 0 : (q == 1 ? n0 : (q == 2 ? n1 : n2)));
                const float* W; bf16_t* WT; int K, N; get_mat(a, m, W, WT, K, N);
                p0_transpose_item(W, K, N, WT, scr, loc, lane, (m >= 8 && m < 12) ? 1 : (m < 2 ? 2 : 0));
            }
        }
    }
}
constexpr int CW_GATEQ = 3072;
__device__ __forceinline__ void gate_run(const Args& a, LAS unsigned char* lds, const bf16_t* Hm, const bf16_t* Wg, const float* bg, float* gates, int j, int tid, int lane, int wave) {
    unsigned* ctr = (unsigned*)(a.ws + WS_CTL) + CW_GATEQ + 64 * j;
    LAS unsigned* slot = (LAS unsigned*)(lds + 8 * 17408);
    const int r = lane & 31, h = lane >> 5;
    for (;;) {
        __syncthreads();
        if (tid == 0) *slot = __hip_atomic_fetch_add(ctr, 1u, __ATOMIC_RELAXED, __HIP_MEMORY_SCOPE_AGENT);
        __syncthreads();
        const int pm = (int)*slot;
        if (pm >= MT / 256) break;
        const int row0 = pm * 256 + 32 * wave;
        const bf16_t* ap = Hm + (size_t)(row0 + r) * DM + 8 * h; const bf16_t* bp = Wg + (size_t)r * DM + 8 * h;
        f32x16 acc;
#pragma unroll
        for (int i = 0; i < 16; ++i) acc[i] = 0.f;
        for (int k8 = 0; k8 < DM / 16; k8 += 8) {
            bf16x8 av[8], bv[8];
#pragma unroll
            for (int u = 0; u < 8; ++u) { av[u] = *(const bf16x8*)(ap + 16 * (k8 + u)); bv[u] = *(const bf16x8*)(bp + 16 * (k8 + u)); }
#pragma unroll
            for (int u = 0; u < 8; ++u) acc = __builtin_amdgcn_mfma_f32_32x32x16_bf16(av[u], bv[u], acc, 0, 0, 0);
        }
        const float bias = bg[r]; const bool ls = (r & 8) != 0;
#pragma unroll
        for (int i = 0; i < 16; ++i) { const int row = row0 + (i & 3) + 8 * (i >> 2) + 4 * h; float v = acc[i] + bias; if (ls) v = log_sigmoid_f(v); gates[(size_t)row * 32 + r] = v; }
    }
}
__device__ __forceinline__ void phase_prologue(const Args& a, LAS unsigned char* lds, int tid, int lane, int wave) {
    const int gw = blockIdx.x * NWAVES + wave, NGW = gridDim.x * NWAVES;
    LAS float* scr = (LAS float*)(lds + wave * 17408);
    for (int rpa = 0; rpa < (((DUP_MASK) >> 9) & 1) + 1; ++rpa)
    for (int q = 0; q < 4; ++q) {
        const int m = bg_mat(0, q);
        const float* W; bf16_t* WT; int K, N; get_mat(a, m, W, WT, K, N);
        const int nitems = (K / 64) * ((N + 63) / 64);
        for (int it = gw; it < nitems; it += NGW) p0_transpose_item(W, K, N, WT, scr, it, lane, (m >= 8 && m < 12) ? 1 : (m < 2 ? 2 : 0));
    }
    {
        const size_t per = (size_t)(NMI_PAD - NMI_RAW) * DM / 8;
        const size_t gt = (size_t)blockIdx.x * NTHREADS + tid, GT = (size_t)gridDim.x * NTHREADS;
        for (size_t e = gt; e < 2 * per; e += GT) { const size_t j = e / per, o = e % per;
            *(u32x4*)((bf16_t*)(a.ws + WS_WMI) + j * NMI_PAD * DM + (size_t)NMI_RAW * DM + o * 8) = (u32x4){0u, 0u, 0u, 0u}; }
        float* rc = (float*)(a.ws + WS_ROPE); float* rs = (float*)(a.ws + WS_ROPE + 1 * MiB);
        for (size_t e = gt; e < (size_t)SEQ * 64; e += GT) { const int t = (int)(e >> 6), jj = (int)(e & 63), fi = jj & 31;
            const float inv = __builtin_amdgcn_exp2f(-(float)fi * (13.287712379549449f / 32.0f)); const float pos = (float)(jj < 32 ? (t >> 6) : (t & 63)); const float rev = pos * inv * 0.15915494309189535f;
            rc[e] = __builtin_amdgcn_cosf(rev); rs[e] = __builtin_amdgcn_sinf(rev); }
    }
    __syncthreads();
    for (int rpd = 0; rpd < (((DUP_MASK) >> 10) & 1) + 1; ++rpd)
    for (int bt = blockIdx.x; bt < 192; bt += gridDim.x) {
        LAS float* sc = (LAS float*)lds;
#pragma unroll
        for (int u = 0; u < 9; ++u) { const int e = 4 * (tid + NTHREADS * u);
            const f32x4 v = u < 8 ? *(const f32x4*)(a.in[I_C] + e) : *(const f32x4*)(a.in[I_CCTX] + (e - 8 * DM));
            *(LAS f32x4*)(sc + e) = (f32x4){v[0] / (1.0f + __expf(-v[0])), v[1] / (1.0f + __expf(-v[1])), v[2] / (1.0f + __expf(-v[2])), v[3] / (1.0f + __expf(-v[3]))}; }
        __syncthreads();
        const int i = bt / 48, n0 = (bt % 48) * 256 + wave * 32 + (lane & 7) * 4, kp = lane >> 3;
        float acc[9][4];
#pragma unroll
        for (int r = 0; r < 9; ++r) { acc[r][0] = 0.f; acc[r][1] = 0.f; acc[r][2] = 0.f; acc[r][3] = 0.f; }
        const float* wp = a.in[I_WMOD] + (size_t)i * DM * MODW + n0;
#pragma unroll 8
        for (int k = kp; k < DM; k += 8) {
            const f32x4 w = __builtin_nontemporal_load((const f32x4*)(wp + (size_t)k * MODW));
#pragma unroll
            for (int r = 0; r < 9; ++r) { const float s = sc[r * DM + k]; acc[r][0] = fmaf(s, w[0], acc[r][0]); acc[r][1] = fmaf(s, w[1], acc[r][1]); acc[r][2] = fmaf(s, w[2], acc[r][2]); acc[r][3] = fmaf(s, w[3], acc[r][3]); }
        }
#pragma unroll
        for (int r = 0; r < 9; ++r)
#pragma unroll
            for (int j = 0; j < 4; ++j) { float v = acc[r][j]; v += __shfl_xor(v, 8); v += __shfl_xor(v, 16); v += __shfl_xor(v, 32); acc[r][j] = v; }
        if (kp == 0) {
            const f32x4 bv = *(const f32x4*)(a.in[I_BMOD] + (size_t)i * MODW + n0);
            float* mo = (float*)(a.ws + WS_MOD) + (size_t)i * 9 * MODW + n0;
#pragma unroll
            for (int r = 0; r < 9; ++r) *(f32x4*)(mo + (size_t)r * MODW) = (f32x4){acc[r][0] + bv[0], acc[r][1] + bv[1], acc[r][2] + bv[2], acc[r][3] + bv[3]};
        }
        __syncthreads();
    }
}

__device__ __forceinline__ void norm_row(int r, const void* xs, bool xs_f32, const void* cs, bool cs_f32, const float* g, const float* modl, int sh_off, int sc_off, bf16_t* H, const float* part, bf16_t* xout, int lane) {
    const bool f32src = r < MX ? xs_f32 : cs_f32; const void* src = r < MX ? xs : cs;
    const int mr = r < MX ? (r >> 12) : 8;
    f32x4 v[8]; float ss = 0.f;
    if (f32src) { const float* xr = (const float*)src + (size_t)r * DM;
#pragma unroll
        for (int j = 0; j < 4; ++j) { v[2 * j] = *(const f32x4*)(xr + 8 * lane + 512 * j); v[2 * j + 1] = *(const f32x4*)(xr + 8 * lane + 512 * j + 4); }
    } else { const bf16_t* xr = (const bf16_t*)src + (size_t)r * DM;
#pragma unroll
        for (int j = 0; j < 4; ++j) { const u32x4 b = *(const u32x4*)(xr + 8 * lane + 512 * j);
            v[2 * j] = (f32x4){bflo(b.x), bfhi(b.x), bflo(b.y), bfhi(b.y)}; v[2 * j + 1] = (f32x4){bflo(b.z), bfhi(b.z), bflo(b.w), bfhi(b.w)}; } }
    if (part != nullptr && r >= MX) {
#pragma unroll
        for (int q = 0; q < 4; ++q) { const float* pr = part + ((size_t)q * MC + (r - MX)) * DM;
#pragma unroll
            for (int j = 0; j < 4; ++j) { v[2 * j] += *(const f32x4*)(pr + 8 * lane + 512 * j); v[2 * j + 1] += *(const f32x4*)(pr + 8 * lane + 512 * j + 4); } }
#pragma unroll
        for (int j = 0; j < 4; ++j) { u32x4 w; w.x = cvtpk(v[2 * j][0], v[2 * j][1]); w.y = cvtpk(v[2 * j][2], v[2 * j][3]); w.z = cvtpk(v[2 * j + 1][0], v[2 * j + 1][1]); w.w = cvtpk(v[2 * j + 1][2], v[2 * j + 1][3]);
            *(u32x4*)(xout + (size_t)r * DM + 8 * lane + 512 * j) = w;
            v[2 * j] = (f32x4){bflo(w.x), bfhi(w.x), bflo(w.y), bfhi(w.y)}; v[2 * j + 1] = (f32x4){bflo(w.z), bfhi(w.z), bflo(w.w), bfhi(w.w)}; }
    }
#pragma unroll
    for (int j = 0; j < 8; ++j) ss += (v[j][0] * v[j][0] + v[j][1] * v[j][1]) + (v[j][2] * v[j][2] + v[j][3] * v[j][3]);
    ss = wave_sum(ss);
    const float rs = 1.0f / sqrtf(ss * (1.0f / DM) + RMS_EPS);
    const float* mrow = modl + (size_t)mr * MODW;
#pragma unroll
    for (int j = 0; j < 4; ++j) { const int col = 8 * lane + 512 * j;
        unsigned o[4];
#pragma unroll
        for (int q = 0; q < 2; ++q) { const f32x4 gg = *(const f32x4*)(g + col + 4 * q), scv = *(const f32x4*)(mrow + sc_off + col + 4 * q), shv = *(const f32x4*)(mrow + sh_off + col + 4 * q);
            float hh[4];
#pragma unroll
            for (int e = 0; e < 4; ++e) hh[e] = (v[2 * j + q][e] * rs * gg[e]) * (1.0f + scv[e]) + shv[e];
            o[2 * q] = cvtpk(hh[0], hh[1]); o[2 * q + 1] = cvtpk(hh[2], hh[3]); }
        *(u32x4*)(H + (size_t)r * DM + col) = (u32x4){o[0], o[1], o[2], o[3]}; }
}
__device__ __forceinline__ void phase_norm(const void* xs, bool xs_f32, const void* cs, bool cs_f32, const float* g, const float* modl, int sh_off, int sc_off, bf16_t* H, int row_end, const float* part, bf16_t* xout, int lane, int wave) {
    const int gw = blockIdx.x * NWAVES + wave, NGW = gridDim.x * NWAVES;
    if (NGW != 2048) { for (int r = gw; r < row_end; r += NGW) norm_row(r, xs, xs_f32, cs, cs_f32, g, modl, sh_off, sc_off, H, part, xout, lane); return; }
    const int b = gw & 7, w8 = gw >> 3;
    f32x4 gs[8], sh[8];
    { const float* mrow = modl + (size_t)b * MODW;
#pragma unroll
      for (int j = 0; j < 4; ++j)
#pragma unroll
        for (int q = 0; q < 2; ++q) { const int col = 8 * lane + 512 * j + 4 * q; const f32x4 gg = *(const f32x4*)(g + col), scv = *(const f32x4*)(mrow + sc_off + col);
            gs[2 * j + q] = gg * (scv + 1.0f); sh[2 * j + q] = *(const f32x4*)(mrow + sh_off + col); } }
    if (MX + gw < row_end) norm_row(MX + gw, xs, xs_f32, cs, cs_f32, g, modl, sh_off, sc_off, H, part, xout, lane);
    for (int k = 14; k >= 0; k -= 2) {
        const int r = b * SEQ + w8 + 256 * k, r2 = r + 256;
        f32x4 va[8], vb[8]; float sa = 0.f, sb = 0.f;
        if (xs_f32) { const float* xa = (const float*)xs + (size_t)r * DM; const float* xb = (const float*)xs + (size_t)r2 * DM;
#pragma unroll
            for (int j = 0; j < 4; ++j) { va[2 * j] = *(const f32x4*)(xa + 8 * lane + 512 * j); va[2 * j + 1] = *(const f32x4*)(xa + 8 * lane + 512 * j + 4);
                vb[2 * j] = *(const f32x4*)(xb + 8 * lane + 512 * j); vb[2 * j + 1] = *(const f32x4*)(xb + 8 * lane + 512 * j + 4); }
        } else { const bf16_t* xa = (const bf16_t*)xs + (size_t)r * DM; const bf16_t* xb = (const bf16_t*)xs + (size_t)r2 * DM;
            u32x4 ba[4], bb[4];
#pragma unroll
            for (int j = 0; j < 4; ++j) { ba[j] = *(const u32x4*)(xa + 8 * lane + 512 * j); bb[j] = *(const u32x4*)(xb + 8 * lane + 512 * j); }
#pragma unroll
            for (int j = 0; j < 4; ++j) { va[2 * j] = (f32x4){bflo(ba[j].x), bfhi(ba[j].x), bflo(ba[j].y), bfhi(ba[j].y)}; va[2 * j + 1] = (f32x4){bflo(ba[j].z), bfhi(ba[j].z), bflo(ba[j].w), bfhi(ba[j].w)};
                vb[2 * j] = (f32x4){bflo(bb[j].x), bfhi(bb[j].x), bflo(bb[j].y), bfhi(bb[j].y)}; vb[2 * j + 1] = (f32x4){bflo(bb[j].z), bfhi(bb[j].z), bflo(bb[j].w), bfhi(bb[j].w)}; } }
#pragma unroll
        for (int j = 0; j < 8; ++j) { sa += (va[j][0] * va[j][0] + va[j][1] * va[j][1]) + (va[j][2] * va[j][2] + va[j][3] * va[j][3]); sb += (vb[j][0] * vb[j][0] + vb[j][1] * vb[j][1]) + (vb[j][2] * vb[j][2] + vb[j][3] * vb[j][3]); }
#pragma unroll
        for (int o = 1; o < 64; o <<= 1) { sa += __shfl_xor(sa, o); sb += __shfl_xor(sb, o); }
        const float ra = 1.0f / sqrtf(sa * (1.0f / DM) + RMS_EPS), rb = 1.0f / sqrtf(sb * (1.0f / DM) + RMS_EPS);
#pragma unroll
        for (int j = 0; j < 4; ++j) { const int col = 8 * lane + 512 * j;
            const f32x4 a0 = va[2 * j] * ra * gs[2 * j] + sh[2 * j], a1 = va[2 * j + 1] * ra * gs[2 * j + 1] + sh[2 * j + 1];
            const f32x4 b0 = vb[2 * j] * rb * gs[2 * j] + sh[2 * j], b1 = vb[2 * j + 1] * rb * gs[2 * j + 1] + sh[2 * j + 1];
            *(u32x4*)(H + (size_t)r * DM + col) = (u32x4){cvtpk(a0[0], a0[1]), cvtpk(a0[2], a0[3]), cvtpk(a1[0], a1[1]), cvtpk(a1[2], a1[3])};
            *(u32x4*)(H + (size_t)r2 * DM + col) = (u32x4){cvtpk(b0[0], b0[1]), cvtpk(b0[2], b0[3]), cvtpk(b1[0], b1[1]), cvtpk(b1[2], b1[3])}; }
    }
}
__device__ __forceinline__ void phase_final(const bf16_t* X, const float* g, float* out, int lane, int wave) {
    const int gw = blockIdx.x * NWAVES + wave, NGW = gridDim.x * NWAVES;
    f32x4 gg[8];
#pragma unroll
    for (int j = 0; j < 4; ++j) { gg[2 * j] = *(const f32x4*)(g + 8 * lane + 512 * j); gg[2 * j + 1] = *(const f32x4*)(g + 8 * lane + 512 * j + 4); }
    const bool fast = NGW == 2048; const int b = gw & 7, w8 = gw >> 3;
    const int n_it = fast ? 8 : (gw < MX ? (MX - gw + 2 * NGW - 1) / (2 * NGW) : 0);
    for (int it = 0; it < n_it; ++it) {
        int r, r2;
        if (fast) { r = b * SEQ + w8 + 256 * (15 - 2 * it); r2 = r - 256; }
        else { r = gw + 2 * NGW * it; r2 = (r + NGW < MX) ? r + NGW : r; }
        u32x4 ba[4], bb[4];
#pragma unroll
        for (int j = 0; j < 4; ++j) { ba[j] = *(const u32x4*)(X + (size_t)r * DM + 8 * lane + 512 * j); bb[j] = *(const u32x4*)(X + (size_t)r2 * DM + 8 * lane + 512 * j); }
        f32x4 va[8], vb[8]; float sa = 0.f, sb = 0.f;
#pragma unroll
        for (int j = 0; j < 4; ++j) { va[2 * j] = (f32x4){bflo(ba[j].x), bfhi(ba[j].x), bflo(ba[j].y), bfhi(ba[j].y)}; va[2 * j + 1] = (f32x4){bflo(ba[j].z), bfhi(ba[j].z), bflo(ba[j].w), bfhi(ba[j].w)};
            vb[2 * j] = (f32x4){bflo(bb[j].x), bfhi(bb[j].x), bflo(bb[j].y), bfhi(bb[j].y)}; vb[2 * j + 1] = (f32x4){bflo(bb[j].z), bfhi(bb[j].z), bflo(bb[j].w), bfhi(bb[j].w)}; }
#pragma unroll
        for (int j = 0; j < 8; ++j) { sa += (va[j][0] * va[j][0] + va[j][1] * va[j][1]) + (va[j][2] * va[j][2] + va[j][3] * va[j][3]); sb += (vb[j][0] * vb[j][0] + vb[j][1] * vb[j][1]) + (vb[j][2] * vb[j][2] + vb[j][3] * vb[j][3]); }
#pragma unroll
        for (int o = 1; o < 64; o <<= 1) { sa += __shfl_xor(sa, o); sb += __shfl_xor(sb, o); }
        const float ra = 1.0f / sqrtf(sa * (1.0f / DM) + RMS_EPS), rb = 1.0f / sqrtf(sb * (1.0f / DM) + RMS_EPS);
#pragma unroll
        for (int j = 0; j < 4; ++j) { const int col = 8 * lane + 512 * j;
            *(f32x4*)(out + (size_t)r * DM + col) = va[2 * j] * ra * gg[2 * j]; *(f32x4*)(out + (size_t)r * DM + col + 4) = va[2 * j + 1] * ra * gg[2 * j + 1];
            *(f32x4*)(out + (size_t)r2 * DM + col) = vb[2 * j] * rb * gg[2 * j]; *(f32x4*)(out + (size_t)r2 * DM + col + 4) = vb[2 * j + 1] * rb * gg[2 * j + 1]; }
    }
}

struct RangeOrder {
    pg8::StaticOrder b; int pm0; unsigned* donectr;
    __device__ void init(int pm_lo, int pm_hi, int N, int G, int c) { b.init((pm_hi - pm_lo) * 256, N, G, c); pm0 = pm_lo; donectr = nullptr; }
    __device__ __forceinline__ bool next(int i, pg8::Unit& u) const { if (!b.next(i, u)) return false; u.pm += pm0; return true; }
    __device__ __forceinline__ void a_ready(const pg8::Unit&) const {}
    __device__ __forceinline__ void done(const pg8::Unit&) const { if (donectr != nullptr && threadIdx.x == 0) (void)__hip_atomic_fetch_add(donectr, 1u, __ATOMIC_RELAXED, __HIP_MEMORY_SCOPE_AGENT); }
};
struct EpiRes {
    static constexpr bool PERM = true, AFTER_DRAIN = false;
    const float* b32; const bf16_t* b16; bf16_t* out; const float* gate;
    __device__ __forceinline__ void operator()(const pg8::f32x4 (&acc)[2][2][4][2], const pg8::Unit& u, int wr, int wc, int fr, int fq) const {
        const int row0 = u.pm * 256 + wr * 64 + fr, col0 = u.pn * 256 + wc * 32 + 8 * fq;
        const int mr = u.pm < (MX / 256) ? (u.pm >> 4) : 8;
        const float* gp = gate + (size_t)mr * MODW + col0;
        f32x4 gv[2][2];
#pragma unroll
        for (int bj = 0; bj < 2; ++bj)
#pragma unroll
            for (int n = 0; n < 2; ++n) gv[bj][n] = *(const f32x4*)(gp + bj * 128 + n * 4);
        if (b16 != nullptr) {
#pragma unroll
            for (int ai = 0; ai < 2; ++ai) {
                u32x4 bs[4][2];
#pragma unroll
                for (int m = 0; m < 4; ++m)
#pragma unroll
                    for (int bj = 0; bj < 2; ++bj) bs[m][bj] = *(const u32x4*)(b16 + (size_t)(row0 + ai * 128 + m * 16) * DM + col0 + bj * 128);
#pragma unroll
                for (int m = 0; m < 4; ++m)
#pragma unroll
                    for (int bj = 0; bj < 2; ++bj) { const u32x4 b = bs[m][bj]; const f32x4 a0 = acc[ai][bj][m][0] * gv[bj][0], a1 = acc[ai][bj][m][1] * gv[bj][1];
                        u32x4 w; w.x = cvtpk(bflo(b.x) + a0[0], bfhi(b.x) + a0[1]); w.y = cvtpk(bflo(b.y) + a0[2], bfhi(b.y) + a0[3]);
                        w.z = cvtpk(bflo(b.z) + a1[0], bfhi(b.z) + a1[1]); w.w = cvtpk(bflo(b.w) + a1[2], bfhi(b.w) + a1[3]);
                        *(u32x4*)(out + (size_t)(row0 + ai * 128 + m * 16) * DM + col0 + bj * 128) = w; }
                asm volatile("" ::: "memory"); }
        } else {
#pragma unroll
            for (int am = 0; am < 4; ++am) {
                const int ai = am >> 1;
                f32x4 bs[2][2][2];
#pragma unroll
                for (int m2 = 0; m2 < 2; ++m2) { const size_t off = (size_t)(row0 + ai * 128 + ((am & 1) * 2 + m2) * 16) * DM + col0;
#pragma unroll
                    for (int bj = 0; bj < 2; ++bj)
#pragma unroll
                        for (int n = 0; n < 2; ++n) bs[m2][bj][n] = *(const f32x4*)(b32 + off + bj * 128 + n * 4); }
#pragma unroll
                for (int m2 = 0; m2 < 2; ++m2) { const int m = (am & 1) * 2 + m2; const size_t off = (size_t)(row0 + ai * 128 + m * 16) * DM + col0;
#pragma unroll
                    for (int bj = 0; bj < 2; ++bj) { const f32x4 o0 = bs[m2][bj][0] + gv[bj][0] * acc[ai][bj][m][0], o1 = bs[m2][bj][1] + gv[bj][1] * acc[ai][bj][m][1];
                        u32x4 w; w.x = cvtpk(o0[0], o0[1]); w.y = cvtpk(o0[2], o0[3]); w.z = cvtpk(o1[0], o1[1]); w.w = cvtpk(o1[2], o1[3]);
                        *(u32x4*)(out + off + bj * 128) = w; } }
                asm volatile("" ::: "memory"); }
        }
    }
};
struct SplitOrder {
    int nN, kq, G, c;
    __device__ void init(int N, int K, int G_, int c_) { nN = N / 256; kq = K / 4; G = G_; c = c_; }
    __device__ __forceinline__ bool next(int i, pg8::Unit& u) const { const int L = i * G + c; if (L >= 8 * nN * 4) return false;
        const int t = L >> 2; u.k0 = (L & 3) * kq; u.pm = MX / 256 + (t & 7); u.pn = t >> 3; return true; }
    __device__ __forceinline__ void a_ready(const pg8::Unit&) const {}
    __device__ __forceinline__ void done(const pg8::Unit&) const {}
};
struct EpiPart {
    static constexpr bool PERM = false, AFTER_DRAIN = false;
    float* part; const float* gate; int kq;
    __device__ __forceinline__ void operator()(const pg8::f32x4 (&acc)[2][2][4][2], const pg8::Unit& u, int wr, int wc, int fr, int fq) const {
        const int row0 = (u.pm - MX / 256) * 256 + wr * 64 + fr, col0 = u.pn * 256 + wc * 32 + 4 * fq;
        const float* gp = gate + (size_t)8 * MODW + col0;
        float* pq = part + (size_t)(u.k0 / kq) * MC * DM;
        f32x4 gv[2][2];
#pragma unroll
        for (int bj = 0; bj < 2; ++bj)
#pragma unroll
            for (int n = 0; n < 2; ++n) gv[bj][n] = *(const f32x4*)(gp + bj * 128 + n * 16);
#pragma unroll
        for (int ai = 0; ai < 2; ++ai)
#pragma unroll
            for (int m = 0; m < 4; ++m) { float* rowp = pq + (size_t)(row0 + ai * 128 + m * 16) * DM + col0;
#pragma unroll
                for (int bj = 0; bj < 2; ++bj)
#pragma unroll
                    for (int n = 0; n < 2; ++n) *(f32x4*)(rowp + bj * 128 + n * 16) = gv[bj][n] * acc[ai][bj][m][n]; }
    }
};
struct EpiBf {
    static constexpr bool PERM = true, AFTER_DRAIN = false;
    bf16_t* O; int ldc;
    __device__ __forceinline__ void operator()(const pg8::f32x4 (&acc)[2][2][4][2], const pg8::Unit& u, int wr, int wc, int fr, int fq) const {
        const int row0 = u.pm * 256 + wr * 64 + fr, col0 = u.pn * 256 + wc * 32 + 8 * fq;
#pragma unroll
        for (int ai = 0; ai < 2; ++ai)
#pragma unroll
            for (int m = 0; m < 4; ++m) { bf16_t* rowp = O + (size_t)(row0 + ai * 128 + m * 16) * ldc + col0;
#pragma unroll
                for (int bj = 0; bj < 2; ++bj) { const f32x4 v0 = acc[ai][bj][m][0], v1 = acc[ai][bj][m][1];
                    u32x4 w; w.x = cvtpk(v0[0], v0[1]); w.y = cvtpk(v0[2], v0[3]); w.z = cvtpk(v1[0], v1[1]); w.w = cvtpk(v1[2], v1[3]);
                    *(u32x4*)(rowp + bj * 128) = w; } }
    }
};
#define DPPF(oldv, src, CTRL) __builtin_bit_cast(float, __builtin_amdgcn_update_dpp(__builtin_bit_cast(int, (float)(oldv)), __builtin_bit_cast(int, (float)(src)), (CTRL), 0xF, 0xF, false))
#define DPPM(src, CTRL) __builtin_bit_cast(float, __builtin_amdgcn_mov_dpp(__builtin_bit_cast(int, (float)(src)), (CTRL), 0xF, 0xF, true))
#define DPP_SHR1 0x111
#define DPP_SHL1 0x101
#define DPP_ROR1 0x121
#define DPP_ROR15 0x12F
__device__ __forceinline__ int xi_idx(int wrx, int aix, int edge, int bj, int n, int wc, int fq) { return ((((((wrx * 2 + aix) * 2 + edge) * 2 + bj) * 4 + wc) * 2 + n) * 4 + fq) * 4; }
struct EpiUpConv {
    static constexpr bool PERM = true, AFTER_DRAIN = false;
    bf16_t* G; float* EA; float* EB; const float* cw; const float* cb; LAS float* xl;
    __device__ __forceinline__ void operator()(const pg8::f32x4 (&acc)[2][2][4][2], const pg8::Unit& u, int wr, int wc, int fr, int fq) const {
        const int j0 = u.pn * 128 + wc * 32 + 8 * fq;
#define XI(wrx, aix, edge, bj, n) xi_idx((wrx), (aix), (edge), (bj), (n), wc, fq)
#pragma unroll
        for (int ai = 0; ai < 2; ++ai)
#pragma unroll
            for (int bj = 0; bj < 2; ++bj)
#pragma unroll
                for (int n = 0; n < 2; ++n) {
                    if (fr == 0) *(LAS f32x4*)(xl + XI(wr, ai, 0, bj, n)) = acc[ai][bj][0][n];
                    if (fr == 15) *(LAS f32x4*)(xl + XI(wr, ai, 1, bj, n)) = acc[ai][bj][3][n];
                }
        if (wr == 0 && fr < 2) {
#pragma unroll
            for (int bj = 0; bj < 2; ++bj)
#pragma unroll
                for (int n = 0; n < 2; ++n) *(f32x4*)((bj ? EB : EA) + ((size_t)u.pm * 4 + fr) * DFF + j0 + 4 * n) = acc[0][bj][0][n];
        }
        if (wr == 1 && fr >= 14) {
#pragma unroll
            for (int bj = 0; bj < 2; ++bj)
#pragma unroll
                for (int n = 0; n < 2; ++n) *(f32x4*)((bj ? EB : EA) + ((size_t)u.pm * 4 + 2 + (fr - 14)) * DFF + j0 + 4 * n) = acc[1][bj][3][n];
        }
        asm volatile("s_waitcnt lgkmcnt(0)" ::: "memory"); __builtin_amdgcn_s_barrier(); __builtin_amdgcn_s_barrier(); asm volatile("" ::: "memory");
        const int pwr = wr ^ 1;
        const unsigned long long m15 = __ballot(fr == 15), m00 = __ballot(fr == 0);
        u32x2 keep[2][4];
#pragma unroll
        for (int n = 0; n < 2; ++n) {
            const float* wp = cw + j0 + 4 * n; const float* bp = cb + j0 + 4 * n;
            const f32x4 wa0 = *(const f32x4*)wp, wa1 = *(const f32x4*)(wp + NUP), wa2 = *(const f32x4*)(wp + 2 * NUP), ba = *(const f32x4*)bp;
            const f32x4 wb0 = *(const f32x4*)(wp + DFF), wb1 = *(const f32x4*)(wp + NUP + DFF), wb2 = *(const f32x4*)(wp + 2 * NUP + DFF), bb = *(const f32x4*)(bp + DFF);
#pragma unroll
            for (int ai = 0; ai < 2; ++ai) {
                const int pai = (wr == 1) ? ai : ai - 1, nai = (wr == 0) ? ai : ai + 1;
                const bool hasp = !(wr == 0 && ai == 0), hasn = !(wr == 1 && ai == 1);
                f32x4 pa = {0.f, 0.f, 0.f, 0.f}, pb = pa, na = pa, nb = pa;
                if (hasp) { pa = *(const LAS f32x4*)(xl + XI(pwr, pai, 1, 0, n)); pb = *(const LAS f32x4*)(xl + XI(pwr, pai, 1, 1, n)); }
                if (hasn) { na = *(const LAS f32x4*)(xl + XI(pwr, nai, 0, 0, n)); nb = *(const LAS f32x4*)(xl + XI(pwr, nai, 0, 1, n)); }
#pragma unroll
                for (int mm = 0; mm < 4; ++mm) {
                    f32x4 Av = wa1 * acc[ai][0][mm][n] + ba, Bv = wb1 * acc[ai][1][mm][n] + bb;
#pragma unroll
                    for (int e = 0; e < 4; ++e) {
                        const float ac = acc[ai][0][mm][n][e], bc = acc[ai][1][mm][n][e];
                        const float psa = (mm == 0) ? pa[e] : acc[ai][0][mm > 0 ? mm - 1 : 0][n][e], psb = (mm == 0) ? pb[e] : acc[ai][1][mm > 0 ? mm - 1 : 0][n][e];
                        const float nsa = (mm == 3) ? na[e] : acc[ai][0][mm < 3 ? mm + 1 : 3][n][e], nsb = (mm == 3) ? nb[e] : acc[ai][1][mm < 3 ? mm + 1 : 3][n][e];
                        float A = Av[e], B = Bv[e], t0, t1, t2, t3;
                        asm("v_cndmask_b32_e64 %2, %6, %7, %16\n\t"
                            "v_cndmask_b32_e64 %3, %6, %8, %17\n\t"
                            "v_cndmask_b32_e64 %4, %9, %10, %16\n\t"
                            "v_cndmask_b32_e64 %5, %9, %11, %17\n\t"
                            "v_fmac_f32_dpp %0, %2, %12 row_ror:1 row_mask:0xf bank_mask:0xf bound_ctrl:1\n\t"
                            "v_fmac_f32_dpp %0, %3, %13 row_ror:15 row_mask:0xf bank_mask:0xf bound_ctrl:1\n\t"
                            "v_fmac_f32_dpp %1, %4, %14 row_ror:1 row_mask:0xf bank_mask:0xf bound_ctrl:1\n\t"
                            "v_fmac_f32_dpp %1, %5, %15 row_ror:15 row_mask:0xf bank_mask:0xf bound_ctrl:1"
                            : "+v"(A), "+v"(B), "=&v"(t0), "=&v"(t1), "=&v"(t2), "=&v"(t3)
                            : "v"(ac), "v"(psa), "v"(nsa), "v"(bc), "v"(psb), "v"(nsb), "v"(wa0[e]), "v"(wa2[e]), "v"(wb0[e]), "v"(wb2[e]), "s"(m15), "s"(m00));
                        Av[e] = A; Bv[e] = B;
                    }
                    const f32x4 tv = Av * -1.44269504f;
                    f32x4 sv = {__builtin_amdgcn_exp2f(tv[0]), __builtin_amdgcn_exp2f(tv[1]), __builtin_amdgcn_exp2f(tv[2]), __builtin_amdgcn_exp2f(tv[3])};
                    sv = sv + 1.0f;
                    const f32x4 rv = {__builtin_amdgcn_rcpf(sv[0]), __builtin_amdgcn_rcpf(sv[1]), __builtin_amdgcn_rcpf(sv[2]), __builtin_amdgcn_rcpf(sv[3])};
                    const f32x4 g = (Av * Bv) * rv;
                    u32x2 w; w.x = cvtpk(g[0], g[1]); w.y = cvtpk(g[2], g[3]);
                    const int rt = ai * 128 + wr * 64 + mm * 16 + fr;
                    if (n == 0) keep[ai][mm] = w;
                    else if (rt != 0 && rt != 255) *(u32x4*)(G + (size_t)(u.pm * 256 + rt) * DFF + j0) = (u32x4){keep[ai][mm].x, keep[ai][mm].y, w.x, w.y};
                }
            }
        }
#undef XI
    }
};
__device__ __forceinline__ void phase_ffn_fix(bf16_t* G, const float* EA, const float* EB, const float* cw, const float* cb, int ntiles, int tid) {
    const int total = ntiles * 2 * (DFF / 4);
    for (int e = blockIdx.x * NTHREADS + tid; e < total; e += gridDim.x * NTHREADS) {
        const int j = (e % (DFF / 4)) * 4, which = (e / (DFF / 4)) & 1, pm = e / (2 * (DFF / 4));
        const int T = pm < MX / 256 ? SEQ : CTXL; const int t0 = pm < MX / 256 ? (pm * 256) & (SEQ - 1) : 0;
        const bool hasp = which == 0 ? (t0 != 0) : true, hasn = which == 0 ? true : (t0 + 256 != T);
        const size_t ip = which == 0 ? ((size_t)(pm - 1) * 4 + 3) : ((size_t)pm * 4 + 2), ic = (size_t)pm * 4 + (which == 0 ? 0 : 3), in_ = which == 0 ? ((size_t)pm * 4 + 1) : ((size_t)(pm + 1) * 4 + 0);
        const f32x4 z = {0.f, 0.f, 0.f, 0.f};
        const f32x4 ap = hasp ? *(const f32x4*)(EA + ip * DFF + j) : z, ac = *(const f32x4*)(EA + ic * DFF + j), an = hasn ? *(const f32x4*)(EA + in_ * DFF + j) : z;
        const f32x4 bp = hasp ? *(const f32x4*)(EB + ip * DFF + j) : z, bc = *(const f32x4*)(EB + ic * DFF + j), bn = hasn ? *(const f32x4*)(EB + in_ * DFF + j) : z;
        const f32x4 wa0 = *(const f32x4*)(cw + j), wa1 = *(const f32x4*)(cw + NUP + j), wa2 = *(const f32x4*)(cw + 2 * NUP + j), ba = *(const f32x4*)(cb + j);
        const f32x4 wb0 = *(const f32x4*)(cw + DFF + j), wb1 = *(const f32x4*)(cw + NUP + DFF + j), wb2 = *(const f32x4*)(cw + 2 * NUP + DFF + j), bb = *(const f32x4*)(cb + DFF + j);
        float g[4];
#pragma unroll
        for (int c = 0; c < 4; ++c) { const float A = fmaf(wa2[c], an[c], fmaf(wa1[c], ac[c], fmaf(wa0[c], ap[c], ba[c]))), B = fmaf(wb2[c], bn[c], fmaf(wb1[c], bc[c], fmaf(wb0[c], bp[c], bb[c]))); g[c] = silu_f(A) * B; }
        u32x2 w; w.x = cvtpk(g[0], g[1]); w.y = cvtpk(g[2], g[3]);
        *(u32x2*)(G + (size_t)(pm * 256 + (which == 0 ? 0 : 255)) * DFF + j) = w;
    }
}
struct EpiQKV {
    static constexpr bool PERM = true, AFTER_DRAIN = false;
    bf16_t* O; const float* rc; const float* rs;
    __device__ __forceinline__ void operator()(const pg8::f32x4 (&acc)[2][2][4][2], const pg8::Unit& u, int wr, int wc, int fr, int fq) const {
        const int row0 = u.pm * 256 + wr * 64 + fr, col0 = u.pn * 256 + wc * 32 + 8 * fq;
        const bool rope = (u.pm < MX / 256) && (u.pn < 10);
        const int jj0 = 16 * wc + 4 * fq;
#pragma unroll
        for (int ai = 0; ai < 2; ++ai)
#pragma unroll
            for (int m = 0; m < 4; ++m) { const int row = row0 + ai * 128 + m * 16; bf16_t* rowp = O + (size_t)row * NQKV + col0;
                f32x4 cv = {1.f, 1.f, 1.f, 1.f}, sv = {0.f, 0.f, 0.f, 0.f};
                if (rope) { const int t = row & (SEQ - 1); cv = *(const f32x4*)(rc + t * 64 + jj0); sv = *(const f32x4*)(rs + t * 64 + jj0); }
#pragma unroll
                for (int bj = 0; bj < 2; ++bj) { const f32x4 v0 = acc[ai][bj][m][0], v1 = acc[ai][bj][m][1];
                    u32x4 w;
                    w.x = cvtpk(v0[0] * cv[0] - v0[1] * sv[0], v0[1] * cv[0] + v0[0] * sv[0]);
                    w.y = cvtpk(v0[2] * cv[1] - v0[3] * sv[1], v0[3] * cv[1] + v0[2] * sv[1]);
                    w.z = cvtpk(v1[0] * cv[2] - v1[1] * sv[2], v1[1] * cv[2] + v1[0] * sv[2]);
                    w.w = cvtpk(v1[2] * cv[3] - v1[3] * sv[3], v1[3] * cv[3] + v1[2] * sv[3]);
                    *(u32x4*)(rowp + bj * 128) = w; } }
    }
};
struct EpiMI {
    static constexpr bool PERM = true, AFTER_DRAIN = false;
    bf16_t* Z; float* G; const float* bias;
    __device__ __forceinline__ void operator()(const pg8::f32x4 (&acc)[2][2][4][2], const pg8::Unit& u, int wr, int wc, int fr, int fq) const {
        const int row0 = u.pm * 256 + wr * 64 + fr;
        if (u.pn < 24) {
            const int col0 = u.pn * 256 + wc * 32 + 8 * fq;
            const float sc = (u.pn >= 4 && u.pn < 8) ? 0.08838834764831845f : 1.0f;
            f32x4 bv[2][2];
#pragma unroll
            for (int bj = 0; bj < 2; ++bj)
#pragma unroll
                for (int n = 0; n < 2; ++n) bv[bj][n] = *(const f32x4*)(bias + col0 + bj * 128 + 4 * n);
#pragma unroll
            for (int ai = 0; ai < 2; ++ai)
#pragma unroll
                for (int m = 0; m < 4; ++m) { bf16_t* rowp = Z + (size_t)(row0 + ai * 128 + m * 16) * NMI + col0;
#pragma unroll
                    for (int bj = 0; bj < 2; ++bj) { const f32x4 v0 = (acc[ai][bj][m][0] + bv[bj][0]) * sc, v1 = (acc[ai][bj][m][1] + bv[bj][1]) * sc;
                        u32x4 w; w.x = cvtpk(v0[0], v0[1]); w.y = cvtpk(v0[2], v0[3]); w.z = cvtpk(v1[0], v1[1]); w.w = cvtpk(v1[2], v1[3]);
                        *(u32x4*)(rowp + bj * 128) = w; } }
        } else if (wc == 0) {
            const f32x4 b0 = *(const f32x4*)(bias + NMI + 8 * fq), b1 = *(const f32x4*)(bias + NMI + 8 * fq + 4);
#pragma unroll
            for (int ai = 0; ai < 2; ++ai)
#pragma unroll
                for (int m = 0; m < 4; ++m) { float* gp = G + (size_t)(row0 + ai * 128 + m * 16) * 32 + 8 * fq;
                    f32x4 v0 = acc[ai][0][m][0] + b0, v1 = acc[ai][0][m][1] + b1;
                    if (fq & 1) {
#pragma unroll
                        for (int e = 0; e < 4; ++e) { v0[e] = log_sigmoid_f(v0[e]); v1[e] = log_sigmoid_f(v1[e]); } }
                    *(f32x4*)gp = v0; *(f32x4*)(gp + 4) = v1; }
        }
    }
};

namespace att {
constexpr int D = 128, KVBLK = 64, LDQ = NQKV;
constexpr float SCALE = 0.088388347648318440f;
constexpr float THR = 8.f;
#ifndef ATT_SDEPTH
#define ATT_SDEPTH 1
#endif
constexpr int SDEPTH = ATT_SDEPTH;
constexpr size_t SHM_V = KVBLK * D * 2, SHM_K = KVBLK * D * 2, SHM_ATTN = 2 * SHM_V + 2 * SHM_K + NWAVES * 64 * 4;
#define KSWZ(row, colB) ((row) * 256 + ((colB) ^ (((row) & 7) << 4)))
#define SBAR() __builtin_amdgcn_sched_barrier(0)
__device__ __forceinline__ int crow(int r, int hi) { return (r & 3) + 8 * (r >> 2) + 4 * hi; }
__device__ __forceinline__ void partialSM(f32x16& p0, f32x16& p1, float& m_reg, float& mn, float& alpha, bool masked, int dpos, int hi) {
  constexpr float C = SCALE * 1.4426950408889634f;
  if (masked) {
    const unsigned ub = (unsigned)(dpos + 4 * hi + 128);
#pragma unroll
    for (int r = 0; r < 16; ++r) { const unsigned kc = (unsigned)((r & 3) + 8 * (r >> 2));
      if (ub + kc > 256u) p0[r] = -1e30f;
      if (ub + kc + 32u > 256u) p1[r] = -1e30f; }
  }
  float pmax = p0[0];
#pragma unroll
  for (int r = 1; r < 16; ++r) pmax = fmaxf(pmax, p0[r]);
#pragma unroll
  for (int r = 0; r < 16; ++r) pmax = fmaxf(pmax, p1[r]);
  { auto rr = __builtin_amdgcn_permlane32_swap(__float_as_uint(pmax), __float_as_uint(pmax), false, false);
    pmax = fmaxf(__uint_as_float(rr[0]), __uint_as_float(rr[1])); }
  if (__builtin_expect(__all(pmax - m_reg <= THR / SCALE), 1)) { mn = m_reg; alpha = 1.f; }
  else { mn = fmaxf(m_reg, pmax); alpha = __builtin_amdgcn_exp2f((m_reg - mn) * C); m_reg = mn; }
  const float mnC = -mn * C;
#pragma unroll
  for (int r = 0; r < 16; ++r) p0[r] = fmaf(p0[r], C, mnC);
#pragma unroll
  for (int r = 0; r < 16; ++r) p1[r] = fmaf(p1[r], C, mnC);
#pragma unroll
  for (int r = 0; r < 16; ++r) p0[r] = __builtin_amdgcn_exp2f(p0[r]);
}
__device__ __forceinline__ void finishSM(f32x16& p0, f32x16& p1, float alpha, float& l_reg, bf16x8& pa0, bf16x8& pa1, bf16x8& pa2, bf16x8& pa3) {
#pragma unroll
  for (int r = 0; r < 16; ++r) p1[r] = __builtin_amdgcn_exp2f(p1[r]);
  float ps = 0;
#pragma unroll
  for (int r = 0; r < 16; ++r) ps += p0[r];
#pragma unroll
  for (int r = 0; r < 16; ++r) ps += p1[r];
  { auto rr = __builtin_amdgcn_permlane32_swap(__float_as_uint(ps), __float_as_uint(ps), false, false);
    ps = __uint_as_float(rr[0]) + __uint_as_float(rr[1]); }
  l_reg = l_reg * alpha + ps;
#define PK4(P, BASE, OUT) do { unsigned a0 = cvtpk(P[BASE + 0], P[BASE + 1]), a1 = cvtpk(P[BASE + 2], P[BASE + 3]);   \
    unsigned b0 = cvtpk(P[BASE + 4], P[BASE + 5]), b1 = cvtpk(P[BASE + 6], P[BASE + 7]);                              \
    auto r0 = __builtin_amdgcn_permlane32_swap(a0, b0, false, false); auto r1 = __builtin_amdgcn_permlane32_swap(a1, b1, false, false); \
    u32x4 w = {r0[0], r1[0], r0[1], r1[1]}; OUT = *reinterpret_cast<bf16x8*>(&w); } while (0)
  PK4(p0, 0, pa0); PK4(p0, 8, pa1); PK4(p1, 0, pa2); PK4(p1, 8, pa3);
#undef PK4
}
__device__ __forceinline__ void qkt(f32x16& p0, f32x16& p1, const char* Ks, const bf16x8* qr, int r32, int hi) {
  p0 = f32x16{}; p1 = f32x16{};
#pragma unroll
  for (int d0 = 0; d0 < 8; ++d0) { const int cb = (d0 * 16 + hi * 8) * 2;
    const bf16x8 b0 = *reinterpret_cast<const bf16x8*>(Ks + KSWZ(r32, cb));
    const bf16x8 b1 = *reinterpret_cast<const bf16x8*>(Ks + KSWZ(32 + r32, cb));
    p0 = __builtin_amdgcn_mfma_f32_32x32x16_bf16(b0, qr[d0], p0, 0, 0, 0);
    p1 = __builtin_amdgcn_mfma_f32_32x32x16_bf16(b1, qr[d0], p1, 0, 0, 0); }
}
__device__ __forceinline__ int v_st(int k, int c) { const int kk = (k & ~0xC) | ((k & 4) << 1) | ((k & 8) >> 1); return ((kk >> 3) * 4 + (c >> 5)) * 512 + ((kk & 7) * 32 + (c & 31)) * 2; }
__device__ __forceinline__ int v_rd_base(int lane) { return ((lane & 3) << 3) | (((lane >> 2) & 3) << 6) | (((lane >> 4) & 1) << 5) | (((lane >> 5) & 1) << 8); }
constexpr int v_rd_off(int d0, int ks, int half) { return d0 * 512 + ks * 4096 + half * 2048; }
template <int OFF> __device__ __forceinline__ s16x4 tr_read(int vb) {
  s16x4 r; asm volatile("ds_read_b64_tr_b16 %0, %1 offset:%2" : "=&v"(r) : "v"(vb), "i"(OFF) : "memory"); return r;
}
template <int D0> __device__ __forceinline__ void pv_one(f32x16& od, int vb, bf16x8 pa0, bf16x8 pa1, bf16x8 pa2, bf16x8 pa3) {
  const s16x4 l0 = tr_read<v_rd_off(D0, 0, 0)>(vb), h0 = tr_read<v_rd_off(D0, 0, 1)>(vb), l1 = tr_read<v_rd_off(D0, 1, 0)>(vb), h1 = tr_read<v_rd_off(D0, 1, 1)>(vb);
  const s16x4 l2 = tr_read<v_rd_off(D0, 2, 0)>(vb), h2 = tr_read<v_rd_off(D0, 2, 1)>(vb), l3 = tr_read<v_rd_off(D0, 3, 0)>(vb), h3 = tr_read<v_rd_off(D0, 3, 1)>(vb);
  asm volatile("s_waitcnt lgkmcnt(0)" ::: "memory"); SBAR();
#define PK(L, H) (bf16x8){L[0], L[1], L[2], L[3], H[0], H[1], H[2], H[3]}
  od = __builtin_amdgcn_mfma_f32_32x32x16_bf16(pa0, PK(l0, h0), od, 0, 0, 0);
  od = __builtin_amdgcn_mfma_f32_32x32x16_bf16(pa1, PK(l1, h1), od, 0, 0, 0);
  od = __builtin_amdgcn_mfma_f32_32x32x16_bf16(pa2, PK(l2, h2), od, 0, 0, 0);
  od = __builtin_amdgcn_mfma_f32_32x32x16_bf16(pa3, PK(l3, h3), od, 0, 0, 0);
#undef PK
}
__device__ __forceinline__ void pv_d0(f32x16* o, int vb, bf16x8 pa0, bf16x8 pa1, bf16x8 pa2, bf16x8 pa3) {
  pv_one<0>(o[0], vb, pa0, pa1, pa2, pa3); pv_one<1>(o[1], vb, pa0, pa1, pa2, pa3); pv_one<2>(o[2], vb, pa0, pa1, pa2, pa3); pv_one<3>(o[3], vb, pa0, pa1, pa2, pa3);
}

__device__ __forceinline__ void attn_unit(const bf16_t* __restrict__ Z, bf16_t* __restrict__ O, int qrow0, int head0, int kvh, int ctxrow0, int winrow0, int NT, int dq0, const float* __restrict__ sinkp, char* lds) {
  int tid_l = threadIdx.x; asm volatile("" : "+v"(tid_l));
  const int tid = tid_l, wid = tid >> 6, lane = tid & 63, r32 = lane & 31, hi = lane >> 5;
  char* V_lds = lds; char* K_lds = lds + 2 * SHM_V;
  float* wsl = (float*)(lds + 2 * SHM_V + 2 * SHM_K) + wid * 64; float* li_l = wsl; float* al_l = wsl + 32;
  float m_reg = -1e30f, l_reg = 0; f32x16 o[4] = {}; bf16x8 qr[8];
  const int head = head0 + (wid >> 2), qloc = (wid & 3) * 32 + r32;
  const bf16_t* Qw = Z + (size_t)(qrow0 + qloc) * LDQ + head * D + hi * 8;
#pragma unroll
  for (int d0 = 0; d0 < 8; ++d0) qr[d0] = *reinterpret_cast<const bf16x8*>(Qw + d0 * 16);
  const int sr = tid >> 4, sc = (tid & 15) * 8, vst0 = v_st(sr, sc), vst1 = v_st(32 + sr, sc);
  const int vb0 = (int)(uintptr_t)V_lds + v_rd_base(lane);
  const bf16_t* Kc = Z + 2048 + kvh * D + sc; const bf16_t* Vc = Z + 2560 + kvh * D + sc;
  const int dlane = dq0 - qloc;
  struct { bf16x8 vs0, vs1, ks0, ks1; } sr_[SDEPTH];
#define TROW(jt) ((jt) < 4 ? ctxrow0 + (jt) * 64 : winrow0 + ((jt) - 4) * 64)
#define SLOAD(i, jt) do { const size_t rb0_ = (size_t)(TROW(jt) + sr) * LDQ, rb1_ = rb0_ + (size_t)32 * LDQ; \
    sr_[i].vs0 = *reinterpret_cast<const bf16x8*>(Vc + rb0_); sr_[i].vs1 = *reinterpret_cast<const bf16x8*>(Vc + rb1_); \
    sr_[i].ks0 = *reinterpret_cast<const bf16x8*>(Kc + rb0_); sr_[i].ks1 = *reinterpret_cast<const bf16x8*>(Kc + rb1_); } while (0)
#define SWRITE(b, i) do { *(bf16x8*)(V_lds + (b) * SHM_V + vst0) = sr_[i].vs0;          \
    *(bf16x8*)(V_lds + (b) * SHM_V + vst1) = sr_[i].vs1; const int kc_ = sc * 2;               \
    *(bf16x8*)(K_lds + (b) * SHM_K + KSWZ(sr, kc_)) = sr_[i].ks0;                       \
    *(bf16x8*)(K_lds + (b) * SHM_K + KSWZ(32 + sr, kc_)) = sr_[i].ks1; } while (0)
#define SWAIT() do { if constexpr (SDEPTH == 2) asm volatile("s_waitcnt vmcnt(4)" ::: "memory"); else asm volatile("s_waitcnt vmcnt(0)" ::: "memory"); } while (0)
#define RESC(a) do { if (__any((a) < 1.f)) { if (hi == 0) al_l[r32] = (a); asm volatile("s_waitcnt lgkmcnt(0)" ::: "memory"); \
    _Pragma("unroll") for (int d = 0; d < 4; ++d) _Pragma("unroll") for (int r = 0; r < 16; ++r) o[d][r] *= al_l[crow(r, hi)]; } } while (0)
#define MSK(jt) ((jt) >= 4), (dlane + ((jt) - 4) * 64)
  f32x16 pA0, pA1, pB0, pB1; float mnA, mnB, alA, alB; bf16x8 pa0, pa1, pa2, pa3;
  constexpr int SE = 0, SO = SDEPTH - 1;
  SLOAD(SE, 0); asm volatile("s_waitcnt vmcnt(0)" ::: "memory"); SWRITE(0, SE); __syncthreads();
  qkt(pA0, pA1, K_lds, qr, r32, hi); partialSM(pA0, pA1, m_reg, mnA, alA, MSK(0), hi);
  SLOAD(SO, 1); if constexpr (SDEPTH == 2) { if (2 < NT) SLOAD(SE, 2); }
  SWAIT(); SWRITE(1, SO); __syncthreads();
  for (int j = 1; j + 1 < NT; j += 2) {
    SBAR(); qkt(pB0, pB1, K_lds + SHM_K, qr, r32, hi);
    finishSM(pA0, pA1, alA, l_reg, pa0, pa1, pa2, pa3); SBAR();
    SLOAD(SO, j + SDEPTH); SBAR();
    pv_d0(o, vb0, pa0, pa1, pa2, pa3); partialSM(pB0, pB1, m_reg, mnB, alB, MSK(j), hi);
    __syncthreads(); SWAIT(); SWRITE(0, SE);
    RESC(alB); __syncthreads();
    SBAR(); qkt(pA0, pA1, K_lds, qr, r32, hi);
    finishSM(pB0, pB1, alB, l_reg, pa0, pa1, pa2, pa3); SBAR();
    if (SDEPTH == 1 || j + 3 < NT) SLOAD(SE, j + 1 + SDEPTH);
    SBAR();
    pv_d0(o, vb0 + (int)SHM_V, pa0, pa1, pa2, pa3); partialSM(pA0, pA1, m_reg, mnA, alA, MSK(j + 1), hi);
    __syncthreads(); SWAIT(); SWRITE(1, SO);
    RESC(alA); __syncthreads();
  }
  SBAR(); qkt(pB0, pB1, K_lds + SHM_K, qr, r32, hi);
  finishSM(pA0, pA1, alA, l_reg, pa0, pa1, pa2, pa3); SBAR();
  pv_d0(o, vb0, pa0, pa1, pa2, pa3); partialSM(pB0, pB1, m_reg, mnB, alB, MSK(NT - 1), hi);
  __syncthreads(); RESC(alB);
  finishSM(pB0, pB1, alB, l_reg, pa0, pa1, pa2, pa3); SBAR();
  pv_d0(o, vb0 + (int)SHM_V, pa0, pa1, pa2, pa3);
  { constexpr float C = SCALE * 1.4426950408889634f; l_reg += __builtin_amdgcn_exp2f(sinkp[wid >> 2] * 1.4426950408889634f - m_reg * C); }
  if (hi == 0) li_l[r32] = l_reg; asm volatile("s_waitcnt lgkmcnt(0)" ::: "memory");
  float rli[16];
#pragma unroll
  for (int r = 0; r < 16; ++r) rli[r] = __builtin_amdgcn_rcpf(li_l[crow(r, hi)]);
  bf16_t* Ow = O + (size_t)(qrow0 + (wid & 3) * 32) * DM + head * D;
#pragma unroll
  for (int r = 0; r < 16; ++r) { const int orow = crow(r, hi);
#pragma unroll
    for (int d0 = 0; d0 < 4; ++d0) { const float v = o[d0][r] * rli[r]; Ow[(size_t)orow * DM + d0 * 32 + r32] = (bf16_t)(cvtpk(v, v) & 0xffffu); } }
#undef TROW
#undef SLOAD
#undef SWRITE
#undef SWAIT
#undef RESC
#undef MSK
}
}

__device__ __forceinline__ void phase_attn(const bf16_t* Z, bf16_t* O, const float* sink, char* lds) {
    constexpr int NU_X = 2048, NU = NU_X + 128;
    for (int u = blockIdx.x; u < NU; u += gridDim.x) {
        if (u < NU_X) {
            const int xw = u & 7, sw = (u >> 3) & 31, b = u >> 8;
            const int kvh = xw >> 1, qb = 16 * (xw & 1) + (sw >> 1), hp = sw & 1;
            const int lo = qb > 0 ? (qb - 1) * 128 : 0, hi = qb < 31 ? (qb + 2) * 128 : SEQ;
            att::attn_unit(Z, O, b * SEQ + qb * 128, kvh * 4 + hp * 2, kvh, MX + b * CTXL, b * SEQ + lo, 4 + (hi - lo) / 64, lo - qb * 128, sink + kvh * 4 + hp * 2, lds);
        } else {
            const int v = u - NU_X; const int hp = v & 1, cqb = (v >> 1) & 1, kvh = (v >> 2) & 3, b = v >> 4;
            att::attn_unit(Z, O, MX + b * CTXL + cqb * 128, kvh * 4 + hp * 2, kvh, MX + b * CTXL, 0, 4, 0, sink + kvh * 4 + hp * 2, lds);
        }
        __syncthreads();
    }
}

__device__ __forceinline__ int scan_row(int b, int dir, int s) {
    if (dir == 0) return s < CTXL ? MX + b * CTXL + s : b * SEQ + (s - CTXL);
    return s < CTXL ? MX + b * CTXL + (CTXL - 1 - s) : b * SEQ + (SEQ - 1 - (s - CTXL));
}
namespace ms {
typedef __bf16 bf16x8v __attribute__((ext_vector_type(8)));
typedef __bf16 bf16x4v __attribute__((ext_vector_type(4)));
constexpr int QOFF = 0, KOFF = 16384, VOFF = 32768, BUFB = 49152;
constexpr int NOFF = 2 * BUFB;
constexpr int WPOFF = NOFF + 1024;
constexpr int NCHUNK = (CTXL + SEQ) / 64;
__host__ __device__ __forceinline__ unsigned off_b(unsigned row, unsigned ch) { return 256u * row + 16u * (ch ^ (((row & 3) << 2) | ((row >> 2) & 3))); }
__host__ __device__ __forceinline__ unsigned tr_addr_nat(unsigned lane, unsigned c, unsigned ks, unsigned t) {
    const unsigned h = lane >> 5, blk = (lane >> 4) & 1, q = (lane & 15) >> 2, p = lane & 3;
    return off_b(16 * ks + 8 * h + 4 * t + q, 4 * c + 2 * blk + (p >> 1)) + 8 * (p & 1);
}
__host__ __device__ __forceinline__ unsigned tr_addr_perm(unsigned lane, unsigned c, unsigned ks, unsigned t) {
    const unsigned h = lane >> 5, blk = (lane >> 4) & 1, q = (lane & 15) >> 2, p = lane & 3;
    return off_b(16 * ks + 8 * t + 4 * h + q, 4 * c + 2 * blk + (p >> 1)) + 8 * (p & 1);
}
template <int OFF> __device__ __forceinline__ s16x4 trr(unsigned addr) { s16x4 r; asm volatile("ds_read_b64_tr_b16 %0, %1 offset:%2" : "=v"(r) : "v"(addr), "i"(OFF) : "memory"); return r; }
__host__ __device__ __forceinline__ unsigned xr16(unsigned r) { return ((r & 3) << 2) | ((r >> 2) & 3); }
#define MS_LWAIT() do { asm volatile("s_waitcnt lgkmcnt(0)" ::: "memory"); __builtin_amdgcn_sched_barrier(0); } while (0)
__device__ __forceinline__ int crow(int r, int hi) { return (r & 3) + 8 * (r >> 2) + 4 * hi; }
__device__ __forceinline__ bf16x8 pack8(const f32x16& x, int s) {
    const f32x8 v = {x[8 * s + 0], x[8 * s + 1], x[8 * s + 2], x[8 * s + 3], x[8 * s + 4], x[8 * s + 5], x[8 * s + 6], x[8 * s + 7]};
    return __builtin_bit_cast(bf16x8, __builtin_convertvector(v, bf16x8v));
}
__device__ __forceinline__ float scan_incl_add(float x, int lane) {
#pragma unroll
    for (int o = 1; o < 64; o <<= 1) { const float v = __shfl_up(x, o); if (lane >= o) x += v; }
    return x;
}
__device__ __forceinline__ float scan_incl_max(float x, int lane) {
#pragma unroll
    for (int o = 1; o < 64; o <<= 1) { const float v = __shfl_up(x, o); if (lane >= o) x = fmaxf(x, v); }
    return x;
}
}

__device__ __forceinline__ void phase_scan2(const bf16_t* Z, const float* GATE, bf16_t* HF, bf16_t* HB, bool need_ctx_out, LAS unsigned char* lds, int tid, int lane, int wave) {
    using namespace ms;
    const int cb = wave & 3, th = wave >> 2, r = lane & 31, h = lane >> 5;
    LAS float* wp = (LAS float*)(lds + WPOFF + wave * 2048);
    LAS float* colf_l = wp; LAS float* wg_l = wp + 64; LAS float* ein_l = wp + 128; LAS float* rden_l = wp + 192;
    for (int task = blockIdx.x; task < 256; task += gridDim.x) {
        const int dvh = task & 1, dir = (task >> 1) & 1, hd = (task >> 2) & 7, b = task >> 5;
        bf16_t* HO = dir == 0 ? HF : HB;
        const int ocol = hd * 256 + dvh * 128 + cb * 32 + r;
        const int d_rl = lane >> 4, d_ch = (lane & 15) ^ ((d_rl << 2) | (wave & 3));
        const int d_col0 = hd * 128 + d_ch * 8, d_col1 = 1024 + hd * 128 + d_ch * 8, d_col2 = 2048 + hd * 256 + dvh * 128 + d_ch * 8;
        float g_ig, g_lf;
#define MS_DMA(c_, buf_) do { _Pragma("unroll") for (int i_ = 0; i_ < 6; ++i_) { const int rg_ = 8 * (i_ & 1) + wave; const int row_ = scan_row(b, dir, (c_) * 64 + 4 * rg_ + d_rl); \
            const int col_ = (i_ >> 1) == 0 ? d_col0 : ((i_ >> 1) == 1 ? d_col1 : d_col2); \
            __builtin_amdgcn_global_load_lds((const unsigned*)(Z + (size_t)row_ * NMI + col_), (LAS unsigned*)(lds + (buf_) * BUFB + (i_ >> 1) * 16384 + 1024 * rg_), 16, 0, 0); } \
            { const int row_ = scan_row(b, dir, (c_) * 64 + lane); g_ig = GATE[(size_t)row_ * 32 + (dir * 2) * 8 + hd]; g_lf = GATE[(size_t)row_ * 32 + (dir * 2 + 1) * 8 + hd]; } } while (0)
        f32x16 C[4];
#pragma unroll
        for (int ti = 0; ti < 4; ++ti)
#pragma unroll
            for (int i = 0; i < 16; ++i) C[ti][i] = 0.f;
        float m_prev = 0.f;
        __syncthreads();
        MS_DMA(0, 0);
        if (tid < 128) ((LAS float*)(lds + NOFF))[tid] = 0.f;
        float c_ig = g_ig, c_lf = g_lf;
        asm volatile("s_waitcnt vmcnt(0)" ::: "memory");
        __syncthreads();
        for (int c = 0; c < NCHUNK; ++c) {
            const int cur = c & 1;
            int lane_l = lane; asm volatile("" : "+v"(lane_l));
            const unsigned ul = (unsigned)lane_l, uh = ul >> 5, ublk = (ul >> 4) & 1, uq = (ul & 15) >> 2, up = ul & 3, ur = ul & 31;
            const unsigned cbase = (unsigned)(cur * BUFB);
            const unsigned a_nat = cbase + 256u * (8u * uh + uq) + ((64u * uq) | (32u * (ublk ^ uh)) | (16u * (up >> 1))) + 8u * (up & 1);
            const unsigned a_perm = cbase + 256u * (4u * uh + uq) + ((64u * uq) | (32u * ublk) | (16u * ((up >> 1) ^ uh))) + 8u * (up & 1);
            const unsigned a_row = cbase + 256u * ur + ((16u * xr16(ur)) ^ (16u * uh));
            const unsigned a_q64 = cbase + 256u * ur + 16u * xr16(ur) + 8u * uh + 8192u * (unsigned)th;
            const unsigned a_qn = cbase + 256u * ur + ((16u * xr16(ur)) ^ (128u * uh)) + 8192u * (unsigned)th;
            const LAS float* ncur = (const LAS float*)(lds + NOFF + cur * 512); LAS float* nnxt = (LAS float*)(lds + NOFF + (cur ^ 1) * 512);
            if (c + 1 < NCHUNK) MS_DMA(c + 1, cur ^ 1);
            const float bsum = scan_incl_add(c_lf, lane);
            const float av = c_ig - bsum;
            const float pm = scan_incl_max(av, lane);
            const float mm = fmaxf(m_prev, pm);
            const float ein = __expf(m_prev - mm), eneg = __expf(-(bsum + mm));
            const float b_end = __shfl(bsum, 63), mm_end = __shfl(mm, 63);
            const float e_prev = __expf(m_prev - mm_end);
            colf_l[lane] = av; wg_l[lane] = __expf(av - mm_end); ein_l[lane] = ein;
            const float rowf_r = -__shfl(mm, 32 * th + r), ein_r = __shfl(ein, 32 * th + r), eneg_r = __shfl(eneg, 32 * th + r);
            m_prev = b_end + mm_end;
            f32x16 X0, X1;
#pragma unroll
            for (int i = 0; i < 16; ++i) { X0[i] = 0.f; X1[i] = 0.f; }
#pragma unroll
            for (int ks = 0; ks < 8; ++ks) {
                const unsigned ar = a_row ^ (32u * ks);
                const bf16x8 qf = *(const LAS bf16x8*)(lds + ar + QOFF + 8192 * th);
                const bf16x8 k0 = *(const LAS bf16x8*)(lds + ar + KOFF);
                X0 = __builtin_amdgcn_mfma_f32_32x32x16_bf16(k0, qf, X0, 0, 0, 0);
                if (th == 1) { const bf16x8 k1 = *(const LAS bf16x8*)(lds + ar + KOFF + 8192); X1 = __builtin_amdgcn_mfma_f32_32x32x16_bf16(k1, qf, X1, 0, 0, 0); }
            }
            float qn = 0.f;
#pragma unroll
            for (int cc = 0; cc < 8; ++cc) { const u32x4 qv = *(const LAS u32x4*)(lds + (a_qn ^ (16u * cc)) + QOFF);
                const f32x4 n0 = *(const LAS f32x4*)(ncur + 64 * h + 8 * cc), n1 = *(const LAS f32x4*)(ncur + 64 * h + 8 * cc + 4);
                qn += bflo(qv.x) * n0[0] + bfhi(qv.x) * n0[1] + bflo(qv.y) * n0[2] + bfhi(qv.y) * n0[3] + bflo(qv.z) * n1[0] + bfhi(qv.z) * n1[1] + bflo(qv.w) * n1[2] + bfhi(qv.w) * n1[3]; }
            qn += __shfl_xor(qn, 32);
            float rsum = 0.f;
            if (th == 0) {
#pragma unroll
                for (int g4 = 0; g4 < 4; ++g4) { const f32x4 cf0 = *(const LAS f32x4*)(colf_l + 8 * g4 + 4 * h);
#pragma unroll
                    for (int e = 0; e < 4; ++e) { const int i = 4 * g4 + e; const int srow_ = 8 * g4 + 4 * h + e;
                        const float w = (srow_ <= r) ? __expf(rowf_r + cf0[e]) : 0.f; X0[i] *= w; rsum += X0[i]; } }
            } else {
#pragma unroll
                for (int g4 = 0; g4 < 4; ++g4) { const f32x4 cf0 = *(const LAS f32x4*)(colf_l + 8 * g4 + 4 * h), cf1 = *(const LAS f32x4*)(colf_l + 32 + 8 * g4 + 4 * h);
#pragma unroll
                    for (int e = 0; e < 4; ++e) { const int i = 4 * g4 + e; const int srow_ = 8 * g4 + 4 * h + e;
                        const float w0 = __expf(rowf_r + cf0[e]); X0[i] *= w0; rsum += X0[i];
                        const float w1 = (srow_ <= r) ? __expf(rowf_r + cf1[e]) : 0.f; X1[i] *= w1; rsum += X1[i]; } }
            }
            rsum += __shfl_xor(rsum, 32);
            { const float den = ein_r * qn + rsum; const float rd = 1.0f / fmaxf(fabsf(den), eneg_r); if (h == 0) rden_l[r] = rd; }
            f32x16 hacc;
#pragma unroll
            for (int i = 0; i < 16; ++i) hacc[i] = 0.f;
#pragma unroll
            for (int ti = 0; ti < 4; ++ti)
#pragma unroll
                for (int ks2 = 0; ks2 < 2; ++ks2) {
                    const s16x4 qa = *(const LAS s16x4*)(lds + (a_q64 ^ (16u * (4 * ti + 2 * ks2 + 0))) + QOFF);
                    const s16x4 qb = *(const LAS s16x4*)(lds + (a_q64 ^ (16u * (4 * ti + 2 * ks2 + 1))) + QOFF);
                    const bf16x8 af = {qa[0], qa[1], qa[2], qa[3], qb[0], qb[1], qb[2], qb[3]};
                    hacc = __builtin_amdgcn_mfma_f32_32x32x16_bf16(af, pack8(C[ti], ks2), hacc, 0, 0, 0);
                }
#pragma unroll
            for (int g4 = 0; g4 < 4; ++g4) { const f32x4 ev = *(const LAS f32x4*)(ein_l + 32 * th + 8 * g4 + 4 * h);
#pragma unroll
                for (int e = 0; e < 4; ++e) hacc[4 * g4 + e] *= ev[e]; }
            {
                const unsigned vb = (unsigned)(uintptr_t)lds + (a_perm ^ (64u * (unsigned)cb));
                const unsigned vb1 = vb ^ 32u;
                const s16x4 l00 = trr<VOFF + 256 * 0>(vb), h00 = trr<VOFF + 256 * 8>(vb1), l01 = trr<VOFF + 256 * 16>(vb), h01 = trr<VOFF + 256 * 24>(vb1);
                MS_LWAIT();
                hacc = __builtin_amdgcn_mfma_f32_32x32x16_bf16(pack8(X0, 0), (bf16x8){l00[0], l00[1], l00[2], l00[3], h00[0], h00[1], h00[2], h00[3]}, hacc, 0, 0, 0);
                hacc = __builtin_amdgcn_mfma_f32_32x32x16_bf16(pack8(X0, 1), (bf16x8){l01[0], l01[1], l01[2], l01[3], h01[0], h01[1], h01[2], h01[3]}, hacc, 0, 0, 0);
                if (th == 1) {
                    const s16x4 l10 = trr<VOFF + 256 * 32>(vb), h10 = trr<VOFF + 256 * 40>(vb1), l11 = trr<VOFF + 256 * 48>(vb), h11 = trr<VOFF + 256 * 56>(vb1);
                    MS_LWAIT();
                    hacc = __builtin_amdgcn_mfma_f32_32x32x16_bf16(pack8(X1, 0), (bf16x8){l10[0], l10[1], l10[2], l10[3], h10[0], h10[1], h10[2], h10[3]}, hacc, 0, 0, 0);
                    hacc = __builtin_amdgcn_mfma_f32_32x32x16_bf16(pack8(X1, 1), (bf16x8){l11[0], l11[1], l11[2], l11[3], h11[0], h11[1], h11[2], h11[3]}, hacc, 0, 0, 0);
                }
            }
            if (need_ctx_out || c >= CTXL / 64) {
#pragma unroll
                for (int g4 = 0; g4 < 4; ++g4) { const f32x4 rv = *(const LAS f32x4*)(rden_l + 8 * g4 + 4 * h);
#pragma unroll
                    for (int e = 0; e < 4; ++e) { const int t = 32 * th + 8 * g4 + 4 * h + e; const int row = scan_row(b, dir, c * 64 + t);
                        const float v = hacc[4 * g4 + e] * rv[e]; HO[(size_t)row * DM + ocol] = (bf16_t)(cvtpk(v, v) & 0xffffu); } }
            }
#pragma unroll
            for (int ti = 0; ti < 4; ++ti)
#pragma unroll
                for (int i = 0; i < 16; ++i) C[ti][i] *= e_prev;
            {
                const unsigned nb = (unsigned)(uintptr_t)lds + a_nat;
                const unsigned vb0 = nb ^ (64u * (unsigned)cb), vb1 = vb0 ^ 16u;
                const unsigned kb00 = nb, kb01 = nb ^ 16u, kb10 = nb ^ 64u, kb11 = nb ^ 80u, kb20 = nb ^ 128u, kb21 = nb ^ 144u, kb30 = nb ^ 192u, kb31 = nb ^ 208u;
#define MS_FSTEP(KS) do { \
                    const s16x4 vl = trr<VOFF + 256 * (16 * (KS))>(vb0), vh = trr<VOFF + 256 * (16 * (KS) + 4)>(vb1); \
                    const s16x4 k0l = trr<KOFF + 256 * (16 * (KS))>(kb00), k0h = trr<KOFF + 256 * (16 * (KS) + 4)>(kb01); \
                    const s16x4 k1l = trr<KOFF + 256 * (16 * (KS))>(kb10), k1h = trr<KOFF + 256 * (16 * (KS) + 4)>(kb11); \
                    const s16x4 k2l = trr<KOFF + 256 * (16 * (KS))>(kb20), k2h = trr<KOFF + 256 * (16 * (KS) + 4)>(kb21); \
                    const s16x4 k3l = trr<KOFF + 256 * (16 * (KS))>(kb30), k3h = trr<KOFF + 256 * (16 * (KS) + 4)>(kb31); \
                    const f32x4 w0 = *(const LAS f32x4*)(wg_l + 16 * (KS) + 8 * h), w1 = *(const LAS f32x4*)(wg_l + 16 * (KS) + 8 * h + 4); \
                    MS_LWAIT(); \
                    f32x8 vf; \
                    _Pragma("unroll") for (int e = 0; e < 4; ++e) { vf[e] = bf2f((bf16_t)vl[e]) * w0[e]; vf[4 + e] = bf2f((bf16_t)vh[e]) * w1[e]; } \
                    const bf16x8 vw = __builtin_bit_cast(bf16x8, __builtin_convertvector(vf, bf16x8v)); \
                    C[0] = __builtin_amdgcn_mfma_f32_32x32x16_bf16((bf16x8){k0l[0], k0l[1], k0l[2], k0l[3], k0h[0], k0h[1], k0h[2], k0h[3]}, vw, C[0], 0, 0, 0); \
                    C[1] = __builtin_amdgcn_mfma_f32_32x32x16_bf16((bf16x8){k1l[0], k1l[1], k1l[2], k1l[3], k1h[0], k1h[1], k1h[2], k1h[3]}, vw, C[1], 0, 0, 0); \
                    C[2] = __builtin_amdgcn_mfma_f32_32x32x16_bf16((bf16x8){k2l[0], k2l[1], k2l[2], k2l[3], k2h[0], k2h[1], k2h[2], k2h[3]}, vw, C[2], 0, 0, 0); \
                    C[3] = __builtin_amdgcn_mfma_f32_32x32x16_bf16((bf16x8){k3l[0], k3l[1], k3l[2], k3l[3], k3h[0], k3h[1], k3h[2], k3h[3]}, vw, C[3], 0, 0, 0); } while (0)
                MS_FSTEP(0); MS_FSTEP(1); MS_FSTEP(2); MS_FSTEP(3);
#undef MS_FSTEP
            }
            {
                const unsigned dl = ul & 15, sg = ul >> 4, d = 16u * (unsigned)wave + dl;
                const unsigned nl = cbase + KOFF + 4096u * sg + 16u * (d >> 3) + 2u * (d & 7);
                float acc = 0.f;
#pragma unroll
                for (int ss = 0; ss < 16; ++ss) { const bf16_t kv = *(const LAS bf16_t*)(lds + ((nl ^ (16u * xr16(ss))) + 256u * ss)); acc = fmaf(wg_l[16 * sg + ss], bf2f(kv), acc); }
                acc += __shfl_xor(acc, 16); acc += __shfl_xor(acc, 32);
                if (sg == 0) nnxt[d] = fmaf(e_prev, ncur[d], acc);
            }
            c_ig = g_ig; c_lf = g_lf;
            asm volatile("s_waitcnt vmcnt(0)" ::: "memory");
            __syncthreads();
        }
#undef MS_DMA
    }
}

namespace ms3 {
using namespace ms;
constexpr int SHOFF = NOFF + 1024;
constexpr int WP3OFF = SHOFF + 2048;
}
__device__ __forceinline__ void phase_scan3(const bf16_t* Z, const float* GATE, bf16_t* HF, bf16_t* HB, bool need_ctx_out, LAS unsigned char* lds, int tid, int lane, int wave) {
    using namespace ms; using namespace ms3;
    const int r = lane & 31, h = lane >> 5;
    const bool helper = wave >= 4; const int cb = wave & 3;
    LAS float* sh_colf = (LAS float*)(lds + SHOFF); LAS float* sh_wg = sh_colf + 64; LAS float* sh_ein = sh_colf + 128; LAS float* sh_rowf = sh_colf + 192; LAS float* sh_eneg = sh_colf + 256;
    LAS float* sh_qn = sh_colf + 320; LAS float* sh_scal = sh_colf + 384;
    LAS float* wpv = (LAS float*)(lds + WP3OFF + wave * 1024);
    for (int task = blockIdx.x; task < 256; task += gridDim.x) {
        const int dvh = task & 1, dir = (task >> 1) & 1, hd = (task >> 2) & 7, b = task >> 5;
        bf16_t* HO = dir == 0 ? HF : HB;
        const int ocol = hd * 256 + dvh * 128 + cb * 32 + r;
        const int d_rl = lane >> 4, d_ch = (lane & 15) ^ ((d_rl << 2) | (wave & 3));
        const int d_col0 = hd * 128 + d_ch * 8, d_col1 = 1024 + hd * 128 + d_ch * 8, d_col2 = 2048 + hd * 256 + dvh * 128 + d_ch * 8;
        float g_ig = 0.f, g_lf = 0.f;
#define MS_DMA(c_, buf_) do { _Pragma("unroll") for (int i_ = 0; i_ < 6; ++i_) { const int rg_ = 8 * (i_ & 1) + wave; const int row_ = scan_row(b, dir, (c_) * 64 + 4 * rg_ + d_rl); \
            const int col_ = (i_ >> 1) == 0 ? d_col0 : ((i_ >> 1) == 1 ? d_col1 : d_col2); \
            __builtin_amdgcn_global_load_lds((const unsigned*)(Z + (size_t)row_ * NMI + col_), (LAS unsigned*)(lds + (buf_) * BUFB + (i_ >> 1) * 16384 + 1024 * rg_), 16, 0, 0); } \
            if (helper) { const int row_ = scan_row(b, dir, (c_) * 64 + lane); g_ig = GATE[(size_t)row_ * 32 + (dir * 2) * 8 + hd]; g_lf = GATE[(size_t)row_ * 32 + (dir * 2 + 1) * 8 + hd]; } } while (0)
        f32x16 C[4];
#pragma unroll
        for (int ti = 0; ti < 4; ++ti)
#pragma unroll
            for (int i = 0; i < 16; ++i) C[ti][i] = 0.f;
        float m_prev = 0.f;
        __syncthreads();
        MS_DMA(0, 0);
        if (tid < 128) ((LAS float*)(lds + NOFF))[tid] = 0.f;
        float c_ig = g_ig, c_lf = g_lf;
        asm volatile("s_waitcnt vmcnt(0)" ::: "memory");
        __syncthreads();
        for (int c = 0; c < NCHUNK; ++c) {
            const int cur = c & 1;
            int lane_l = lane; asm volatile("" : "+v"(lane_l));
            const unsigned ul = (unsigned)lane_l, uh = ul >> 5, ublk = (ul >> 4) & 1, uq = (ul & 15) >> 2, up = ul & 3, ur = ul & 31;
            const unsigned cbase = (unsigned)(cur * BUFB);
            const LAS float* ncur = (const LAS float*)(lds + NOFF + cur * 512); LAS float* nnxt = (LAS float*)(lds + NOFF + (cur ^ 1) * 512);
            if (c + 1 < NCHUNK) MS_DMA(c + 1, cur ^ 1);
            if (helper) {
                const int hw = wave - 4;
                const float bsum = scan_incl_add(c_lf, lane);
                const float av = c_ig - bsum;
                const float pm = scan_incl_max(av, lane);
                const float mm = fmaxf(m_prev, pm);
                const float ein = __expf(m_prev - mm), eneg = __expf(-(bsum + mm));
                const float b_end = __shfl(bsum, 63), mm_end = __shfl(mm, 63);
                const float e_prev = __expf(m_prev - mm_end);
                const float wgv = __expf(av - mm_end);
                wpv[lane] = wgv;
                if (hw == 0) { sh_colf[lane] = av; sh_wg[lane] = wgv; sh_ein[lane] = ein; sh_rowf[lane] = -mm; sh_eneg[lane] = eneg; if (lane == 0) sh_scal[0] = e_prev; }
                m_prev = b_end + mm_end;
                {
                    const unsigned rr = ul & 15, dg = ul >> 4, row = 16u * (unsigned)hw + rr;
                    const unsigned qa = cbase + QOFF + 256u * row + 16u * ((4u * dg) ^ xr16(row & 15));
                    float qn = 0.f;
#pragma unroll
                    for (int cc = 0; cc < 4; ++cc) { const u32x4 qv = *(const LAS u32x4*)(lds + (qa ^ (16u * cc)));
                        const f32x4 n0 = *(const LAS f32x4*)(ncur + 32 * dg + 8 * cc), n1 = *(const LAS f32x4*)(ncur + 32 * dg + 8 * cc + 4);
                        qn += bflo(qv.x) * n0[0] + bfhi(qv.x) * n0[1] + bflo(qv.y) * n0[2] + bfhi(qv.y) * n0[3] + bflo(qv.z) * n1[0] + bfhi(qv.z) * n1[1] + bflo(qv.w) * n1[2] + bfhi(qv.w) * n1[3]; }
                    qn += __shfl_xor(qn, 16); qn += __shfl_xor(qn, 32);
                    if (dg == 0) sh_qn[row] = qn;
                }
                asm volatile("s_waitcnt lgkmcnt(0)" ::: "memory");
                __syncthreads();
                {
                    const unsigned dl = ul & 31, sg = ul >> 5, d = 32u * (unsigned)hw + dl;
                    const unsigned nl = cbase + KOFF + 8192u * sg + 16u * (d >> 3) + 2u * (d & 7);
                    float acc = 0.f;
#pragma unroll
                    for (int ss = 0; ss < 32; ++ss) { const bf16_t kv = *(const LAS bf16_t*)(lds + ((nl ^ (16u * xr16(ss & 15))) + 256u * ss)); acc = fmaf(wpv[32 * sg + ss], bf2f(kv), acc); }
                    acc += __shfl_xor(acc, 32);
                    if (sg == 0) nnxt[d] = fmaf(e_prev, ncur[d], acc);
                }
                c_ig = g_ig; c_lf = g_lf;
            } else {
                const unsigned a_nat = cbase + 256u * (8u * uh + uq) + ((64u * uq) | (32u * (ublk ^ uh)) | (16u * (up >> 1))) + 8u * (up & 1);
                const unsigned a_perm = cbase + 256u * (4u * uh + uq) + ((64u * uq) | (32u * ublk) | (16u * ((up >> 1) ^ uh))) + 8u * (up & 1);
                const unsigned a_row = cbase + 256u * ur + ((16u * xr16(ur)) ^ (16u * uh));
                const unsigned a_q64 = cbase + 256u * ur + 16u * xr16(ur) + 8u * uh;
                f32x16 Xa, Xb, Xc;
#pragma unroll
                for (int i = 0; i < 16; ++i) { Xa[i] = 0.f; Xb[i] = 0.f; Xc[i] = 0.f; }
#pragma unroll
                for (int ks = 0; ks < 8; ++ks) {
                    const unsigned ar = a_row ^ (32u * ks);
                    const bf16x8 q0 = *(const LAS bf16x8*)(lds + ar + QOFF), q1 = *(const LAS bf16x8*)(lds + ar + QOFF + 8192);
                    const bf16x8 k0 = *(const LAS bf16x8*)(lds + ar + KOFF), k1 = *(const LAS bf16x8*)(lds + ar + KOFF + 8192);
                    Xa = __builtin_amdgcn_mfma_f32_32x32x16_bf16(k0, q0, Xa, 0, 0, 0);
                    Xb = __builtin_amdgcn_mfma_f32_32x32x16_bf16(k0, q1, Xb, 0, 0, 0);
                    Xc = __builtin_amdgcn_mfma_f32_32x32x16_bf16(k1, q1, Xc, 0, 0, 0);
                }
                __syncthreads();
                const float e_prev = sh_scal[0];
                LAS float* rden_l = wpv;
                {
                    const float rowf0 = sh_rowf[r], rowf1 = sh_rowf[32 + r];
                    float rs0 = 0.f, rs1 = 0.f;
#pragma unroll
                    for (int g4 = 0; g4 < 4; ++g4) { const f32x4 cf0 = *(const LAS f32x4*)(sh_colf + 8 * g4 + 4 * h), cf1 = *(const LAS f32x4*)(sh_colf + 32 + 8 * g4 + 4 * h);
#pragma unroll
                        for (int e = 0; e < 4; ++e) { const int i = 4 * g4 + e; const int srow_ = 8 * g4 + 4 * h + e;
                            const float wa = (srow_ <= r) ? __expf(rowf0 + cf0[e]) : 0.f; Xa[i] *= wa; rs0 += Xa[i];
                            const float wb = __expf(rowf1 + cf0[e]); Xb[i] *= wb; rs1 += Xb[i];
                            const float wc = (srow_ <= r) ? __expf(rowf1 + cf1[e]) : 0.f; Xc[i] *= wc; rs1 += Xc[i]; } }
                    rs0 += __shfl_xor(rs0, 32); rs1 += __shfl_xor(rs1, 32);
                    const float den0 = sh_ein[r] * sh_qn[r] + rs0, den1 = sh_ein[32 + r] * sh_qn[32 + r] + rs1;
                    const float rd0 = 1.0f / fmaxf(fabsf(den0), sh_eneg[r]), rd1 = 1.0f / fmaxf(fabsf(den1), sh_eneg[32 + r]);
                    if (h == 0) { rden_l[r] = rd0; rden_l[32 + r] = rd1; }
                }
                f32x16 h0, h1;
#pragma unroll
                for (int i = 0; i < 16; ++i) { h0[i] = 0.f; h1[i] = 0.f; }
#pragma unroll
                for (int ti = 0; ti < 4; ++ti)
#pragma unroll
                    for (int ks2 = 0; ks2 < 2; ++ks2) {
                        const unsigned qx0 = a_q64 ^ (16u * (4 * ti + 2 * ks2 + 0)), qx1 = a_q64 ^ (16u * (4 * ti + 2 * ks2 + 1));
                        const s16x4 qa0 = *(const LAS s16x4*)(lds + qx0 + QOFF), qb0 = *(const LAS s16x4*)(lds + qx1 + QOFF);
                        const s16x4 qa1 = *(const LAS s16x4*)(lds + qx0 + QOFF + 8192), qb1 = *(const LAS s16x4*)(lds + qx1 + QOFF + 8192);
                        const bf16x8 cp = pack8(C[ti], ks2);
                        h0 = __builtin_amdgcn_mfma_f32_32x32x16_bf16((bf16x8){qa0[0], qa0[1], qa0[2], qa0[3], qb0[0], qb0[1], qb0[2], qb0[3]}, cp, h0, 0, 0, 0);
                        h1 = __builtin_amdgcn_mfma_f32_32x32x16_bf16((bf16x8){qa1[0], qa1[1], qa1[2], qa1[3], qb1[0], qb1[1], qb1[2], qb1[3]}, cp, h1, 0, 0, 0);
                    }
#pragma unroll
                for (int g4 = 0; g4 < 4; ++g4) { const f32x4 e0 = *(const LAS f32x4*)(sh_ein + 8 * g4 + 4 * h), e1 = *(const LAS f32x4*)(sh_ein + 32 + 8 * g4 + 4 * h);
#pragma unroll
                    for (int e = 0; e < 4; ++e) { h0[4 * g4 + e] *= e0[e]; h1[4 * g4 + e] *= e1[e]; } }
                {
                    const unsigned vb = (unsigned)(uintptr_t)lds + (a_perm ^ (64u * (unsigned)cb)); const unsigned vb1 = vb ^ 32u;
                    const s16x4 l00 = trr<VOFF + 256 * 0>(vb), h00 = trr<VOFF + 256 * 8>(vb1), l01 = trr<VOFF + 256 * 16>(vb), h01 = trr<VOFF + 256 * 24>(vb1);
                    const s16x4 l10 = trr<VOFF + 256 * 32>(vb), h10 = trr<VOFF + 256 * 40>(vb1), l11 = trr<VOFF + 256 * 48>(vb), h11 = trr<VOFF + 256 * 56>(vb1);
                    MS_LWAIT();
                    const bf16x8 v00 = {l00[0], l00[1], l00[2], l00[3], h00[0], h00[1], h00[2], h00[3]}, v01 = {l01[0], l01[1], l01[2], l01[3], h01[0], h01[1], h01[2], h01[3]};
                    const bf16x8 v10 = {l10[0], l10[1], l10[2], l10[3], h10[0], h10[1], h10[2], h10[3]}, v11 = {l11[0], l11[1], l11[2], l11[3], h11[0], h11[1], h11[2], h11[3]};
                    h0 = __builtin_amdgcn_mfma_f32_32x32x16_bf16(pack8(Xa, 0), v00, h0, 0, 0, 0);
                    h0 = __builtin_amdgcn_mfma_f32_32x32x16_bf16(pack8(Xa, 1), v01, h0, 0, 0, 0);
                    h1 = __builtin_amdgcn_mfma_f32_32x32x16_bf16(pack8(Xb, 0), v00, h1, 0, 0, 0);
                    h1 = __builtin_amdgcn_mfma_f32_32x32x16_bf16(pack8(Xb, 1), v01, h1, 0, 0, 0);
                    h1 = __builtin_amdgcn_mfma_f32_32x32x16_bf16(pack8(Xc, 0), v10, h1, 0, 0, 0);
                    h1 = __builtin_amdgcn_mfma_f32_32x32x16_bf16(pack8(Xc, 1), v11, h1, 0, 0, 0);
                }
                if (need_ctx_out || c >= CTXL / 64) {
#pragma unroll
                    for (int g4 = 0; g4 < 4; ++g4) { const f32x4 r0 = *(const LAS f32x4*)(rden_l + 8 * g4 + 4 * h), r1 = *(const LAS f32x4*)(rden_l + 32 + 8 * g4 + 4 * h);
#pragma unroll
                        for (int e = 0; e < 4; ++e) { const int t = 8 * g4 + 4 * h + e;
                            const int row0 = scan_row(b, dir, c * 64 + t), row1 = scan_row(b, dir, c * 64 + 32 + t);
                            const float v0 = h0[4 * g4 + e] * r0[e], v1 = h1[4 * g4 + e] * r1[e];
                            HO[(size_t)row0 * DM + ocol] = (bf16_t)(cvtpk(v0, v0) & 0xffffu); HO[(size_t)row1 * DM + ocol] = (bf16_t)(cvtpk(v1, v1) & 0xffffu); } }
                }
#pragma unroll
                for (int ti = 0; ti < 4; ++ti)
#pragma unroll
                    for (int i = 0; i < 16; ++i) C[ti][i] *= e_prev;
                {
                    const unsigned nb = (unsigned)(uintptr_t)lds + a_nat;
                    const unsigned vb0 = nb ^ (64u * (unsigned)cb), vb1 = vb0 ^ 16u;
                    const unsigned kb00 = nb, kb01 = nb ^ 16u, kb10 = nb ^ 64u, kb11 = nb ^ 80u, kb20 = nb ^ 128u, kb21 = nb ^ 144u, kb30 = nb ^ 192u, kb31 = nb ^ 208u;
#define MS_FSTEP(KS) do { \
                        const s16x4 vl = trr<VOFF + 256 * (16 * (KS))>(vb0), vh = trr<VOFF + 256 * (16 * (KS) + 4)>(vb1); \
                        const s16x4 k0l = trr<KOFF + 256 * (16 * (KS))>(kb00), k0h = trr<KOFF + 256 * (16 * (KS) + 4)>(kb01); \
                        const s16x4 k1l = trr<KOFF + 256 * (16 * (KS))>(kb10), k1h = trr<KOFF + 256 * (16 * (KS) + 4)>(kb11); \
                        const s16x4 k2l = trr<KOFF + 256 * (16 * (KS))>(kb20), k2h = trr<KOFF + 256 * (16 * (KS) + 4)>(kb21); \
                        const s16x4 k3l = trr<KOFF + 256 * (16 * (KS))>(kb30), k3h = trr<KOFF + 256 * (16 * (KS) + 4)>(kb31); \
                        const f32x4 w0 = *(const LAS f32x4*)(sh_wg + 16 * (KS) + 8 * h), w1 = *(const LAS f32x4*)(sh_wg + 16 * (KS) + 8 * h + 4); \
                        MS_LWAIT(); \
                        f32x8 vf; \
                        _Pragma("unroll") for (int e = 0; e < 4; ++e) { vf[e] = bf2f((bf16_t)vl[e]) * w0[e]; vf[4 + e] = bf2f((bf16_t)vh[e]) * w1[e]; } \
                        const bf16x8 vw = __builtin_bit_cast(bf16x8, __builtin_convertvector(vf, bf16x8v)); \
                        C[0] = __builtin_amdgcn_mfma_f32_32x32x16_bf16((bf16x8){k0l[0], k0l[1], k0l[2], k0l[3], k0h[0], k0h[1], k0h[2], k0h[3]}, vw, C[0], 0, 0, 0); \
                        C[1] = __builtin_amdgcn_mfma_f32_32x32x16_bf16((bf16x8){k1l[0], k1l[1], k1l[2], k1l[3], k1h[0], k1h[1], k1h[2], k1h[3]}, vw, C[1], 0, 0, 0); \
                        C[2] = __builtin_amdgcn_mfma_f32_32x32x16_bf16((bf16x8){k2l[0], k2l[1], k2l[2], k2l[3], k2h[0], k2h[1], k2h[2], k2h[3]}, vw, C[2], 0, 0, 0); \
                        C[3] = __builtin_amdgcn_mfma_f32_32x32x16_bf16((bf16x8){k3l[0], k3l[1], k3l[2], k3l[3], k3h[0], k3h[1], k3h[2], k3h[3]}, vw, C[3], 0, 0, 0); } while (0)
                    MS_FSTEP(0); MS_FSTEP(1); MS_FSTEP(2); MS_FSTEP(3);
#undef MS_FSTEP
                }
            }
            asm volatile("s_waitcnt vmcnt(0)" ::: "memory");
            __syncthreads();
        }
#undef MS_DMA
    }
}

namespace ms4 {
using namespace ms;
constexpr int GOFF = NOFF + 1024;
constexpr int GBUF = 6 * 64 * 4;
constexpr int POFF = GOFF + 2 * GBUF;
constexpr int RSOFF = POFF + 6144;
constexpr int WP4OFF = RSOFF + 1024;
}
__device__ __forceinline__ void phase_scan4(const bf16_t* Z, const float* GATE, bf16_t* HF, bf16_t* HB, bool need_ctx_out, LAS unsigned char* lds, int tid, int lane, int wave) {
    using namespace ms; using namespace ms4;
    const int r = lane & 31, h = lane >> 5;
    const bool score = wave >= 4; const int cb = wave & 3, T = wave - 4;
    LAS float* rsA = (LAS float*)(lds + RSOFF); LAS float* sh_qn = rsA + 96;
    LAS float* wpv = (LAS float*)(lds + WP4OFF + wave * 512);
    for (int task = blockIdx.x; task < 256; task += gridDim.x) {
        const int dvh = task & 1, dir = (task >> 1) & 1, hd = (task >> 2) & 7, b = task >> 5;
        bf16_t* HO = dir == 0 ? HF : HB;
        const int ocol0 = hd * 256 + dvh * 128 + cb * 32;
        const int d_rl = lane >> 4, d_ch = (lane & 15) ^ ((d_rl << 2) | (wave & 3));
        const int d_col0 = hd * 128 + d_ch * 8, d_col1 = 1024 + hd * 128 + d_ch * 8, d_col2 = 2048 + hd * 256 + dvh * 128 + d_ch * 8;
        float g_ig = 0.f, g_lf = 0.f;
        const int rstep = dir == 0 ? 1 : -1;
#define MS_DMA(c_, buf_) do { const int rb_ = scan_row(b, dir, (c_) * 64); _Pragma("unroll") for (int i_ = 0; i_ < 6; ++i_) { const int rg_ = 8 * (i_ & 1) + wave; const int row_ = rb_ + rstep * (4 * rg_ + d_rl); \
            const int col_ = (i_ >> 1) == 0 ? d_col0 : ((i_ >> 1) == 1 ? d_col1 : d_col2); \
            __builtin_amdgcn_global_load_lds((const unsigned*)(Z + (size_t)row_ * NMI + col_), (LAS unsigned*)(lds + (buf_) * BUFB + (i_ >> 1) * 16384 + 1024 * rg_), 16, 0, 0); } } while (0)
#define MS_GLOAD(c_) do { const int row_ = scan_row(b, dir, (c_) * 64) + rstep * lane; g_ig = GATE[(size_t)row_ * 32 + (dir * 2) * 8 + hd]; g_lf = GATE[(size_t)row_ * 32 + (dir * 2 + 1) * 8 + hd]; } while (0)
#define MS_GATES(gb_) do { \
            const float bsum_ = scan_incl_add(g_lf, lane); const float av_ = g_ig - bsum_; const float pm_ = scan_incl_max(av_, lane); const float mm_ = fmaxf(m_prev, pm_); \
            const float b_end_ = __shfl(bsum_, 63), mm_end_ = __shfl(mm_, 63); \
            if (T == 3) { LAS float* gp_ = (LAS float*)(lds + GOFF + (gb_) * GBUF); gp_[lane] = av_; gp_[64 + lane] = __expf(av_ - mm_end_); gp_[128 + lane] = __expf(m_prev - mm_); \
                gp_[192 + lane] = -mm_; gp_[256 + lane] = __expf(-(bsum_ + mm_)); if (lane == 0) gp_[320] = __expf(m_prev - mm_end_); } \
            m_prev = b_end_ + mm_end_; } while (0)
        f32x16 C[4];
#pragma unroll
        for (int ti = 0; ti < 4; ++ti)
#pragma unroll
            for (int i = 0; i < 16; ++i) C[ti][i] = 0.f;
        float m_prev = 0.f;
        __syncthreads();
        MS_DMA(0, 0);
        if (tid < 128) ((LAS float*)(lds + NOFF))[tid] = 0.f;
        if (score) { MS_GLOAD(0); MS_GATES(0); }
        asm volatile("s_waitcnt vmcnt(0) lgkmcnt(0)" ::: "memory");
        __syncthreads();
        for (int c = 0; c < NCHUNK; ++c) {
            const int cur = c & 1;
            int lane_l = lane; asm volatile("" : "+v"(lane_l));
            const unsigned ul = (unsigned)lane_l, uh = ul >> 5, ublk = (ul >> 4) & 1, uq = (ul & 15) >> 2, up = ul & 3, ur = ul & 31;
            const unsigned cbase = (unsigned)(cur * BUFB);
            const LAS float* ncur = (const LAS float*)(lds + NOFF + cur * 512); LAS float* nnxt = (LAS float*)(lds + NOFF + (cur ^ 1) * 512);
            const LAS float* gcur = (const LAS float*)(lds + GOFF + cur * GBUF);
            if (score) {
                if (c + 1 < NCHUNK) MS_GLOAD(c + 1);
                if (T < 3) {
                    const unsigned a_row = cbase + 256u * ur + ((16u * xr16(ur)) ^ (16u * uh));
                    const unsigned qoff = QOFF + (T == 0 ? 0u : 8192u), koff = KOFF + (T == 2 ? 8192u : 0u);
                    f32x16 X;
#pragma unroll
                    for (int i = 0; i < 16; ++i) X[i] = 0.f;
#pragma unroll
                    for (int ks = 0; ks < 8; ++ks) { const unsigned ar = a_row ^ (32u * ks);
                        X = __builtin_amdgcn_mfma_f32_32x32x16_bf16(*(const LAS bf16x8*)(lds + ar + koff), *(const LAS bf16x8*)(lds + ar + qoff), X, 0, 0, 0); }
                    const float rowf = gcur[192 + (T == 0 ? 0 : 32) + r];
                    const LAS float* cfp = gcur + (T == 2 ? 32 : 0);
                    float rs = 0.f;
#pragma unroll
                    for (int g4 = 0; g4 < 4; ++g4) { const f32x4 cf = *(const LAS f32x4*)(cfp + 8 * g4 + 4 * h);
#pragma unroll
                        for (int e = 0; e < 4; ++e) { const int i = 4 * g4 + e; const int srow_ = 8 * g4 + 4 * h + e;
                            const float w = (T == 1 || srow_ <= r) ? __expf(rowf + cf[e]) : 0.f; X[i] *= w; rs += X[i]; } }
                    rs += __shfl_xor(rs, 32);
                    if (h == 0) rsA[32 * T + r] = rs;
                    *(LAS bf16x8*)(lds + POFF + ((T * 2 + 0) * 64 + lane) * 16) = pack8(X, 0);
                    *(LAS bf16x8*)(lds + POFF + ((T * 2 + 1) * 64 + lane) * 16) = pack8(X, 1);
                }
                {
                    const unsigned rr = ul & 15, dg = ul >> 4, row = 16u * (unsigned)T + rr;
                    const unsigned qa = cbase + QOFF + 256u * row + 16u * ((4u * dg) ^ xr16(row & 15));
                    float qn = 0.f;
#pragma unroll
                    for (int cc = 0; cc < 4; ++cc) { const u32x4 qv = *(const LAS u32x4*)(lds + (qa ^ (16u * cc)));
                        const f32x4 n0 = *(const LAS f32x4*)(ncur + 32 * dg + 8 * cc), n1 = *(const LAS f32x4*)(ncur + 32 * dg + 8 * cc + 4);
                        qn += bflo(qv.x) * n0[0] + bfhi(qv.x) * n0[1] + bflo(qv.y) * n0[2] + bfhi(qv.y) * n0[3] + bflo(qv.z) * n1[0] + bfhi(qv.z) * n1[1] + bflo(qv.w) * n1[2] + bfhi(qv.w) * n1[3]; }
                    qn += __shfl_xor(qn, 16); qn += __shfl_xor(qn, 32);
                    if (dg == 0) sh_qn[row] = qn;
                }
                asm volatile("s_waitcnt lgkmcnt(0)" ::: "memory");
                __builtin_amdgcn_s_barrier(); asm volatile("" ::: "memory");
                asm volatile("" : "+v"(g_ig), "+v"(g_lf));
                if (c + 1 < NCHUNK) MS_DMA(c + 1, cur ^ 1);
                {
                    const float e_prev = gcur[320];
                    const unsigned dl = ul & 31, sg = ul >> 5, d = 32u * (unsigned)T + dl;
                    const unsigned nl = cbase + KOFF + 8192u * sg + 16u * (d >> 3) + 2u * (d & 7);
                    float acc = 0.f;
#pragma unroll
                    for (int ss = 0; ss < 32; ++ss) { const bf16_t kv = *(const LAS bf16_t*)(lds + ((nl ^ (16u * xr16(ss & 15))) + 256u * ss)); acc = fmaf(gcur[64 + 32 * sg + ss], bf2f(kv), acc); }
                    acc += __shfl_xor(acc, 32);
                    if (sg == 0) nnxt[d] = fmaf(e_prev, ncur[d], acc);
                }
                if (c + 1 < NCHUNK) MS_GATES(cur ^ 1);
            } else {
                const unsigned a_nat = cbase + 256u * (8u * uh + uq) + ((64u * uq) | (32u * (ublk ^ uh)) | (16u * (up >> 1))) + 8u * (up & 1);
                const unsigned a_perm = cbase + 256u * (4u * uh + uq) + ((64u * uq) | (32u * ublk) | (16u * ((up >> 1) ^ uh))) + 8u * (up & 1);
                const unsigned a_q64 = cbase + 256u * ur + 16u * xr16(ur) + 8u * uh;
                f32x16 h0, h1;
#pragma unroll
                for (int i = 0; i < 16; ++i) { h0[i] = 0.f; h1[i] = 0.f; }
#pragma unroll
                for (int ti = 0; ti < 4; ++ti)
#pragma unroll
                    for (int ks2 = 0; ks2 < 2; ++ks2) {
                        const unsigned qx0 = a_q64 ^ (16u * (4 * ti + 2 * ks2 + 0)), qx1 = a_q64 ^ (16u * (4 * ti + 2 * ks2 + 1));
                        const s16x4 qa0 = *(const LAS s16x4*)(lds + qx0 + QOFF), qb0 = *(const LAS s16x4*)(lds + qx1 + QOFF);
                        const s16x4 qa1 = *(const LAS s16x4*)(lds + qx0 + QOFF + 8192), qb1 = *(const LAS s16x4*)(lds + qx1 + QOFF + 8192);
                        const bf16x8 cp = pack8(C[ti], ks2);
                        h0 = __builtin_amdgcn_mfma_f32_32x32x16_bf16(cp, (bf16x8){qa0[0], qa0[1], qa0[2], qa0[3], qb0[0], qb0[1], qb0[2], qb0[3]}, h0, 0, 0, 0);
                        h1 = __builtin_amdgcn_mfma_f32_32x32x16_bf16(cp, (bf16x8){qa1[0], qa1[1], qa1[2], qa1[3], qb1[0], qb1[1], qb1[2], qb1[3]}, h1, 0, 0, 0);
                    }
                const float ein0 = gcur[128 + r], ein1 = gcur[128 + 32 + r];
#pragma unroll
                for (int i = 0; i < 16; ++i) { h0[i] *= ein0; h1[i] *= ein1; }
                if (c + 1 < NCHUNK) MS_DMA(c + 1, cur ^ 1);
                asm volatile("s_waitcnt lgkmcnt(0)" ::: "memory"); __builtin_amdgcn_s_barrier(); asm volatile("" ::: "memory");
                const float e_prev = gcur[320];
                const float den0 = ein0 * sh_qn[r] + rsA[r], den1 = ein1 * sh_qn[32 + r] + rsA[32 + r] + rsA[64 + r];
                const float rd0 = __builtin_amdgcn_rcpf(fmaxf(fabsf(den0), gcur[256 + r])), rd1 = __builtin_amdgcn_rcpf(fmaxf(fabsf(den1), gcur[256 + 32 + r]));
                {
                    const unsigned vb = (unsigned)(uintptr_t)lds + (a_perm ^ (64u * (unsigned)cb)); const unsigned vb1 = vb ^ 32u;
                    const s16x4 l00 = trr<VOFF + 256 * 0>(vb), h00 = trr<VOFF + 256 * 8>(vb1), l01 = trr<VOFF + 256 * 16>(vb), h01 = trr<VOFF + 256 * 24>(vb1);
                    const s16x4 l10 = trr<VOFF + 256 * 32>(vb), h10 = trr<VOFF + 256 * 40>(vb1), l11 = trr<VOFF + 256 * 48>(vb), h11 = trr<VOFF + 256 * 56>(vb1);
                    const LAS bf16x8* pf = (const LAS bf16x8*)(lds + POFF) + lane;
                    const bf16x8 pa0 = pf[0 * 64], pa1 = pf[1 * 64], pb0 = pf[2 * 64], pb1 = pf[3 * 64], pc0 = pf[4 * 64], pc1 = pf[5 * 64];
                    MS_LWAIT();
                    const bf16x8 v00 = {l00[0], l00[1], l00[2], l00[3], h00[0], h00[1], h00[2], h00[3]}, v01 = {l01[0], l01[1], l01[2], l01[3], h01[0], h01[1], h01[2], h01[3]};
                    const bf16x8 v10 = {l10[0], l10[1], l10[2], l10[3], h10[0], h10[1], h10[2], h10[3]}, v11 = {l11[0], l11[1], l11[2], l11[3], h11[0], h11[1], h11[2], h11[3]};
                    h0 = __builtin_amdgcn_mfma_f32_32x32x16_bf16(v00, pa0, h0, 0, 0, 0);
                    h0 = __builtin_amdgcn_mfma_f32_32x32x16_bf16(v01, pa1, h0, 0, 0, 0);
                    h1 = __builtin_amdgcn_mfma_f32_32x32x16_bf16(v00, pb0, h1, 0, 0, 0);
                    h1 = __builtin_amdgcn_mfma_f32_32x32x16_bf16(v01, pb1, h1, 0, 0, 0);
                    h1 = __builtin_amdgcn_mfma_f32_32x32x16_bf16(v10, pc0, h1, 0, 0, 0);
                    h1 = __builtin_amdgcn_mfma_f32_32x32x16_bf16(v11, pc1, h1, 0, 0, 0);
                }
                if (need_ctx_out || c >= CTXL / 64) {
                    const long es = (long)rstep * DM;
                    bf16_t* hp0 = HO + (size_t)scan_row(b, dir, c * 64) * DM + ocol0 + 8 * h + (long)r * es;
                    bf16_t* hp1 = hp0 + 32 * es;
#pragma unroll
                    for (int gp = 0; gp < 2; ++gp) { const int ib = 8 * gp;
                        { const unsigned a0 = cvtpk(h0[ib + 0] * rd0, h0[ib + 1] * rd0), a1 = cvtpk(h0[ib + 2] * rd0, h0[ib + 3] * rd0), b0 = cvtpk(h0[ib + 4] * rd0, h0[ib + 5] * rd0), b1 = cvtpk(h0[ib + 6] * rd0, h0[ib + 7] * rd0);
                          auto s0 = __builtin_amdgcn_permlane32_swap(a0, b0, false, false); auto s1 = __builtin_amdgcn_permlane32_swap(a1, b1, false, false);
                          *(u32x4*)(hp0 + 16 * gp) = (u32x4){s0[0], s1[0], s0[1], s1[1]}; }
                        { const unsigned a0 = cvtpk(h1[ib + 0] * rd1, h1[ib + 1] * rd1), a1 = cvtpk(h1[ib + 2] * rd1, h1[ib + 3] * rd1), b0 = cvtpk(h1[ib + 4] * rd1, h1[ib + 5] * rd1), b1 = cvtpk(h1[ib + 6] * rd1, h1[ib + 7] * rd1);
                          auto s0 = __builtin_amdgcn_permlane32_swap(a0, b0, false, false); auto s1 = __builtin_amdgcn_permlane32_swap(a1, b1, false, false);
                          *(u32x4*)(hp1 + 16 * gp) = (u32x4){s0[0], s1[0], s0[1], s1[1]}; } }
                }
#pragma unroll
                for (int ti = 0; ti < 4; ++ti)
#pragma unroll
                    for (int i = 0; i < 16; ++i) C[ti][i] *= e_prev;
                {
                    const unsigned nb = (unsigned)(uintptr_t)lds + a_nat;
                    const unsigned vb0 = nb ^ (64u * (unsigned)cb), vb1 = vb0 ^ 16u;
                    const unsigned kb00 = nb, kb01 = nb ^ 16u, kb10 = nb ^ 64u, kb11 = nb ^ 80u, kb20 = nb ^ 128u, kb21 = nb ^ 144u, kb30 = nb ^ 192u, kb31 = nb ^ 208u;
#define MS_FSTEP(KS) do { \
                        const s16x4 vl = trr<VOFF + 256 * (16 * (KS))>(vb0), vh = trr<VOFF + 256 * (16 * (KS) + 4)>(vb1); \
                        const s16x4 k0l = trr<KOFF + 256 * (16 * (KS))>(kb00), k0h = trr<KOFF + 256 * (16 * (KS) + 4)>(kb01); \
                        const s16x4 k1l = trr<KOFF + 256 * (16 * (KS))>(kb10), k1h = trr<KOFF + 256 * (16 * (KS) + 4)>(kb11); \
                        const s16x4 k2l = trr<KOFF + 256 * (16 * (KS))>(kb20), k2h = trr<KOFF + 256 * (16 * (KS) + 4)>(kb21); \
                        const s16x4 k3l = trr<KOFF + 256 * (16 * (KS))>(kb30), k3h = trr<KOFF + 256 * (16 * (KS) + 4)>(kb31); \
                        const f32x4 w0 = *(const LAS f32x4*)(gcur + 64 + 16 * (KS) + 8 * h), w1 = *(const LAS f32x4*)(gcur + 64 + 16 * (KS) + 8 * h + 4); \
                        MS_LWAIT(); \
                        f32x8 vf; \
                        _Pragma("unroll") for (int e = 0; e < 4; ++e) { vf[e] = bf2f((bf16_t)vl[e]) * w0[e]; vf[4 + e] = bf2f((bf16_t)vh[e]) * w1[e]; } \
                        const bf16x8 vw = __builtin_bit_cast(bf16x8, __builtin_convertvector(vf, bf16x8v)); \
                        C[0] = __builtin_amdgcn_mfma_f32_32x32x16_bf16((bf16x8){k0l[0], k0l[1], k0l[2], k0l[3], k0h[0], k0h[1], k0h[2], k0h[3]}, vw, C[0], 0, 0, 0); \
                        C[1] = __builtin_amdgcn_mfma_f32_32x32x16_bf16((bf16x8){k1l[0], k1l[1], k1l[2], k1l[3], k1h[0], k1h[1], k1h[2], k1h[3]}, vw, C[1], 0, 0, 0); \
                        C[2] = __builtin_amdgcn_mfma_f32_32x32x16_bf16((bf16x8){k2l[0], k2l[1], k2l[2], k2l[3], k2h[0], k2h[1], k2h[2], k2h[3]}, vw, C[2], 0, 0, 0); \
                        C[3] = __builtin_amdgcn_mfma_f32_32x32x16_bf16((bf16x8){k3l[0], k3l[1], k3l[2], k3l[3], k3h[0], k3h[1], k3h[2], k3h[3]}, vw, C[3], 0, 0, 0); } while (0)
                    MS_FSTEP(0); MS_FSTEP(1); MS_FSTEP(2); MS_FSTEP(3);
#undef MS_FSTEP
                }
            }
            if (!score && (need_ctx_out || c >= CTXL / 64)) asm volatile("s_waitcnt vmcnt(4) lgkmcnt(0)" ::: "memory");
            else asm volatile("s_waitcnt vmcnt(0) lgkmcnt(0)" ::: "memory");
            __syncthreads();
        }
#undef MS_DMA
#undef MS_GLOAD
#undef MS_GATES
    }
}

__device__ __forceinline__ void phase_mfinish(const bf16_t* Z, const bf16_t* HF, const bf16_t* HB, const float* ghead, bf16_t* H, int row_end, int lane, int wave) {
    const int gw = blockIdx.x * NWAVES + wave, NGW = gridDim.x * NWAVES;
    const int lcol = (lane >> 5) * 256 + (lane & 31) * 8;
    f32x4 gh[8];
#pragma unroll
    for (int j = 0; j < 4; ++j) { gh[2 * j] = *(const f32x4*)(ghead + lcol + 512 * j); gh[2 * j + 1] = *(const f32x4*)(ghead + lcol + 512 * j + 4); }
    const bool fast = NGW == 2048; const int b = gw & 7, w8 = gw >> 3;
    const int n_it = fast ? 8 + (MX + gw < row_end ? 1 : 0) : (gw < row_end ? (row_end - gw + 2 * NGW - 1) / (2 * NGW) : 0);
    for (int it = 0; it < n_it; ++it) {
        int r, r2;
        if (fast) { if (it < 8) { r = b * SEQ + w8 + 256 * (15 - it); r2 = b * SEQ + w8 + 256 * it; } else { r = MX + gw; r2 = r; } }
        else { r = gw + 2 * NGW * it; r2 = (r + NGW < row_end) ? r + NGW : r; }
        u32x4 fa[4], ba[4], oa[4], fb[4], bb[4], ob[4];
#pragma unroll
        for (int j = 0; j < 4; ++j) { const int col = lcol + 512 * j;
            fa[j] = *(const u32x4*)(HF + (size_t)r * DM + col); ba[j] = *(const u32x4*)(HB + (size_t)r * DM + col); oa[j] = *(const u32x4*)(Z + (size_t)r * NMI + 4096 + col);
            fb[j] = *(const u32x4*)(HF + (size_t)r2 * DM + col); bb[j] = *(const u32x4*)(HB + (size_t)r2 * DM + col); ob[j] = *(const u32x4*)(Z + (size_t)r2 * NMI + 4096 + col); }
#pragma unroll
        for (int j = 0; j < 4; ++j) { const int col = lcol + 512 * j;
            float sa[8] = {bflo(fa[j].x) + bflo(ba[j].x), bfhi(fa[j].x) + bfhi(ba[j].x), bflo(fa[j].y) + bflo(ba[j].y), bfhi(fa[j].y) + bfhi(ba[j].y),
                           bflo(fa[j].z) + bflo(ba[j].z), bfhi(fa[j].z) + bfhi(ba[j].z), bflo(fa[j].w) + bflo(ba[j].w), bfhi(fa[j].w) + bfhi(ba[j].w)};
            float sb[8] = {bflo(fb[j].x) + bflo(bb[j].x), bfhi(fb[j].x) + bfhi(bb[j].x), bflo(fb[j].y) + bflo(bb[j].y), bfhi(fb[j].y) + bfhi(bb[j].y),
                           bflo(fb[j].z) + bflo(bb[j].z), bfhi(fb[j].z) + bfhi(bb[j].z), bflo(fb[j].w) + bflo(bb[j].w), bfhi(fb[j].w) + bfhi(bb[j].w)};
            float qa = 0.f, qb = 0.f;
#pragma unroll
            for (int e = 0; e < 8; ++e) { qa += sa[e] * sa[e]; qb += sb[e] * sb[e]; }
#pragma unroll
            for (int o = 1; o < 32; o <<= 1) { qa += __shfl_xor(qa, o); qb += __shfl_xor(qb, o); }
            const float ra = 1.0f / sqrtf(qa * (1.0f / 256.0f) + RMS_EPS), rb = 1.0f / sqrtf(qb * (1.0f / 256.0f) + RMS_EPS);
            const float oav[8] = {bflo(oa[j].x), bfhi(oa[j].x), bflo(oa[j].y), bfhi(oa[j].y), bflo(oa[j].z), bfhi(oa[j].z), bflo(oa[j].w), bfhi(oa[j].w)};
            const float obv[8] = {bflo(ob[j].x), bfhi(ob[j].x), bflo(ob[j].y), bfhi(ob[j].y), bflo(ob[j].z), bfhi(ob[j].z), bflo(ob[j].w), bfhi(ob[j].w)};
            float ya[8], yb[8];
#pragma unroll
            for (int e = 0; e < 8; ++e) { const float gg = e < 4 ? gh[2 * j][e] : gh[2 * j + 1][e - 4]; ya[e] = sigmoid_f(oav[e]) * (sa[e] * ra) * gg; yb[e] = sigmoid_f(obv[e]) * (sb[e] * rb) * gg; }
            *(u32x4*)(H + (size_t)r * DM + col) = (u32x4){cvtpk(ya[0], ya[1]), cvtpk(ya[2], ya[3]), cvtpk(ya[4], ya[5]), cvtpk(ya[6], ya[7])};
            *(u32x4*)(H + (size_t)r2 * DM + col) = (u32x4){cvtpk(yb[0], yb[1]), cvtpk(yb[2], yb[3]), cvtpk(yb[4], yb[5]), cvtpk(yb[6], yb[7])}; }
    }
}

#ifndef STAGGER_TICKS
#define STAGGER_TICKS 125
#endif
__device__ __forceinline__ void gemm_stagger(int bx) {
    const unsigned long long d = (unsigned long long)((bx >> 3) & 7) * STAGGER_TICKS;
    if (d) { const unsigned long long t0 = __builtin_amdgcn_s_memrealtime(); while (__builtin_amdgcn_s_memrealtime() - t0 < d) __builtin_amdgcn_s_sleep(8); }
}
#ifndef PROBE_KIND
#define PROBE_KIND 0
#endif
#ifndef PROBE_WG
#define PROBE_WG 5
#endif
#ifndef PROBE_SITE
#define PROBE_SITE 0
#endif
#ifndef PROBE_N
#define PROBE_N 16
#endif
#ifndef BG_BUDGET
#define BG_BUDGET 3
#endif
#define BG_TAIL(nunits_, cidx_) do { const int rem_ = (nunits_) % G; if (i < 3 && rem_ != 0 && bx >= rem_) { TL bg_run(a, lds, i + 1, 3, 1 << 30, (const unsigned*)(a.ws + WS_CTL) + CW_DONE + 64 * (cidx_), (unsigned)(nunits_), tid, lane, wave); } } while (0)
constexpr int CW_DONE = 3584;
constexpr int N_PHASES = 38;
#define REP(bit) for (int rep_ = 0; rep_ < (((DUP_MASK) >> (bit)) & 1) + 1; ++rep_)
#ifndef EN_PRO
#define EN_PRO 1
#endif
#ifndef EN_NORM
#define EN_NORM 1
#endif
#ifndef EN_ROPE
#define EN_ROPE 1
#endif
#ifndef EN_ATTN
#define EN_ATTN 1
#endif
#ifndef EN_SCAN
#define EN_SCAN 1
#endif
#ifndef EN_MFIN
#define EN_MFIN 1
#endif
#ifndef EN_CONV
#define EN_CONV 1
#endif
#ifndef EN_FINAL
#define EN_FINAL 1
#endif
#ifndef EN_G1
#define EN_G1 1
#endif
#ifndef EN_G2
#define EN_G2 1
#endif
#ifndef EN_G3
#define EN_G3 1
#endif
#ifndef EN_G4
#define EN_G4 1
#endif
#ifndef EN_G5
#define EN_G5 1
#endif
#ifndef EN_G6
#define EN_G6 1
#endif
__global__ void __launch_bounds__(NTHREADS, 2) fwd(Args a) {
    extern __shared__ __attribute__((aligned(16))) unsigned char lds_raw[];
    LAS unsigned char* lds = (LAS unsigned char*)lds_raw;
    volatile LAS unsigned* MISC = (volatile LAS unsigned*)(lds + MISC_OFF);
    if (threadIdx.x < 32) MISC[threadIdx.x] = 0u;
    __syncthreads();
    unsigned* ctl = (unsigned*)(a.ws + WS_CTL);
    XcdBarrier bar = xcd_barrier_post(ctl + CW_BAR + a.li * XCD_BAR_WORDS, MISC + 8);
    const int G = gridDim.x, bx = blockIdx.x;
    const int lo = a.ph_lo, hi = a.ph_hi;
#define IN(k) (lo <= (k) && (k) < hi)
#define TL int tid = threadIdx.x; asm volatile("" : "+v"(tid)); const int lane = tid & 63, wave = __builtin_amdgcn_readfirstlane(tid >> 6); (void)lane; (void)wave;
#define SEAM(k) do { if (IN(k) && IN((k) + 1)) xcd_barrier(bar); } while (0)
    unsigned char* ws = a.ws;
    bf16_t* X = (bf16_t*)(ws + WS_X); bf16_t* H = (bf16_t*)(ws + WS_H); bf16_t* Z = (bf16_t*)(ws + WS_Z);
    float* GATE = (float*)(ws + WS_GATE); bf16_t* HF = (bf16_t*)(ws + WS_HF); bf16_t* HB = (bf16_t*)(ws + WS_HB);
    const float* mod = (const float*)(ws + WS_MOD);
    float* PART = (float*)(ws + WS_HB);

    if (EN_PRO && IN(0)) REP(0) { TL phase_prologue(a, lds, tid, lane, wave); }
    SEAM(0);

    for (int i = 0; i < 4; ++i) {
        const int P = 1 + 9 * i, j = i >> 1; const bool last = (i == 3);
        const float* modl = mod + (size_t)i * 9 * MODW;
        const float* xin32 = a.in[I_X]; const float* cin32 = a.in[I_CTX] - (size_t)MX * DM;
        const int pm_hi_mix = last ? MX / 256 : MT / 256;
        if (EN_NORM && IN(P + 0)) REP(1) { TL phase_norm(i == 0 ? (const void*)xin32 : (const void*)X, i == 0, i == 0 ? (const void*)cin32 : (const void*)X, i == 0, a.in[I_GMIX] + (size_t)i * DM, modl, 0, DM, H, MT, i > 0 ? PART : (const float*)nullptr, X, lane, wave); }
        SEAM(P + 0);
        if ((i & 1) == 0) {
            if (EN_G1 && IN(P + 1)) REP(2) { pg8::Gemm g{H, (const bf16_t*)(ws + WS_WQKV) + (size_t)j * NQKV * DM, MT, NQKV, DM, DM}; RangeOrder S; S.init(0, MT / 256, NQKV, G, bx);
                EpiQKV E{Z, (const float*)(ws + WS_ROPE), (const float*)(ws + WS_ROPE + 1 * MiB)};
#if PROBE_KIND
                if (PROBE_SITE == 2 && i == 2) pg8::gemm_phase<EpiQKV, RangeOrder, true>(lds, g, S, E, (unsigned long long*)(ws + 512 * 1024) + 64 * bx); else
#endif
                S.donectr = (unsigned*)(ws + WS_CTL) + CW_DONE + 64 * (2 * i);
                pg8::gemm_phase<EpiQKV, RangeOrder>(lds, g, S, E, nullptr);
                BG_TAIL((MT / 256) * (NQKV / 256), 2 * i); }
            SEAM(P + 1);
            if (EN_ATTN && IN(P + 3)) REP(3) { phase_attn(Z, H, a.in[I_SINK] + (size_t)j * 16, (char*)lds_raw); }
            SEAM(P + 3);
            if (EN_G2 && IN(P + 4)) { const bf16_t* Wt = (const bf16_t*)(ws + WS_WAO) + (size_t)j * DM * DM;
                { pg8::Gemm g{H, Wt, MT, DM, DM, DM}; RangeOrder S; S.init(0, MX / 256, DM, G, bx);
                  EpiRes E{xin32, i == 0 ? (const bf16_t*)nullptr : X, X, modl + 2 * DM}; pg8::gemm_phase<EpiRes, RangeOrder>(lds, g, S, E, nullptr); }
                { pg8::Gemm g{H, Wt, MT, DM, DM / 4, DM}; SplitOrder S; S.init(DM, DM, G, bx);
                  EpiPart E{PART, modl + 2 * DM, DM / 4}; pg8::gemm_phase<EpiPart, SplitOrder>(lds, g, S, E, nullptr); } }
            SEAM(P + 4);
        } else {
            if (EN_G3 && IN(P + 1)) REP(4) { pg8::Gemm g{H, (const bf16_t*)(ws + WS_WMI) + (size_t)j * NMI_PAD * DM, MT, NMI, DM, DM}; RangeOrder S; S.init(0, MT / 256, NMI, G, bx);
                EpiMI E{Z, GATE, a.in[I_BMI] + (size_t)j * NMI_RAW}; pg8::gemm_phase<EpiMI, RangeOrder>(lds, g, S, E, nullptr);
                { TL gate_run(a, lds, H, (const bf16_t*)(ws + WS_WMI) + (size_t)j * NMI_PAD * DM + (size_t)NMI * DM, a.in[I_BMI] + (size_t)j * NMI_RAW + NMI, GATE, j, tid, lane, wave); } }
            SEAM(P + 1);
            if (EN_SCAN && IN(P + 2)) REP(5) { TL phase_scan4(Z, GATE, HF, HB, !last, lds, tid, lane, wave); }
            SEAM(P + 2);
            if (EN_MFIN && IN(P + 3)) REP(6) { TL phase_mfinish(Z, HF, HB, a.in[I_GHEAD] + (size_t)j * DM, H, last ? MX : MT, lane, wave); }
            SEAM(P + 3);
            if (EN_G4 && IN(P + 4)) { const bf16_t* Wt = (const bf16_t*)(ws + WS_WMO) + (size_t)j * DM * DM;
                { pg8::Gemm g{H, Wt, MT, DM, DM, DM}; RangeOrder S; S.init(0, MX / 256, DM, G, bx);
                  EpiRes E{xin32, i == 0 ? (const bf16_t*)nullptr : X, X, modl + 2 * DM}; pg8::gemm_phase<EpiRes, RangeOrder>(lds, g, S, E, nullptr); }
                if (!last) { pg8::Gemm g{H, Wt, MT, DM, DM / 4, DM}; SplitOrder S; S.init(DM, DM, G, bx);
                  EpiPart E{PART, modl + 2 * DM, DM / 4}; pg8::gemm_phase<EpiPart, SplitOrder>(lds, g, S, E, nullptr); } }
            SEAM(P + 4);
        }
        if (EN_NORM && IN(P + 5)) REP(1) { TL phase_norm((const void*)X, false, i == 0 ? (const void*)cin32 : (const void*)X, i == 0, a.in[I_GFFN] + (size_t)i * DM, modl, 3 * DM, 4 * DM, H, last ? MX : MT, last ? (const float*)nullptr : PART, X, lane, wave); }
        SEAM(P + 5);
        {
            const int pm_hi = last ? MX / 256 : MT / 256;
            bf16_t* Gb = (bf16_t*)(ws + WS_Z); float* EA = (float*)(ws + WS_HF); float* EB = (float*)(ws + WS_HF + 16 * MiB);
            const float* cwp = a.in[I_CONVW] + (size_t)i * 3 * NUP; const float* cbp = a.in[I_CONVB] + (size_t)i * NUP;
            if (EN_G5 && IN(P + 6)) REP(7) { pg8::Gemm g{H, (const bf16_t*)(ws + WS_WUP) + (size_t)i * NUP * DM, MT, NUP, DM, DM}; RangeOrder S; S.init(0, pm_hi, NUP, G, bx);
                EpiUpConv E{Gb, EA, EB, cwp, cbp, (LAS float*)(lds + 132096)}; S.donectr = (unsigned*)(ws + WS_CTL) + CW_DONE + 64 * (2 * i + 1);
#if PROBE_KIND
                if (PROBE_SITE == 0 && i == 2) pg8::gemm_phase<EpiUpConv, RangeOrder, true>(lds, g, S, E, (unsigned long long*)(ws + 512 * 1024) + 64 * bx); else
#endif
                pg8::gemm_phase<EpiUpConv, RangeOrder>(lds, g, S, E, nullptr);
                BG_TAIL(pm_hi * (NUP / 256), 2 * i + 1); }
            SEAM(P + 6);
            if (EN_CONV && IN(P + 7)) REP(8) { TL phase_ffn_fix(Gb, EA, EB, cwp, cbp, pm_hi, tid); }
            SEAM(P + 7);
            if (EN_G6 && IN(P + 8)) { const bf16_t* Wt = (const bf16_t*)(ws + WS_WDN) + (size_t)i * DM * DFF;
                pg8::Gemm g{Gb, Wt, MT, DM, DFF, DFF}; RangeOrder S; S.init(0, MX / 256, DM, G, bx);
                EpiRes E{(const float*)nullptr, X, X, modl + 5 * DM};
#if PROBE_KIND
                if (PROBE_SITE == 1 && i == 2) pg8::gemm_phase<EpiRes, RangeOrder, true>(lds, g, S, E, (unsigned long long*)(ws + 512 * 1024) + 64 * bx); else
#endif
                pg8::gemm_phase<EpiRes, RangeOrder>(lds, g, S, E, nullptr);
                if (!last) { TL bg_run(a, lds, i + 1, i + 1, 1 << 30, (const unsigned*)nullptr, 0u, tid, lane, wave); __syncthreads(); }
                if (!last) { pg8::Gemm g2{Gb, Wt, MT, DM, DFF / 4, DFF}; SplitOrder S2; S2.init(DM, DFF, G, bx);
                  EpiPart E2{PART, modl + 5 * DM, DFF / 4}; pg8::gemm_phase<EpiPart, SplitOrder>(lds, g2, S2, E2, nullptr); } }
            SEAM(P + 8);
        }
    }
    if (EN_FINAL && IN(37)) { TL phase_final(X, a.in[I_GFINAL], a.out, lane, wave); }
#if PROBE_KIND
    __syncthreads();
    if (blockIdx.x == 0 && threadIdx.x == 0) {
        const unsigned long long* st = (const unsigned long long*)(ws + 512 * 1024) + 64 * PROBE_WG;
        double kl = 0, ep = 0; const int n = PROBE_N;
        for (int u = 1; u < 1 + n; ++u) { kl += (double)(st[2 + 2 * u] - st[3 + 2 * (u - 1)]); ep += (double)(st[3 + 2 * u] - st[2 + 2 * u]); }
        const double cyc = (double)(st[3 + 2 * 20] - st[3 + 2 * 1]), tk = 0;
        float v = 0.f;
        if (PROBE_KIND == 1) v = (float)(kl / n / 100.0);
        if (PROBE_KIND == 2) v = (float)(ep / n / 100.0);
        if (PROBE_KIND == 3) v = (float)((double)(st[63] - st[62]) / 10.0);
        if (PROBE_KIND == 4) v = (float)(cyc / 19.0 / 100.0);
        a.out[0] = v;
    }
#endif
#undef IN
#undef SEAM
}

#ifndef MK_N_LAUNCHES
#define MK_N_LAUNCHES 1
#endif
extern "C" void kernel_launch(void* const* d_in, const int* in_sizes, int n_in, void* d_out, int out_size, void* d_ws, size_t ws_size, hipStream_t stream) {
    static int grid = 0;
    if (grid == 0) {
        if (n_in != 20 || in_sizes[0] != MX * DM || out_size != MX * DM || ws_size < WS_END) {
            fprintf(stderr, "kernel_launch: shape mismatch (n_in %d, in0 %d, out %d, ws %zu, need ws >= %zu); nothing launched\n", n_in, n_in > 0 ? in_sizes[0] : -1, out_size, ws_size, (size_t)WS_END); grid = -1; return; }
        int dev = 0, cus = 0, per_cu = 0;
        if (hipGetDevice(&dev) != hipSuccess || hipDeviceGetAttribute(&cus, hipDeviceAttributeMultiprocessorCount, dev) != hipSuccess) { fprintf(stderr, "kernel_launch: device query failed\n"); grid = -1; return; }
        if (hipFuncSetAttribute((const void*)fwd, hipFuncAttributeMaxDynamicSharedMemorySize, LDS_BYTES) != hipSuccess) { fprintf(stderr, "kernel_launch: hipFuncSetAttribute failed\n"); grid = -1; return; }
        if (hipOccupancyMaxActiveBlocksPerMultiprocessor(&per_cu, (const void*)fwd, NTHREADS, LDS_BYTES) != hipSuccess || per_cu < 1) {
            fprintf(stderr, "kernel_launch: occupancy query reports %d workgroups per CU; nothing launched\n", per_cu); (void)hipGetLastError(); grid = -1; return; }
        grid = cus;
    }
    if (grid < 0) return;
    if (hipMemsetAsync((char*)d_ws + WS_CTL, 0, CTL_ZERO_BYTES, stream) != hipSuccess) { fprintf(stderr, "kernel_launch: memset failed\n"); return; }
    Args a{};
    for (int i = 0; i < 20; ++i) a.in[i] = (const float*)d_in[i];
    a.out = (float*)d_out; a.ws = (unsigned char*)d_ws; a.pad = 0;
    constexpr int NL = MK_N_LAUNCHES;
    for (int li = 0; li < NL; ++li) {
        a.ph_lo = (int)((long)li * N_PHASES / NL); a.ph_hi = (int)((long)(li + 1) * N_PHASES / NL); a.li = li;
        hipLaunchKernelGGL(fwd, dim3(grid), dim3(NTHREADS), LDS_BYTES, stream, a);
        const hipError_t le = hipPeekAtLastError();
        if (le != hipSuccess) { fprintf(stderr, "kernel_launch: launch %d failed: %s\n", li, hipGetErrorName(le)); break; }
    }
}
```

```cpp
#include <hip/hip_runtime.h>
namespace pg8 {
#define PG8_LAS __attribute__((address_space(3)))
typedef unsigned short bf16_t;
typedef short bf16x8 __attribute__((ext_vector_type(8)));
typedef float f32x4 __attribute__((ext_vector_type(4)));
typedef unsigned u32x4 __attribute__((ext_vector_type(4)));
constexpr int BM = 256, BK = 64, HALF = 128, HTB = HALF * BK * 2  , STAGE_BYTES = 8 * HTB, NXCD = 8, WGM = 4;

__host__ __device__ __forceinline__ int lds_byte(int r, int c) { const int st = (r >> 4) * 2 + (c >> 5), rr = r & 15, cc = c & 31, ob = rr * 64 + cc * 2; return st * 1024 + (ob ^ (((ob >> 9) & 1) << 5)); }
__host__ __device__ __forceinline__ void stage_rc(int b, int& R, int& C) { const int st = b / 1024, sb = b % 1024, swz = sb ^ (((sb >> 9) & 1) << 5); R = (st >> 1) * 16 + swz / 64; C = (st & 1) * 32 + (swz % 64) / 2; }
__host__ __device__ __forceinline__ int perm32(int rho) { const int n = rho >> 4, i = rho & 15; return 8 * (i >> 2) + 4 * n + (i & 3); }

struct Unit { int pm, pn, k0; };
struct Gemm { const bf16_t* A; const bf16_t* Bt; int M, N, K, ld; };

struct StaticOrder {
    int nM, nN, nwg, G, c;
    __host__ __device__ void init(int M, int N, int G_, int c_) { nM = M / BM; nN = N / BM; nwg = nM * nN; G = G_; c = c_; }
    __host__ __device__ bool next(int i, Unit& u) const {
        const long L = (long)i * G + c; if (L >= nwg) return false;
        int wgid = (int)L; { const int q = nwg / NXCD, r = nwg % NXCD, xcd = wgid % NXCD, off = wgid / NXCD; wgid = (xcd < r ? xcd * (q + 1) : r * (q + 1) + (xcd - r) * q) + off; }
        const int nig = WGM * nN, gid = wgid / nig, fm = gid * WGM, gsz = (nM - fm) < WGM ? (nM - fm) : WGM;
        u.pm = fm + ((wgid % nig) % gsz); u.pn = (wgid % nig) / gsz; u.k0 = 0; return true;
    }
    __device__ __forceinline__ void a_ready(const Unit&) const {}
    __device__ __forceinline__ void done(const Unit&) const {}
};
struct CountedOrder : StaticOrder {
    const unsigned* ready; unsigned need; unsigned* tmo;
    __device__ __forceinline__ void a_ready(const Unit& u) const {
        if (threadIdx.x < 64) {
            const unsigned long long t0 = __builtin_amdgcn_s_memrealtime(); unsigned polls = 0;
            while ((unsigned)__builtin_amdgcn_readfirstlane(__hip_atomic_load(ready + 64 * u.pm, __ATOMIC_RELAXED, __HIP_MEMORY_SCOPE_AGENT)) < need) {
                if ((++polls & 255u) == 0u && __builtin_amdgcn_readfirstlane(__hip_atomic_load(tmo, __ATOMIC_RELAXED, __HIP_MEMORY_SCOPE_AGENT)) != 0u) break;
                if (__builtin_amdgcn_s_memrealtime() - t0 > 2000000ull) {
                    if (threadIdx.x == 0) { unsigned expect = 0u; __hip_atomic_compare_exchange_strong(tmo + 1, &expect, 0x600u | (unsigned)(u.pm & 0xff), __ATOMIC_RELAXED, __ATOMIC_RELAXED, __HIP_MEMORY_SCOPE_AGENT); __hip_atomic_store(tmo, 1u, __ATOMIC_RELAXED, __HIP_MEMORY_SCOPE_AGENT); }
                    break; }
                __builtin_amdgcn_s_sleep(2); }
            __builtin_amdgcn_fence(__ATOMIC_ACQUIRE, "agent");
            asm volatile("s_waitcnt vmcnt(0)" ::: "memory");
        }
#if !defined(BROKEN_HOOK_NO_BARRIER)
        asm volatile("" ::: "memory"); __builtin_amdgcn_s_barrier(); asm volatile("" ::: "memory");
#endif
    }
};

template <class Epi, class Sched, bool STAMP = false>
__device__ __forceinline__ void gemm_phase(PG8_LAS unsigned char* lds, const Gemm g, const Sched& S, const Epi& E, unsigned long long* stamps) {
    int tid_l = threadIdx.x; asm volatile("" : "+v"(tid_l));
    const int tid = tid_l, wid = __builtin_amdgcn_readfirstlane(tid >> 6), lane = tid & 63, wr = wid >> 2, wc = wid & 3, fr = lane & 15, fq = lane >> 4;
    const int K = g.ld, nt = g.K / BK;
    int ts_lo = 0, ts_hi = 0, nts = 0; const unsigned long long rt_entry = STAMP ? (unsigned long long)wall_clock64() : 0ull;
#define PG8_STAMP() do { if (STAMP && wid == 0 && nts < 64) { const unsigned long long _c = (unsigned long long)clock64(); \
        ts_lo = (lane == nts) ? (int)(unsigned)_c : ts_lo; ts_hi = (lane == nts) ? (int)(unsigned)(_c >> 32) : ts_hi; ++nts; } } while (0)
    PG8_STAMP();
    unsigned voffA[2], voffB[2];
#pragma unroll
    for (int i = 0; i < 2; ++i) { int R, C; stage_rc(tid * 16 + i * 8192, R, C); const int Rb = Epi::PERM ? ((R & ~31) + perm32(R & 31)) : R;
        voffA[i] = (unsigned)(R * K + C) * 2u; voffB[i] = (unsigned)(Rb * K + C) * 2u; }
    const size_t kstep = (size_t)(BK * 2);
    const size_t hstep = (size_t)HALF * K * 2;
    const size_t tstep = 2 * hstep;
    const unsigned ldsw = (unsigned)wid * 1024u;
    const int aoff = lds_byte(wr * 64 + fr, fq * 8), boff = lds_byte(wc * 32 + fr, fq * 8);
#define PG8_SA(b, h) (((b) * 2 + (h)) * HTB)
#define PG8_SB(b, h) ((4 + (b) * 2 + (h)) * HTB)
#define PG8_STAGE(bufoff, gbase, voff) do { _Pragma("unroll") for (int _i = 0; _i < 2; ++_i) \
        __builtin_amdgcn_global_load_lds((const unsigned*)((const char*)(gbase) + (voff)[_i]), (PG8_LAS unsigned*)(lds + (bufoff) + ldsw + _i * 8192), 16, 0, 0); } while (0)
#define PG8_LDA(dst, b, h) do { _Pragma("unroll") for (int m = 0; m < 4; ++m) _Pragma("unroll") for (int k = 0; k < 2; ++k) dst[m][k] = *(const PG8_LAS bf16x8*)(lds + PG8_SA(b, h) + aoff + m * 2048 + k * 1024); } while (0)
#define PG8_LDB(dst, b, h) do { _Pragma("unroll") for (int n = 0; n < 2; ++n) _Pragma("unroll") for (int k = 0; k < 2; ++k) dst[n][k] = *(const PG8_LAS bf16x8*)(lds + PG8_SB(b, h) + boff + n * 2048 + k * 1024); } while (0)
#define PG8_MMA(ai, bj, At, Bt) do { __builtin_amdgcn_s_setprio(1); _Pragma("unroll") for (int m = 0; m < 4; ++m) _Pragma("unroll") for (int n = 0; n < 2; ++n) _Pragma("unroll") for (int k = 0; k < 2; ++k) \
        acc[ai][bj][m][n] = __builtin_amdgcn_mfma_f32_16x16x32_bf16(Bt[n][k], At[m][k], acc[ai][bj][m][n], 0, 0, 0); __builtin_amdgcn_s_setprio(0); } while (0)
#define PG8_WAIT_V(n) asm volatile("s_waitcnt vmcnt(" #n ")" ::: "memory")
#define PG8_WAIT_L(n) asm volatile("s_waitcnt lgkmcnt(" #n ")" ::: "memory")
#define PG8_BAR __builtin_amdgcn_s_barrier()
#define PG8_SCHED __builtin_amdgcn_sched_barrier(0)
    Unit cur, nxt; int ui = 0;
    if (!S.next(0, cur)) return;
    f32x4 acc[2][2][4][2];
#pragma unroll
    for (int a = 0; a < 2; ++a)
#pragma unroll
        for (int b = 0; b < 2; ++b)
#pragma unroll
            for (int m = 0; m < 4; ++m)
#pragma unroll
                for (int n = 0; n < 2; ++n) acc[a][b][m][n] = (f32x4){0.f, 0.f, 0.f, 0.f};
    bf16x8 At[4][2], B0[2][2], B1[2][2];
    const char* cA = (const char*)g.A + (size_t)cur.pm * tstep + (size_t)cur.k0 * 2; const char* cB = (const char*)g.Bt + (size_t)cur.pn * tstep + (size_t)cur.k0 * 2;
    S.a_ready(cur);
    PG8_STAGE(PG8_SB(0, 0), cB, voffB); PG8_STAGE(PG8_SA(0, 0), cA, voffA); PG8_STAGE(PG8_SB(0, 1), cB + hstep, voffB); PG8_STAGE(PG8_SA(0, 1), cA + hstep, voffA);
    if (wr == 1) PG8_BAR;
    PG8_WAIT_V(4); PG8_BAR;
    PG8_STAGE(PG8_SB(1, 0), cB + kstep, voffB); PG8_STAGE(PG8_SA(1, 0), cA + kstep, voffA); PG8_STAGE(PG8_SB(1, 1), cB + hstep + kstep, voffB);
    PG8_WAIT_V(6); PG8_BAR;
    PG8_STAMP();
    for (;;) {
        const bool has_next = S.next(ui + 1, nxt);
        const char* nA = has_next ? (const char*)g.A + (size_t)nxt.pm * tstep + (size_t)nxt.k0 * 2 : cA; const char* nB = has_next ? (const char*)g.Bt + (size_t)nxt.pn * tstep + (size_t)nxt.k0 * 2 : cB;
        for (int t = 0; t < nt; t += 2) {
            const bool last = (t == nt - 2);
            const char* a1 = cA + (size_t)(t + 1) * kstep;
            const char* a2 = last ? nA : cA + (size_t)(t + 2) * kstep; const char* b2 = last ? nB : cB + (size_t)(t + 2) * kstep;
            const char* a3 = a2 + kstep; const char* b3 = b2 + kstep;
            if (last && has_next) S.a_ready(nxt);
            PG8_LDB(B0, 0, 0); PG8_SCHED; PG8_LDA(At, 0, 0); PG8_STAGE(PG8_SA(1, 1), a1 + hstep, voffA);
            PG8_WAIT_L(8); PG8_BAR; PG8_WAIT_L(0); PG8_MMA(0, 0, At, B0); PG8_BAR; PG8_SCHED;
            PG8_LDB(B1, 0, 1); PG8_STAGE(PG8_SB(0, 0), b2, voffB);
            PG8_BAR; PG8_WAIT_L(0); PG8_MMA(0, 1, At, B1); PG8_BAR;
            PG8_LDA(At, 0, 1); PG8_STAGE(PG8_SA(0, 0), a2, voffA);
            PG8_BAR; PG8_WAIT_L(0); PG8_MMA(1, 0, At, B0); PG8_BAR; PG8_SCHED;
            PG8_STAGE(PG8_SB(0, 1), b2 + hstep, voffB);
            PG8_WAIT_V(6); PG8_BAR; PG8_MMA(1, 1, At, B1); PG8_BAR;
            PG8_LDB(B0, 1, 0); PG8_SCHED; PG8_LDA(At, 1, 0); PG8_STAGE(PG8_SA(0, 1), a2 + hstep, voffA);
            PG8_WAIT_L(8); PG8_BAR; PG8_WAIT_L(0); PG8_MMA(0, 0, At, B0); PG8_BAR; PG8_SCHED;
            PG8_LDB(B1, 1, 1); PG8_STAGE(PG8_SB(1, 0), b3, voffB);
            PG8_BAR; PG8_WAIT_L(0); PG8_MMA(0, 1, At, B1); PG8_BAR;
            PG8_LDA(At, 1, 1); PG8_STAGE(PG8_SA(1, 0), a3, voffA);
            PG8_BAR; PG8_WAIT_L(0); PG8_MMA(1, 0, At, B0); PG8_BAR; PG8_SCHED;
            PG8_STAGE(PG8_SB(1, 1), b3 + hstep, voffB);
            PG8_WAIT_V(6); PG8_BAR; PG8_MMA(1, 1, At, B1); PG8_BAR;
        }
        PG8_STAMP();
        if constexpr (!Epi::AFTER_DRAIN) { E(acc, cur, wr, wc, fr, fq); S.done(cur); }
        PG8_STAMP();
        if (!has_next) break;
#pragma unroll
        for (int a = 0; a < 2; ++a)
#pragma unroll
            for (int b = 0; b < 2; ++b)
#pragma unroll
                for (int m = 0; m < 4; ++m)
#pragma unroll
                    for (int n = 0; n < 2; ++n) acc[a][b][m][n] = (f32x4){0.f, 0.f, 0.f, 0.f};
        cur = nxt; cA = nA; cB = nB; ++ui;
    }
    PG8_WAIT_V(0);
    if (wr == 0) PG8_BAR;
    PG8_BAR;
    if constexpr (Epi::AFTER_DRAIN) { E.fused(acc, cur, wr, wc, fr, fq, lds, wid, lane); S.done(cur); }
    PG8_STAMP();
    if (STAMP && wid == 0) { stamps[lane] = lane < nts ? (((unsigned long long)(unsigned)ts_hi << 32) | (unsigned)ts_lo) : 0ull;
        if (lane == 62) stamps[62] = rt_entry; if (lane == 63) stamps[63] = (unsigned long long)wall_clock64(); }
#undef PG8_STAMP
#undef PG8_SA
#undef PG8_SB
#undef PG8_STAGE
#undef PG8_LDA
#undef PG8_LDB
#undef PG8_MMA
#undef PG8_WAIT_V
#undef PG8_WAIT_L
#undef PG8_BAR
#undef PG8_SCHED
}
}
#ifndef DUP_MASK
#define DUP_MASK 0
#endif

#include <cstdio>
#include <cstdint>
#define LAS __attribute__((address_space(3)))
typedef unsigned short bf16_t;
typedef short bf16x8 __attribute__((ext_vector_type(8)));
typedef short s16x4 __attribute__((ext_vector_type(4)));
typedef float f32x4 __attribute__((ext_vector_type(4)));
typedef float f32x8 __attribute__((ext_vector_type(8)));
typedef float f32x16 __attribute__((ext_vector_type(16)));
typedef unsigned u32x4 __attribute__((ext_vector_type(4)));
typedef unsigned u32x2 __attribute__((ext_vector_type(2)));

constexpr int DM = 2048, NBATCH = 8, SEQ = 4096, CTXL = 256;
constexpr int MX = NBATCH * SEQ, MC = NBATCH * CTXL, MT = MX + MC;
constexpr int NQKV = 3072, NMI = 6144, NMI_RAW = 6176, NMI_PAD = 6400, DFF = 5632, NUP = 2 * DFF;
constexpr int MODW = 6 * DM;
constexpr float RMS_EPS = 1e-6f;
constexpr int NTHREADS = 512, NWAVES = 8;

constexpr size_t MiB = 1u << 20;
constexpr size_t WS_CTL = 0, CTL_ZERO_BYTES = 1 * MiB;
constexpr size_t WS_MOD = 1 * MiB;
constexpr size_t WS_ROPE = 3 * MiB;
constexpr size_t WS_WQKV = 8 * MiB;
constexpr size_t WS_WAO = 32 * MiB;
constexpr size_t WS_WMI = 48 * MiB;
constexpr size_t WS_WMO = 98 * MiB;
constexpr size_t WS_WUP = 114 * MiB;
constexpr size_t WS_WDN = 290 * MiB;
constexpr size_t WS_X = 378 * MiB;
constexpr size_t WS_H = 650 * MiB;
constexpr size_t WS_Z = 786 * MiB;
constexpr size_t WS_GATE = 1194 * MiB;
constexpr size_t WS_HF = 1200 * MiB;
constexpr size_t WS_HB = 1336 * MiB;
constexpr size_t WS_END = 1472 * MiB;
constexpr int CW_TMO = 0;
constexpr int CW_BAR = 4096;

constexpr int LDS_BYTES = 147456;
constexpr int MISC_OFF = LDS_BYTES - 256;

#define XB_TMO      128
#define XB_XCNT(j)  (256  + 64 * (j))
#define XB_XSUB(j)  (1280 + 64 * (j))
#define XB_XGEN(j)  (2304 + 64 * (j))
#define XB_TOP      3328
#define XB_TOPGEN   3392
#define XCD_BAR_WORDS 3456
#define XB_SPIN_CAP (1u << 18)

__device__ __forceinline__ unsigned xb_ld(unsigned* p)              { return __hip_atomic_load(p, __ATOMIC_RELAXED, __HIP_MEMORY_SCOPE_AGENT); }
__device__ __forceinline__ unsigned xb_add(unsigned* p, unsigned v) { return __hip_atomic_fetch_add(p, v, __ATOMIC_RELAXED, __HIP_MEMORY_SCOPE_AGENT); }
__device__ __forceinline__ unsigned xb_xcc_id() { return (unsigned)__builtin_amdgcn_s_getreg((3 << 11) | 20) & 0xFu; }
#define XB_SPIN(cond, bar) do { unsigned _sp = 0; while (cond) { __builtin_amdgcn_s_sleep(1); \
    if ((++_sp & 255u) == 0u) { if (xb_ld(&(bar)[XB_TMO])) break; if (_sp > XB_SPIN_CAP) { atomicAdd(&(bar)[XB_TMO], 1u); break; } } } } while (0)

struct XcdBarrier { unsigned* bar; unsigned x; volatile LAS unsigned* st; };

__device__ __forceinline__ XcdBarrier xcd_barrier_post(unsigned* bar, volatile LAS unsigned* st) {
    XcdBarrier b; b.bar = bar; b.x = xb_xcc_id(); b.st = st;
    if (threadIdx.x == 0) (void)xb_add(&bar[XB_XCNT(b.x)], 1u);
    return b;
}
__device__ __forceinline__ void xcd_barrier_complete(unsigned* bar, unsigned x, unsigned& nloc, unsigned& nx) {
    const unsigned G = gridDim.x * gridDim.y * gridDim.z;
    unsigned sum, cnt, mine, sp = 0u;
    for (;;) {
        sum = 0u; cnt = 0u; mine = 0u;
#pragma unroll
        for (unsigned j = 0; j < 16; ++j) { const unsigned c = xb_ld(&bar[XB_XCNT(j)]); sum += c; cnt += (c > 0u) ? 1u : 0u; mine = (j == x) ? c : mine; }
        if (sum == G) break;
        __builtin_amdgcn_s_sleep(1);
        if ((++sp & 255u) == 0u) { if (xb_ld(&bar[XB_TMO])) break; if (sp > XB_SPIN_CAP) { atomicAdd(&bar[XB_TMO], 1u); break; } }
    }
    nloc = mine > 0u ? mine : 1u; nx = cnt > 0u ? cnt : 1u;
}
__device__ __forceinline__ void xcd_barrier(const XcdBarrier& b) {
    asm volatile("s_waitcnt vmcnt(0)" ::: "memory");
    __syncthreads();
    if (threadIdx.x == 0) {
        unsigned* bar = b.bar;
        __builtin_amdgcn_s_waitcnt(0);
        unsigned nloc = b.st[0], nx = b.st[1];
        if (nloc == 0u) { xcd_barrier_complete(bar, b.x, nloc, nx); b.st[0] = nloc; b.st[1] = nx; }
        const unsigned old = xb_add(&bar[XB_XSUB(b.x)], 1u);
        const unsigned gen = old / nloc;
        if (old + 1u == (gen + 1u) * nloc) {
            __builtin_amdgcn_fence(__ATOMIC_RELEASE, "agent");
            asm volatile("s_waitcnt vmcnt(0)" ::: "memory");
            const unsigned og = xb_add(&bar[XB_TOP], 1u);
            const unsigned tg = og / nx;
            if (og + 1u == (tg + 1u) * nx) xb_add(&bar[XB_TOPGEN], 1u);
            else XB_SPIN(xb_ld(&bar[XB_TOPGEN]) == tg, bar);
            __builtin_amdgcn_fence(__ATOMIC_ACQUIRE, "agent");
            xb_add(&bar[XB_XGEN(b.x)], 1u);
            asm volatile("s_waitcnt vmcnt(0)" ::: "memory");
        } else {
            XB_SPIN(xb_ld(&bar[XB_XGEN(b.x)]) == gen, bar);
            __builtin_amdgcn_fence(__ATOMIC_ACQUIRE, "agent");
            asm volatile("s_waitcnt vmcnt(0)" ::: "memory");
        }
    }
    __syncthreads();
}

#define LDS_WAIT() asm volatile("s_waitcnt lgkmcnt(0)" ::: "memory")
__device__ __forceinline__ unsigned cvtpk(float lo, float hi) { unsigned r; asm volatile("v_cvt_pk_bf16_f32 %0, %1, %2" : "=v"(r) : "v"(lo), "v"(hi)); return r; }
__device__ __forceinline__ float bf2f(bf16_t b) { return __uint_as_float(((unsigned)b) << 16); }
__device__ __forceinline__ float bflo(unsigned w) { return __uint_as_float(w << 16); }
__device__ __forceinline__ float bfhi(unsigned w) { return __uint_as_float(w & 0xffff0000u); }
__device__ __forceinline__ float wave_sum(float v) {
#pragma unroll
    for (int o = 1; o < 64; o <<= 1) v += __shfl_xor(v, o);
    return v;
}
__device__ __forceinline__ float silu_f(float v) { return v * __builtin_amdgcn_rcpf(1.0f + __expf(-v)); }
__device__ __forceinline__ float sigmoid_f(float v) { return __builtin_amdgcn_rcpf(1.0f + __expf(-v)); }
__device__ __forceinline__ float log_sigmoid_f(float v) { return v < 0.f ? v - log1pf(expf(v)) : -log1pf(expf(-v)); }

struct Args { const float* in[20]; float* out; unsigned char* ws; int ph_lo, ph_hi; int li, pad; };
enum { I_X = 0, I_C, I_CTX, I_CCTX, I_WMOD, I_BMOD, I_GMIX, I_GFFN, I_WQKV, I_SINK, I_WAO, I_WMI, I_BMI, I_GHEAD, I_WMO, I_WUP, I_CONVW, I_CONVB, I_WDN, I_GFINAL };

__device__ __forceinline__ void p0_transpose_item(const float* W, int K, int N, bf16_t* WT, LAS float* scr, int item, int lane, int mapkind) {
    const int nblk = (N + 63) / 64, kb = item / nblk, nb = item % nblk, k0 = 64 * kb, n0 = 64 * nb;
    f32x4 v[16];
    const int nn = (lane & 15) * 4; const bool nok = n0 + nn < N;
#pragma unroll
    for (int i = 0; i < 16; ++i) { const int kk = 4 * i + (lane >> 4); v[i] = nok ? __builtin_nontemporal_load((const f32x4*)(W + (size_t)(k0 + kk) * N + n0 + nn)) : (f32x4){0.f, 0.f, 0.f, 0.f}; }
#pragma unroll
    for (int i = 0; i < 16; ++i) { const int kk = 4 * i + (lane >> 4); LAS float* d = scr + kk * 65 + nn; d[0] = v[i][0]; d[1] = v[i][1]; d[2] = v[i][2]; d[3] = v[i][3]; }
    LDS_WAIT(); asm volatile("" ::: "memory");
    const int c = lane & 7;
#pragma unroll
    for (int j = 0; j < 8; ++j) { const int n = (lane >> 3) + 8 * j, nc = n0 + n;
        int row = nc;
        if (mapkind == 1) row = nc < DFF ? 256 * (nc / 128) + (nc % 128) : 256 * ((nc - DFF) / 128) + 128 + ((nc - DFF) % 128);
        if (mapkind == 2 && nc < 2560) { const int d0 = nc % 128; row = (nc - d0) + 2 * (d0 % 64) + d0 / 64; }
        const LAS float* s = scr + (8 * c) * 65 + n;
        u32x4 o; o.x = cvtpk(s[0 * 65], s[1 * 65]); o.y = cvtpk(s[2 * 65], s[3 * 65]); o.z = cvtpk(s[4 * 65], s[5 * 65]); o.w = cvtpk(s[6 * 65], s[7 * 65]);
        if (nc < N) *(u32x4*)(WT + (size_t)row * K + k0 + 8 * c) = o; }
    LDS_WAIT(); asm volatile("" ::: "memory");
}
__device__ __forceinline__ void get_mat(const Args& a, int m, const float*& W, bf16_t*& WT, int& K, int& N) {
    unsigned char* ws = a.ws;
    if (m < 2)       { K = DM;  N = NQKV;    W = a.in[I_WQKV] + (size_t)m * DM * NQKV;          WT = (bf16_t*)(ws + WS_WQKV) + (size_t)m * NQKV * DM; }
    else if (m < 4)  { K = DM;  N = DM;      W = a.in[I_WAO] + (size_t)(m - 2) * DM * DM;       WT = (bf16_t*)(ws + WS_WAO) + (size_t)(m - 2) * DM * DM; }
    else if (m < 6)  { K = DM;  N = NMI_RAW; W = a.in[I_WMI] + (size_t)(m - 4) * DM * NMI_RAW;  WT = (bf16_t*)(ws + WS_WMI) + (size_t)(m - 4) * NMI_PAD * DM; }
    else if (m < 8)  { K = DM;  N = DM;      W = a.in[I_WMO] + (size_t)(m - 6) * DM * DM;       WT = (bf16_t*)(ws + WS_WMO) + (size_t)(m - 6) * DM * DM; }
    else if (m < 12) { K = DM;  N = NUP;     W = a.in[I_WUP] + (size_t)(m - 8) * DM * NUP;      WT = (bf16_t*)(ws + WS_WUP) + (size_t)(m - 8) * NUP * DM; }
    else             { K = DFF; N = DM;      W = a.in[I_WDN] + (size_t)(m - 12) * DFF * DM;     WT = (bf16_t*)(ws + WS_WDN) + (size_t)(m - 12) * DM * DFF; }
}
constexpr int CW_BG = 2048;
__device__ __forceinline__ int bg_mat(int L, int q) {
    return q == 0 ? ((L & 1) ? 4 + (L >> 1) : (L >> 1)) : (q == 1 ? ((L & 1) ? 6 + (L >> 1) : 2 + (L >> 1)) : (q == 2 ? 8 + L : 12 + L));
}
__device__ __forceinline__ int bg_items(int m) { const int K = m >= 12 ? DFF : DM, N = m < 2 ? NQKV : (m < 4 ? DM : (m < 6 ? NMI_RAW : (m < 8 ? DM : (m < 12 ? NUP : DM)))); return (K / 64) * ((N + 63) / 64); }
__device__ __forceinline__ void bg_run(const Args& a, LAS unsigned char* lds, int L_lo, int L_hi, int max_claims, const unsigned* donectr, unsigned done_total, int tid, int lane, int wave) {
    unsigned* ctr = (unsigned*)(a.ws + WS_CTL) + CW_BG;
    LAS unsigned* slot = (LAS unsigned*)(lds + 8 * 17408);
    LAS float* scr = (LAS float*)(lds + wave * 17408);
    int claims = 0;
    for (int L = L_lo; L <= L_hi; ++L) {
        const int n0 = bg_items(bg_mat(L, 0)), n1 = n0 + bg_items(bg_mat(L, 1)), n2 = n1 + bg_items(bg_mat(L, 2)), total = n2 + bg_items(bg_mat(L, 3));
        for (;;) {
            if (claims >= max_claims) return;
            __syncthreads();
            if (tid == 0) { unsigned v = 0x7fffffffu;
                if (donectr == nullptr || __hip_atomic_load(donectr, __ATOMIC_RELAXED, __HIP_MEMORY_SCOPE_AGENT) < done_total) v = __hip_atomic_fetch_add(ctr + 64 * L, 8u, __ATOMIC_RELAXED, __HIP_MEMORY_SCOPE_AGENT);
                *slot = v; }
            __syncthreads();
            const int base = (int)*slot;
            if (base == 0x7fffffff) return;
            if (base >= total) break;
            ++claims;
            const int it = base + wave;
            if (it < total) {
                const int q = it < n0 ? 0 : (it < n1 ? 1 : (it < n2 ? 2 : 3)); const int m = bg_mat(L, q); const int loc = it - (q == 0 ? 0 : (q == 1 ? n0 : (q == 2 ? n1 : n2)));
                const float* W; bf16_t* WT; int K, N; get_mat(a, m, W, WT, K, N);
                p0_transpose_item(W, K, N, WT, scr, loc, lane, (m >= 8 && m < 12) ? 1 : (m < 2 ? 2 : 0));
            }
        }
    }
}
constexpr int CW_GATEQ = 3072;
__device__ __forceinline__ void gate_run(const Args& a, LAS unsigned char* lds, const bf16_t* Hm, const bf16_t* Wg, const float* bg, float* gates, int j, int tid, int lane, int wave) {
    unsigned* ctr = (unsigned*)(a.ws + WS_CTL) + CW_GATEQ + 64 * j;
    LAS unsigned* slot = (LAS unsigned*)(lds + 8 * 17408);
    const int r = lane & 31, h = lane >> 5;
    for (;;) {
        __syncthreads();
        if (tid == 0) *slot = __hip_atomic_fetch_add(ctr, 1u, __ATOMIC_RELAXED, __HIP_MEMORY_SCOPE_AGENT);
        __syncthreads();
        const int pm = (int)*slot;
        if (pm >= MT / 256) break;
        const int row0 = pm * 256 + 32 * wave;
        const bf16_t* ap = Hm + (size_t)(row0 + r) * DM + 8 * h; const bf16_t* bp = Wg + (size_t)r * DM + 8 * h;
        f32x16 acc;
#pragma unroll
        for (int i = 0; i < 16; ++i) acc[i] = 0.f;
        for (int k8 = 0; k8 < DM / 16; k8 += 8) {
            bf16x8 av[8], bv[8];
#pragma unroll
            for (int u = 0; u < 8; ++u) { av[u] = *(const bf16x8*)(ap + 16 * (k8 + u)); bv[u] = *(const bf16x8*)(bp + 16 * (k8 + u)); }
#pragma unroll
            for (int u = 0; u < 8; ++u) acc = __builtin_amdgcn_mfma_f32_32x32x16_bf16(av[u], bv[u], acc, 0, 0, 0);
        }
        const float bias = bg[r]; const bool ls = (r & 8) != 0;
#pragma unroll
        for (int i = 0; i < 16; ++i) { const int row = row0 + (i & 3) + 8 * (i >> 2) + 4 * h; float v = acc[i] + bias; if (ls) v = log_sigmoid_f(v); gates[(size_t)row * 32 + r] = v; }
    }
}
__device__ __forceinline__ void phase_prologue(const Args& a, LAS unsigned char* lds, int tid, int lane, int wave) {
    const int gw = blockIdx.x * NWAVES + wave, NGW = gridDim.x * NWAVES;
    LAS float* scr = (LAS float*)(lds + wave * 17408);
    for (int rpa = 0; rpa < (((DUP_MASK) >> 9) & 1) + 1; ++rpa)
    for (int q = 0; q < 4; ++q) {
        const int m = bg_mat(0, q);
        const float* W; bf16_t* WT; int K, N; get_mat(a, m, W, WT, K, N);
        const int nitems = (K / 64) * ((N + 63) / 64);
        for (int it = gw; it < nitems; it += NGW) p0_transpose_item(W, K, N, WT, scr, it, lane, (m >= 8 && m < 12) ? 1 : (m < 2 ? 2 : 0));
    }
    {
        const size_t per = (size_t)(NMI_PAD - NMI_RAW) * DM / 8;
        const size_t gt = (size_t)blockIdx.x * NTHREADS + tid, GT = (size_t)gridDim.x * NTHREADS;
        for (size_t e = gt; e < 2 * per; e += GT) { const size_t j = e / per, o = e % per;
            *(u32x4*)((bf16_t*)(a.ws + WS_WMI) + j * NMI_PAD * DM + (size_t)NMI_RAW * DM + o * 8) = (u32x4){0u, 0u, 0u, 0u}; }
        float* rc = (float*)(a.ws + WS_ROPE); float* rs = (float*)(a.ws + WS_ROPE + 1 * MiB);
        for (size_t e = gt; e < (size_t)SEQ * 64; e += GT) { const int t = (int)(e >> 6), jj = (int)(e & 63), fi = jj & 31;
            const float inv = __builtin_amdgcn_exp2f(-(float)fi * (13.287712379549449f / 32.0f)); const float pos = (float)(jj < 32 ? (t >> 6) : (t & 63)); const float rev = pos * inv * 0.15915494309189535f;
            rc[e] = __builtin_amdgcn_cosf(rev); rs[e] = __builtin_amdgcn_sinf(rev); }
    }
    __syncthreads();
    for (int rpd = 0; rpd < (((DUP_MASK) >> 10) & 1) + 1; ++rpd)
    for (int bt = blockIdx.x; bt < 192; bt += gridDim.x) {
        LAS float* sc = (LAS float*)lds;
#pragma unroll
        for (int u = 0; u < 9; ++u) { const int e = 4 * (tid + NTHREADS * u);
            const f32x4 v = u < 8 ? *(const f32x4*)(a.in[I_C] + e) : *(const f32x4*)(a.in[I_CCTX] + (e - 8 * DM));
            *(LAS f32x4*)(sc + e) = (f32x4){v[0] / (1.0f + __expf(-v[0])), v[1] / (1.0f + __expf(-v[1])), v[2] / (1.0f + __expf(-v[2])), v[3] / (1.0f + __expf(-v[3]))}; }
        __syncthreads();
        const int i = bt / 48, n0 = (bt % 48) * 256 + wave * 32 + (lane & 7) * 4, kp = lane >> 3;
        float acc[9][4];
#pragma unroll
        for (int r = 0; r < 9; ++r) { acc[r][0] = 0.f; acc[r][1] = 0.f; acc[r][2] = 0.f; acc[r][3] = 0.f; }
        const float* wp = a.in[I_WMOD] + (size_t)i * DM * MODW + n0;
#pragma unroll 8
        for (int k = kp; k < DM; k += 8) {
            const f32x4 w = __builtin_nontemporal_load((const f32x4*)(wp + (size_t)k * MODW));
#pragma unroll
            for (int r = 0; r < 9; ++r) { const float s = sc[r * DM + k]; acc[r][0] = fmaf(s, w[0], acc[r][0]); acc[r][1] = fmaf(s, w[1], acc[r][1]); acc[r][2] = fmaf(s, w[2], acc[r][2]); acc[r][3] = fmaf(s, w[3], acc[r][3]); }
        }
#pragma unroll
        for (int r = 0; r < 9; ++r)
#pragma unroll
            for (int j = 0; j < 4; ++j) { float v = acc[r][j]; v += __shfl_xor(v, 8); v += __shfl_xor(v, 16); v += __shfl_xor(v, 32); acc[r][j] = v; }
        if (kp == 0) {
            const f32x4 bv = *(const f32x4*)(a.in[I_BMOD] + (size_t)i * MODW + n0);
            float* mo = (float*)(a.ws + WS_MOD) + (size_t)i * 9 * MODW + n0;
#pragma unroll
            for (int r = 0; r < 9; ++r) *(f32x4*)(mo + (size_t)r * MODW) = (f32x4){acc[r][0] + bv[0], acc[r][1] + bv[1], acc[r][2] + bv[2], acc[r][3] + bv[3]};
        }
        __syncthreads();
    }
}

__device__ __forceinline__ void norm_row(int r, const void* xs, bool xs_f32, const void* cs, bool cs_f32, const float* g, const float* modl, int sh_off, int sc_off, bf16_t* H, const float* part, bf16_t* xout, int lane) {
    const bool f32src = r < MX ? xs_f32 : cs_f32; const void* src = r < MX ? xs : cs;
    const int mr = r < MX ? (r >> 12) : 8;
    f32x4 v[8]; float ss = 0.f;
    if (f32src) { const float* xr = (const float*)src + (size_t)r * DM;
#pragma unroll
        for (int j = 0; j < 4; ++j) { v[2 * j] = *(const f32x4*)(xr + 8 * lane + 512 * j); v[2 * j + 1] = *(const f32x4*)(xr + 8 * lane + 512 * j + 4); }
    } else { const bf16_t* xr = (const bf16_t*)src + (size_t)r * DM;
#pragma unroll
        for (int j = 0; j < 4; ++j) { const u32x4 b = *(const u32x4*)(xr + 8 * lane + 512 * j);
            v[2 * j] = (f32x4){bflo(b.x), bfhi(b.x), bflo(b.y), bfhi(b.y)}; v[2 * j + 1] = (f32x4){bflo(b.z), bfhi(b.z), bflo(b.w), bfhi(b.w)}; } }
    if (part != nullptr && r >= MX) {
#pragma unroll
        for (int q = 0; q < 4; ++q) { const bf16_t* pr = (const bf16_t*)part + ((size_t)q * MC + (r - MX)) * DM;
#pragma unroll
            for (int j = 0; j < 4; ++j) { const u32x4 pb = *(const u32x4*)(pr + 8 * lane + 512 * j);
                v[2 * j] += (f32x4){bflo(pb.x), bfhi(pb.x), bflo(pb.y), bfhi(pb.y)}; v[2 * j + 1] += (f32x4){bflo(pb.z), bfhi(pb.z), bflo(pb.w), bfhi(pb.w)}; } }
#pragma unroll
        for (int j = 0; j < 4; ++j) { u32x4 w; w.x = cvtpk(v[2 * j][0], v[2 * j][1]); w.y = cvtpk(v[2 * j][2], v[2 * j][3]); w.z = cvtpk(v[2 * j + 1][0], v[2 * j + 1][1]); w.w = cvtpk(v[2 * j + 1][2], v[2 * j + 1][3]);
            *(u32x4*)(xout + (size_t)r * DM + 8 * lane + 512 * j) = w;
            v[2 * j] = (f32x4){bflo(w.x), bfhi(w.x), bflo(w.y), bfhi(w.y)}; v[2 * j + 1] = (f32x4){bflo(w.z), bfhi(w.z), bflo(w.w), bfhi(w.w)}; }
    }
#pragma unroll
    for (int j = 0; j < 8; ++j) ss += (v[j][0] * v[j][0] + v[j][1] * v[j][1]) + (v[j][2] * v[j][2] + v[j][3] * v[j][3]);
    ss = wave_sum(ss);
    const float rs = 1.0f / sqrtf(ss * (1.0f / DM) + RMS_EPS);
    const float* mrow = modl + (size_t)mr * MODW;
#pragma unroll
    for (int j = 0; j < 4; ++j) { const int col = 8 * lane + 512 * j;
        unsigned o[4];
#pragma unroll
        for (int q = 0; q < 2; ++q) { const f32x4 gg = *(const f32x4*)(g + col + 4 * q), scv = *(const f32x4*)(mrow + sc_off + col + 4 * q), shv = *(const f32x4*)(mrow + sh_off + col + 4 * q);
            float hh[4];
#pragma unroll
            for (int e = 0; e < 4; ++e) hh[e] = (v[2 * j + q][e] * rs * gg[e]) * (1.0f + scv[e]) + shv[e];
            o[2 * q] = cvtpk(hh[0], hh[1]); o[2 * q + 1] = cvtpk(hh[2], hh[3]); }
        *(u32x4*)(H + (size_t)r * DM + col) = (u32x4){o[0], o[1], o[2], o[3]}; }
}
__device__ __forceinline__ void phase_norm(const void* xs, bool xs_f32, const void* cs, bool cs_f32, const float* g, const float* modl, int sh_off, int sc_off, bf16_t* H, int row_end, const float* part, bf16_t* xout, int lane, int wave) {
    const int gw = blockIdx.x * NWAVES + wave, NGW = gridDim.x * NWAVES;
    if (NGW != 2048) { for (int r = gw; r < row_end; r += NGW) norm_row(r, xs, xs_f32, cs, cs_f32, g, modl, sh_off, sc_off, H, part, xout, lane); return; }
    const int b = gw & 7, w8 = gw >> 3;
    f32x4 gs[8], sh[8];
    { const float* mrow = modl + (size_t)b * MODW;
#pragma unroll
      for (int j = 0; j < 4; ++j)
#pragma unroll
        for (int q = 0; q < 2; ++q) { const int col = 8 * lane + 512 * j + 4 * q; const f32x4 gg = *(const f32x4*)(g + col), scv = *(const f32x4*)(mrow + sc_off + col);
            gs[2 * j + q] = gg * (scv + 1.0f); sh[2 * j + q] = *(const f32x4*)(mrow + sh_off + col); } }
    if (MX + gw < row_end) norm_row(MX + gw, xs, xs_f32, cs, cs_f32, g, modl, sh_off, sc_off, H, part, xout, lane);
    for (int k = 14; k >= 0; k -= 2) {
        const int r = b * SEQ + w8 + 256 * k, r2 = r + 256;
        f32x4 va[8], vb[8]; float sa = 0.f, sb = 0.f;
        if (xs_f32) { const float* xa = (const float*)xs + (size_t)r * DM; const float* xb = (const float*)xs + (size_t)r2 * DM;
#pragma unroll
            for (int j = 0; j < 4; ++j) { va[2 * j] = *(const f32x4*)(xa + 8 * lane + 512 * j); va[2 * j + 1] = *(const f32x4*)(xa + 8 * lane + 512 * j + 4);
                vb[2 * j] = *(const f32x4*)(xb + 8 * lane + 512 * j); vb[2 * j + 1] = *(const f32x4*)(xb + 8 * lane + 512 * j + 4); }
        } else { const bf16_t* xa = (const bf16_t*)xs + (size_t)r * DM; const bf16_t* xb = (const bf16_t*)xs + (size_t)r2 * DM;
            u32x4 ba[4], bb[4];
#pragma unroll
            for (int j = 0; j < 4; ++j) { ba[j] = *(const u32x4*)(xa + 8 * lane + 512 * j); bb[j] = *(const u32x4*)(xb + 8 * lane + 512 * j); }
#pragma unroll
            for (int j = 0; j < 4; ++j) { va[2 * j] = (f32x4){bflo(ba[j].x), bfhi(ba[j].x), bflo(ba[j].y), bfhi(ba[j].y)}; va[2 * j + 1] = (f32x4){bflo(ba[j].z), bfhi(ba[j].z), bflo(ba[j].w), bfhi(ba[j].w)};
                vb[2 * j] = (f32x4){bflo(bb[j].x), bfhi(bb[j].x), bflo(bb[j].y), bfhi(bb[j].y)}; vb[2 * j + 1] = (f32x4){bflo(bb[j].z), bfhi(bb[j].z), bflo(bb[j].w), bfhi(bb[j].w)}; } }
#pragma unroll
        for (int j = 0; j < 8; ++j) { sa += (va[j][0] * va[j][0] + va[j][1] * va[j][1]) + (va[j][2] * va[j][2] + va[j][3] * va[j][3]); sb += (vb[j][0] * vb[j][0] + vb[j][1] * vb[j][1]) + (vb[j][2] * vb[j][2] + vb[j][3] * vb[j][3]); }
#pragma unroll
        for (int o = 1; o < 64; o <<= 1) { sa += __shfl_xor(sa, o); sb += __shfl_xor(sb, o); }
        const float ra = 1.0f / sqrtf(sa * (1.0f / DM) + RMS_EPS), rb = 1.0f / sqrtf(sb * (1.0f / DM) + RMS_EPS);
#pragma unroll
        for (int j = 0; j < 4; ++j) { const int col = 8 * lane + 512 * j;
            const f32x4 a0 = va[2 * j] * ra * gs[2 * j] + sh[2 * j], a1 = va[2 * j + 1] * ra * gs[2 * j + 1] + sh[2 * j + 1];
            const f32x4 b0 = vb[2 * j] * rb * gs[2 * j] + sh[2 * j], b1 = vb[2 * j + 1] * rb * gs[2 * j + 1] + sh[2 * j + 1];
            *(u32x4*)(H + (size_t)r * DM + col) = (u32x4){cvtpk(a0[0], a0[1]), cvtpk(a0[2], a0[3]), cvtpk(a1[0], a1[1]), cvtpk(a1[2], a1[3])};
            *(u32x4*)(H + (size_t)r2 * DM + col) = (u32x4){cvtpk(b0[0], b0[1]), cvtpk(b0[2], b0[3]), cvtpk(b1[0], b1[1]), cvtpk(b1[2], b1[3])}; }
    }
}
__device__ __forceinline__ void phase_final(const bf16_t* X, const float* g, float* out, int lane, int wave) {
    const int gw = blockIdx.x * NWAVES + wave, NGW = gridDim.x * NWAVES;
    f32x4 gg[8];
#pragma unroll
    for (int j = 0; j < 4; ++j) { gg[2 * j] = *(const f32x4*)(g + 8 * lane + 512 * j); gg[2 * j + 1] = *(const f32x4*)(g + 8 * lane + 512 * j + 4); }
    const bool fast = NGW == 2048; const int b = gw & 7, w8 = gw >> 3;
    const int n_it = fast ? 8 : (gw < MX ? (MX - gw + 2 * NGW - 1) / (2 * NGW) : 0);
    for (int it = 0; it < n_it; ++it) {
        int r, r2;
        if (fast) { r = b * SEQ + w8 + 256 * (15 - 2 * it); r2 = r - 256; }
        else { r = gw + 2 * NGW * it; r2 = (r + NGW < MX) ? r + NGW : r; }
        u32x4 ba[4], bb[4];
#pragma unroll
        for (int j = 0; j < 4; ++j) { ba[j] = *(const u32x4*)(X + (size_t)r * DM + 8 * lane + 512 * j); bb[j] = *(const u32x4*)(X + (size_t)r2 * DM + 8 * lane + 512 * j); }
        f32x4 va[8], vb[8]; float sa = 0.f, sb = 0.f;
#pragma unroll
        for (int j = 0; j < 4; ++j) { va[2 * j] = (f32x4){bflo(ba[j].x), bfhi(ba[j].x), bflo(ba[j].y), bfhi(ba[j].y)}; va[2 * j + 1] = (f32x4){bflo(ba[j].z), bfhi(ba[j].z), bflo(ba[j].w), bfhi(ba[j].w)};
            vb[2 * j] = (f32x4){bflo(bb[j].x), bfhi(bb[j].x), bflo(bb[j].y), bfhi(bb[j].y)}; vb[2 * j + 1] = (f32x4){bflo(bb[j].z), bfhi(bb[j].z), bflo(bb[j].w), bfhi(bb[j].w)}; }
#pragma unroll
        for (int j = 0; j < 8; ++j) { sa += (va[j][0] * va[j][0] + va[j][1] * va[j][1]) + (va[j][2] * va[j][2] + va[j][3] * va[j][3]); sb += (vb[j][0] * vb[j][0] + vb[j][1] * vb[j][1]) + (vb[j][2] * vb[j][2] + vb[j][3] * vb[j][3]); }
#pragma unroll
        for (int o = 1; o < 64; o <<= 1) { sa += __shfl_xor(sa, o); sb += __shfl_xor(sb, o); }
        const float ra = 1.0f / sqrtf(sa * (1.0f / DM) + RMS_EPS), rb = 1.0f / sqrtf(sb * (1.0f / DM) + RMS_EPS);
#pragma unroll
        for (int j = 0; j < 4; ++j) { const int col = 8 * lane + 512 * j;
            *(f32x4*)(out + (size_t)r * DM + col) = va[2 * j] * ra * gg[2 * j]; *(f32x4*)(out + (size_t)r * DM + col + 4) = va[2 * j + 1] * ra * gg[2 * j + 1];
            *(f32x4*)(out + (size_t)r2 * DM + col) = vb[2 * j] * rb * gg[2 * j]; *(f32x4*)(out + (size_t)r2 * DM + col + 4) = vb[2 * j + 1] * rb * gg[2 * j + 1]; }
    }
}

struct RangeOrder {
    pg8::StaticOrder b; int pm0; unsigned* donectr;
    __device__ void init(int pm_lo, int pm_hi, int N, int G, int c) { b.init((pm_hi - pm_lo) * 256, N, G, c); pm0 = pm_lo; donectr = nullptr; }
    __device__ __forceinline__ bool next(int i, pg8::Unit& u) const { if (!b.next(i, u)) return false; u.pm += pm0; return true; }
    __device__ __forceinline__ void a_ready(const pg8::Unit&) const {}
    __device__ __forceinline__ void done(const pg8::Unit&) const { if (donectr != nullptr && threadIdx.x == 0) (void)__hip_atomic_fetch_add(donectr, 1u, __ATOMIC_RELAXED, __HIP_MEMORY_SCOPE_AGENT); }
};
struct EpiRes {
    static constexpr bool PERM = true, AFTER_DRAIN = false;
    const float* b32; const bf16_t* b16; bf16_t* out; const float* gate;
    __device__ __forceinline__ void operator()(const pg8::f32x4 (&acc)[2][2][4][2], const pg8::Unit& u, int wr, int wc, int fr, int fq) const {
        const int row0 = u.pm * 256 + wr * 64 + fr, col0 = u.pn * 256 + wc * 32 + 8 * fq;
        const int mr = u.pm < (MX / 256) ? (u.pm >> 4) : 8;
        const float* gp = gate + (size_t)mr * MODW + col0;
        f32x4 gv[2][2];
#pragma unroll
        for (int bj = 0; bj < 2; ++bj)
#pragma unroll
            for (int n = 0; n < 2; ++n) gv[bj][n] = *(const f32x4*)(gp + bj * 128 + n * 4);
        if (b16 != nullptr) {
#pragma unroll
            for (int ai = 0; ai < 2; ++ai) {
                u32x4 bs[4][2];
#pragma unroll
                for (int m = 0; m < 4; ++m)
#pragma unroll
                    for (int bj = 0; bj < 2; ++bj) bs[m][bj] = *(const u32x4*)(b16 + (size_t)(row0 + ai * 128 + m * 16) * DM + col0 + bj * 128);
#pragma unroll
                for (int m = 0; m < 4; ++m)
#pragma unroll
                    for (int bj = 0; bj < 2; ++bj) { const u32x4 b = bs[m][bj]; const f32x4 a0 = acc[ai][bj][m][0] * gv[bj][0], a1 = acc[ai][bj][m][1] * gv[bj][1];
                        u32x4 w; w.x = cvtpk(bflo(b.x) + a0[0], bfhi(b.x) + a0[1]); w.y = cvtpk(bflo(b.y) + a0[2], bfhi(b.y) + a0[3]);
                        w.z = cvtpk(bflo(b.z) + a1[0], bfhi(b.z) + a1[1]); w.w = cvtpk(bflo(b.w) + a1[2], bfhi(b.w) + a1[3]);
                        *(u32x4*)(out + (size_t)(row0 + ai * 128 + m * 16) * DM + col0 + bj * 128) = w; }
                asm volatile("" ::: "memory"); }
        } else {
#pragma unroll
            for (int am = 0; am < 4; ++am) {
                const int ai = am >> 1;
                f32x4 bs[2][2][2];
#pragma unroll
                for (int m2 = 0; m2 < 2; ++m2) { const size_t off = (size_t)(row0 + ai * 128 + ((am & 1) * 2 + m2) * 16) * DM + col0;
#pragma unroll
                    for (int bj = 0; bj < 2; ++bj)
#pragma unroll
                        for (int n = 0; n < 2; ++n) bs[m2][bj][n] = *(const f32x4*)(b32 + off + bj * 128 + n * 4); }
#pragma unroll
                for (int m2 = 0; m2 < 2; ++m2) { const int m = (am & 1) * 2 + m2; const size_t off = (size_t)(row0 + ai * 128 + m * 16) * DM + col0;
#pragma unroll
                    for (int bj = 0; bj < 2; ++bj) { const f32x4 o0 = bs[m2][bj][0] + gv[bj][0] * acc[ai][bj][m][0], o1 = bs[m2][bj][1] + gv[bj][1] * acc[ai][bj][m][1];
                        u32x4 w; w.x = cvtpk(o0[0], o0[1]); w.y = cvtpk(o0[2], o0[3]); w.z = cvtpk(o1[0], o1[1]); w.w = cvtpk(o1[2], o1[3]);
                        *(u32x4*)(out + off + bj * 128) = w; } }
                asm volatile("" ::: "memory"); }
        }
    }
};
struct SplitOrder {
    int nN, kq, G, c;
    __device__ void init(int N, int K, int G_, int c_) { nN = N / 256; kq = K / 4; G = G_; c = c_; }
    __device__ __forceinline__ bool next(int i, pg8::Unit& u) const { const int L = i * G + c; if (L >= 8 * nN * 4) return false;
        const int t = L >> 2; u.k0 = (L & 3) * kq; u.pm = MX / 256 + (t & 7); u.pn = t >> 3; return true; }
    __device__ __forceinline__ void a_ready(const pg8::Unit&) const {}
    __device__ __forceinline__ void done(const pg8::Unit&) const {}
};
struct EpiPart {
    static constexpr bool PERM = false, AFTER_DRAIN = false;
    float* part; const float* gate; int kq;
    __device__ __forceinline__ void operator()(const pg8::f32x4 (&acc)[2][2][4][2], const pg8::Unit& u, int wr, int wc, int fr, int fq) const {
        const int row0 = (u.pm - MX / 256) * 256 + wr * 64 + fr, col0 = u.pn * 256 + wc * 32 + 4 * fq;
        const float* gp = gate + (size_t)8 * MODW + col0;
        bf16_t* pq = (bf16_t*)part + (size_t)(u.k0 / kq) * MC * DM;
        f32x4 gv[2][2];
#pragma unroll
        for (int bj = 0; bj < 2; ++bj)
#pragma unroll
            for (int n = 0; n < 2; ++n) gv[bj][n] = *(const f32x4*)(gp + bj * 128 + n * 16);
#pragma unroll
        for (int ai = 0; ai < 2; ++ai)
#pragma unroll
            for (int m = 0; m < 4; ++m) { bf16_t* rowp = pq + (size_t)(row0 + ai * 128 + m * 16) * DM + col0;
#pragma unroll
                for (int bj = 0; bj < 2; ++bj)
#pragma unroll
                    for (int n = 0; n < 2; ++n) { const f32x4 pv = gv[bj][n] * acc[ai][bj][m][n]; *(u32x2*)(rowp + bj * 128 + n * 16) = (u32x2){cvtpk(pv[0], pv[1]), cvtpk(pv[2], pv[3])}; } }
    }
};
struct EpiBf {
    static constexpr bool PERM = true, AFTER_DRAIN = false;
    bf16_t* O; int ldc;
    __device__ __forceinline__ void operator()(const pg8::f32x4 (&acc)[2][2][4][2], const pg8::Unit& u, int wr, int wc, int fr, int fq) const {
        const int row0 = u.pm * 256 + wr * 64 + fr, col0 = u.pn * 256 + wc * 32 + 8 * fq;
#pragma unroll
        for (int ai = 0; ai < 2; ++ai)
#pragma unroll
            for (int m = 0; m < 4; ++m) { bf16_t* rowp = O + (size_t)(row0 + ai * 128 + m * 16) * ldc + col0;
#pragma unroll
                for (int bj = 0; bj < 2; ++bj) { const f32x4 v0 = acc[ai][bj][m][0], v1 = acc[ai][bj][m][1];
                    u32x4 w; w.x = cvtpk(v0[0], v0[1]); w.y = cvtpk(v0[2], v0[3]); w.z = cvtpk(v1[0], v1[1]); w.w = cvtpk(v1[2], v1[3]);
                    *(u32x4*)(rowp + bj * 128) = w; } }
    }
};
#define DPPF(oldv, src, CTRL) __builtin_bit_cast(float, __builtin_amdgcn_update_dpp(__builtin_bit_cast(int, (float)(oldv)), __builtin_bit_cast(int, (float)(src)), (CTRL), 0xF, 0xF, false))
#define DPPM(src, CTRL) __builtin_bit_cast(float, __builtin_amdgcn_mov_dpp(__builtin_bit_cast(int, (float)(src)), (CTRL), 0xF, 0xF, true))
#define DPP_SHR1 0x111
#define DPP_SHL1 0x101
#define DPP_ROR1 0x121
#define DPP_ROR15 0x12F
__device__ __forceinline__ int xi_idx(int wrx, int aix, int edge, int bj, int n, int wc, int fq) { return ((((((wrx * 2 + aix) * 2 + edge) * 2 + bj) * 4 + wc) * 2 + n) * 4 + fq) * 4; }
struct EpiUpConv {
    static constexpr bool PERM = true, AFTER_DRAIN = false;
    bf16_t* G; float* EA; float* EB; const float* cw; const float* cb; LAS float* xl;
    __device__ __forceinline__ void operator()(const pg8::f32x4 (&acc)[2][2][4][2], const pg8::Unit& u, int wr, int wc, int fr, int fq) const {
        const int j0 = u.pn * 128 + wc * 32 + 8 * fq;
#define XI(wrx, aix, edge, bj, n) xi_idx((wrx), (aix), (edge), (bj), (n), wc, fq)
#pragma unroll
        for (int ai = 0; ai < 2; ++ai)
#pragma unroll
            for (int bj = 0; bj < 2; ++bj)
#pragma unroll
                for (int n = 0; n < 2; ++n) {
                    if (fr == 0) *(LAS f32x4*)(xl + XI(wr, ai, 0, bj, n)) = acc[ai][bj][0][n];
                    if (fr == 15) *(LAS f32x4*)(xl + XI(wr, ai, 1, bj, n)) = acc[ai][bj][3][n];
                }
        if (wr == 0 && fr < 2) {
#pragma unroll
            for (int bj = 0; bj < 2; ++bj)
#pragma unroll
                for (int n = 0; n < 2; ++n) *(f32x4*)((bj ? EB : EA) + ((size_t)u.pm * 4 + fr) * DFF + j0 + 4 * n) = acc[0][bj][0][n];
        }
        if (wr == 1 && fr >= 14) {
#pragma unroll
            for (int bj = 0; bj < 2; ++bj)
#pragma unroll
                for (int n = 0; n < 2; ++n) *(f32x4*)((bj ? EB : EA) + ((size_t)u.pm * 4 + 2 + (fr - 14)) * DFF + j0 + 4 * n) = acc[1][bj][3][n];
        }
        asm volatile("s_waitcnt lgkmcnt(0)" ::: "memory"); __builtin_amdgcn_s_barrier(); __builtin_amdgcn_s_barrier(); asm volatile("" ::: "memory");
        const int pwr = wr ^ 1;
        const unsigned long long m15 = __ballot(fr == 15), m00 = __ballot(fr == 0);
        u32x2 keep[2][4];
#pragma unroll
        for (int n = 0; n < 2; ++n) {
            const float* wp = cw + j0 + 4 * n; const float* bp = cb + j0 + 4 * n;
            const f32x4 wa0 = *(const f32x4*)wp, wa1 = *(const f32x4*)(wp + NUP), wa2 = *(const f32x4*)(wp + 2 * NUP), ba = *(const f32x4*)bp;
            const f32x4 wb0 = *(const f32x4*)(wp + DFF), wb1 = *(const f32x4*)(wp + NUP + DFF), wb2 = *(const f32x4*)(wp + 2 * NUP + DFF), bb = *(const f32x4*)(bp + DFF);
#pragma unroll
            for (int ai = 0; ai < 2; ++ai) {
                const int pai = (wr == 1) ? ai : ai - 1, nai = (wr == 0) ? ai : ai + 1;
                const bool hasp = !(wr == 0 && ai == 0), hasn = !(wr == 1 && ai == 1);
                f32x4 pa = {0.f, 0.f, 0.f, 0.f}, pb = pa, na = pa, nb = pa;
                if (hasp) { pa = *(const LAS f32x4*)(xl + XI(pwr, pai, 1, 0, n)); pb = *(const LAS f32x4*)(xl + XI(pwr, pai, 1, 1, n)); }
                if (hasn) { na = *(const LAS f32x4*)(xl + XI(pwr, nai, 0, 0, n)); nb = *(const LAS f32x4*)(xl + XI(pwr, nai, 0, 1, n)); }
#pragma unroll
                for (int mm = 0; mm < 4; ++mm) {
                    f32x4 Av = wa1 * acc[ai][0][mm][n] + ba, Bv = wb1 * acc[ai][1][mm][n] + bb;
#pragma unroll
                    for (int e = 0; e < 4; ++e) {
                        const float ac = acc[ai][0][mm][n][e], bc = acc[ai][1][mm][n][e];
                        const float psa = (mm == 0) ? pa[e] : acc[ai][0][mm > 0 ? mm - 1 : 0][n][e], psb = (mm == 0) ? pb[e] : acc[ai][1][mm > 0 ? mm - 1 : 0][n][e];
                        const float nsa = (mm == 3) ? na[e] : acc[ai][0][mm < 3 ? mm + 1 : 3][n][e], nsb = (mm == 3) ? nb[e] : acc[ai][1][mm < 3 ? mm + 1 : 3][n][e];
                        float A = Av[e], B = Bv[e], t0, t1, t2, t3;
                        asm("v_cndmask_b32_e64 %2, %6, %7, %16\n\t"
                            "v_cndmask_b32_e64 %3, %6, %8, %17\n\t"
                            "v_cndmask_b32_e64 %4, %9, %10, %16\n\t"
                            "v_cndmask_b32_e64 %5, %9, %11, %17\n\t"
                            "v_fmac_f32_dpp %0, %2, %12 row_ror:1 row_mask:0xf bank_mask:0xf bound_ctrl:1\n\t"
                            "v_fmac_f32_dpp %0, %3, %13 row_ror:15 row_mask:0xf bank_mask:0xf bound_ctrl:1\n\t"
                            "v_fmac_f32_dpp %1, %4, %14 row_ror:1 row_mask:0xf bank_mask:0xf bound_ctrl:1\n\t"
                            "v_fmac_f32_dpp %1, %5, %15 row_ror:15 row_mask:0xf bank_mask:0xf bound_ctrl:1"
                            : "+v"(A), "+v"(B), "=&v"(t0), "=&v"(t1), "=&v"(t2), "=&v"(t3)
                            : "v"(ac), "v"(psa), "v"(nsa), "v"(bc), "v"(psb), "v"(nsb), "v"(wa0[e]), "v"(wa2[e]), "v"(wb0[e]), "v"(wb2[e]), "s"(m15), "s"(m00));
                        Av[e] = A; Bv[e] = B;
                    }
                    const f32x4 tv = Av * -1.44269504f;
                    f32x4 sv = {__builtin_amdgcn_exp2f(tv[0]), __builtin_amdgcn_exp2f(tv[1]), __builtin_amdgcn_exp2f(tv[2]), __builtin_amdgcn_exp2f(tv[3])};
                    sv = sv + 1.0f;
                    const f32x4 rv = {__builtin_amdgcn_rcpf(sv[0]), __builtin_amdgcn_rcpf(sv[1]), __builtin_amdgcn_rcpf(sv[2]), __builtin_amdgcn_rcpf(sv[3])};
                    const f32x4 g = (Av * Bv) * rv;
                    u32x2 w; w.x = cvtpk(g[0], g[1]); w.y = cvtpk(g[2], g[3]);
                    const int rt = ai * 128 + wr * 64 + mm * 16 + fr;
                    if (n == 0) keep[ai][mm] = w;
                    else if (rt != 0 && rt != 255) *(u32x4*)(G + (size_t)(u.pm * 256 + rt) * DFF + j0) = (u32x4){keep[ai][mm].x, keep[ai][mm].y, w.x, w.y};
                }
            }
        }
#undef XI
    }
};
__device__ __forceinline__ void phase_ffn_fix(bf16_t* G, const float* EA, const float* EB, const float* cw, const float* cb, int ntiles, int tid) {
    const int total = ntiles * 2 * (DFF / 4);
    for (int e = blockIdx.x * NTHREADS + tid; e < total; e += gridDim.x * NTHREADS) {
        const int j = (e % (DFF / 4)) * 4, which = (e / (DFF / 4)) & 1, pm = e / (2 * (DFF / 4));
        const int T = pm < MX / 256 ? SEQ : CTXL; const int t0 = pm < MX / 256 ? (pm * 256) & (SEQ - 1) : 0;
        const bool hasp = which == 0 ? (t0 != 0) : true, hasn = which == 0 ? true : (t0 + 256 != T);
        const size_t ip = which == 0 ? ((size_t)(pm - 1) * 4 + 3) : ((size_t)pm * 4 + 2), ic = (size_t)pm * 4 + (which == 0 ? 0 : 3), in_ = which == 0 ? ((size_t)pm * 4 + 1) : ((size_t)(pm + 1) * 4 + 0);
        const f32x4 z = {0.f, 0.f, 0.f, 0.f};
        const f32x4 ap = hasp ? *(const f32x4*)(EA + ip * DFF + j) : z, ac = *(const f32x4*)(EA + ic * DFF + j), an = hasn ? *(const f32x4*)(EA + in_ * DFF + j) : z;
        const f32x4 bp = hasp ? *(const f32x4*)(EB + ip * DFF + j) : z, bc = *(const f32x4*)(EB + ic * DFF + j), bn = hasn ? *(const f32x4*)(EB + in_ * DFF + j) : z;
        const f32x4 wa0 = *(const f32x4*)(cw + j), wa1 = *(const f32x4*)(cw + NUP + j), wa2 = *(const f32x4*)(cw + 2 * NUP + j), ba = *(const f32x4*)(cb + j);
        const f32x4 wb0 = *(const f32x4*)(cw + DFF + j), wb1 = *(const f32x4*)(cw + NUP + DFF + j), wb2 = *(const f32x4*)(cw + 2 * NUP + DFF + j), bb = *(const f32x4*)(cb + DFF + j);
        float g[4];
#pragma unroll
        for (int c = 0; c < 4; ++c) { const float A = fmaf(wa2[c], an[c], fmaf(wa1[c], ac[c], fmaf(wa0[c], ap[c], ba[c]))), B = fmaf(wb2[c], bn[c], fmaf(wb1[c], bc[c], fmaf(wb0[c], bp[c], bb[c]))); g[c] = silu_f(A) * B; }
        u32x2 w; w.x = cvtpk(g[0], g[1]); w.y = cvtpk(g[2], g[3]);
        *(u32x2*)(G + (size_t)(pm * 256 + (which == 0 ? 0 : 255)) * DFF + j) = w;
    }
}
struct EpiQKV {
    static constexpr bool PERM = true, AFTER_DRAIN = false;
    bf16_t* O; const float* rc; const float* rs;
    __device__ __forceinline__ void operator()(const pg8::f32x4 (&acc)[2][2][4][2], const pg8::Unit& u, int wr, int wc, int fr, int fq) const {
        const int row0 = u.pm * 256 + wr * 64 + fr, col0 = u.pn * 256 + wc * 32 + 8 * fq;
        const bool rope = (u.pm < MX / 256) && (u.pn < 10);
        const int jj0 = 16 * wc + 4 * fq;
#pragma unroll
        for (int ai = 0; ai < 2; ++ai)
#pragma unroll
            for (int m = 0; m < 4; ++m) { const int row = row0 + ai * 128 + m * 16; bf16_t* rowp = O + (size_t)row * NQKV + col0;
                f32x4 cv = {1.f, 1.f, 1.f, 1.f}, sv = {0.f, 0.f, 0.f, 0.f};
                if (rope) { const int t = row & (SEQ - 1); cv = *(const f32x4*)(rc + t * 64 + jj0); sv = *(const f32x4*)(rs + t * 64 + jj0); }
#pragma unroll
                for (int bj = 0; bj < 2; ++bj) { const f32x4 v0 = acc[ai][bj][m][0], v1 = acc[ai][bj][m][1];
                    u32x4 w;
                    w.x = cvtpk(v0[0] * cv[0] - v0[1] * sv[0], v0[1] * cv[0] + v0[0] * sv[0]);
                    w.y = cvtpk(v0[2] * cv[1] - v0[3] * sv[1], v0[3] * cv[1] + v0[2] * sv[1]);
                    w.z = cvtpk(v1[0] * cv[2] - v1[1] * sv[2], v1[1] * cv[2] + v1[0] * sv[2]);
                    w.w = cvtpk(v1[2] * cv[3] - v1[3] * sv[3], v1[3] * cv[3] + v1[2] * sv[3]);
                    *(u32x4*)(rowp + bj * 128) = w; } }
    }
};
struct EpiMI {
    static constexpr bool PERM = true, AFTER_DRAIN = false;
    bf16_t* Z; float* G; const float* bias;
    __device__ __forceinline__ void operator()(const pg8::f32x4 (&acc)[2][2][4][2], const pg8::Unit& u, int wr, int wc, int fr, int fq) const {
        const int row0 = u.pm * 256 + wr * 64 + fr;
        if (u.pn < 24) {
            const int col0 = u.pn * 256 + wc * 32 + 8 * fq;
            const float sc = (u.pn >= 4 && u.pn < 8) ? 0.08838834764831845f : 1.0f;
            f32x4 bv[2][2];
#pragma unroll
            for (int bj = 0; bj < 2; ++bj)
#pragma unroll
                for (int n = 0; n < 2; ++n) bv[bj][n] = *(const f32x4*)(bias + col0 + bj * 128 + 4 * n);
#pragma unroll
            for (int ai = 0; ai < 2; ++ai)
#pragma unroll
                for (int m = 0; m < 4; ++m) { bf16_t* rowp = Z + (size_t)(row0 + ai * 128 + m * 16) * NMI + col0;
#pragma unroll
                    for (int bj = 0; bj < 2; ++bj) { const f32x4 v0 = (acc[ai][bj][m][0] + bv[bj][0]) * sc, v1 = (acc[ai][bj][m][1] + bv[bj][1]) * sc;
                        u32x4 w; w.x = cvtpk(v0[0], v0[1]); w.y = cvtpk(v0[2], v0[3]); w.z = cvtpk(v1[0], v1[1]); w.w = cvtpk(v1[2], v1[3]);
                        *(u32x4*)(rowp + bj * 128) = w; } }
        } else if (wc == 0) {
            const f32x4 b0 = *(const f32x4*)(bias + NMI + 8 * fq), b1 = *(const f32x4*)(bias + NMI + 8 * fq + 4);
#pragma unroll
            for (int ai = 0; ai < 2; ++ai)
#pragma unroll
                for (int m = 0; m < 4; ++m) { float* gp = G + (size_t)(row0 + ai * 128 + m * 16) * 32 + 8 * fq;
                    f32x4 v0 = acc[ai][0][m][0] + b0, v1 = acc[ai][0][m][1] + b1;
                    if (fq & 1) {
#pragma unroll
                        for (int e = 0; e < 4; ++e) { v0[e] = log_sigmoid_f(v0[e]); v1[e] = log_sigmoid_f(v1[e]); } }
                    *(f32x4*)gp = v0; *(f32x4*)(gp + 4) = v1; }
        }
    }
};

namespace att {
constexpr int D = 128, KVBLK = 64, LDQ = NQKV;
constexpr float SCALE = 0.088388347648318440f;
constexpr float THR = 8.f;
#ifndef ATT_SDEPTH
#define ATT_SDEPTH 1
#endif
constexpr int SDEPTH = ATT_SDEPTH;
constexpr size_t SHM_V = KVBLK * D * 2, SHM_K = KVBLK * D * 2, SHM_ATTN = 2 * SHM_V + 2 * SHM_K + NWAVES * 64 * 4;
#define KSWZ(row, colB) ((row) * 256 + ((colB) ^ (((row) & 7) << 4)))
#define SBAR() __builtin_amdgcn_sched_barrier(0)
__device__ __forceinline__ int crow(int r, int hi) { return (r & 3) + 8 * (r >> 2) + 4 * hi; }
__device__ __forceinline__ void partialSM(f32x16& p0, f32x16& p1, float& m_reg, float& mn, float& alpha, bool masked, int dpos, int hi) {
  constexpr float C = SCALE * 1.4426950408889634f;
  if (masked) {
    const unsigned ub = (unsigned)(dpos + 4 * hi + 128);
#pragma unroll
    for (int r = 0; r < 16; ++r) { const unsigned kc = (unsigned)((r & 3) + 8 * (r >> 2));
      if (ub + kc > 256u) p0[r] = -1e30f;
      if (ub + kc + 32u > 256u) p1[r] = -1e30f; }
  }
  float pmax = p0[0];
#pragma unroll
  for (int r = 1; r < 16; ++r) pmax = fmaxf(pmax, p0[r]);
#pragma unroll
  for (int r = 0; r < 16; ++r) pmax = fmaxf(pmax, p1[r]);
  { auto rr = __builtin_amdgcn_permlane32_swap(__float_as_uint(pmax), __float_as_uint(pmax), false, false);
    pmax = fmaxf(__uint_as_float(rr[0]), __uint_as_float(rr[1])); }
  if (__builtin_expect(__all(pmax - m_reg <= THR / SCALE), 1)) { mn = m_reg; alpha = 1.f; }
  else { mn = fmaxf(m_reg, pmax); alpha = __builtin_amdgcn_exp2f((m_reg - mn) * C); m_reg = mn; }
  const float mnC = -mn * C;
#pragma unroll
  for (int r = 0; r < 16; ++r) p0[r] = fmaf(p0[r], C, mnC);
#pragma unroll
  for (int r = 0; r < 16; ++r) p1[r] = fmaf(p1[r], C, mnC);
#pragma unroll
  for (int r = 0; r < 16; ++r) p0[r] = __builtin_amdgcn_exp2f(p0[r]);
}
__device__ __forceinline__ void finishSM(f32x16& p0, f32x16& p1, float alpha, float& l_reg, bf16x8& pa0, bf16x8& pa1, bf16x8& pa2, bf16x8& pa3) {
#pragma unroll
  for (int r = 0; r < 16; ++r) p1[r] = __builtin_amdgcn_exp2f(p1[r]);
  float ps = 0;
#pragma unroll
  for (int r = 0; r < 16; ++r) ps += p0[r];
#pragma unroll
  for (int r = 0; r < 16; ++r) ps += p1[r];
  { auto rr = __builtin_amdgcn_permlane32_swap(__float_as_uint(ps), __float_as_uint(ps), false, false);
    ps = __uint_as_float(rr[0]) + __uint_as_float(rr[1]); }
  l_reg = l_reg * alpha + ps;
#define PK4(P, BASE, OUT) do { unsigned a0 = cvtpk(P[BASE + 0], P[BASE + 1]), a1 = cvtpk(P[BASE + 2], P[BASE + 3]);   \
    unsigned b0 = cvtpk(P[BASE + 4], P[BASE + 5]), b1 = cvtpk(P[BASE + 6], P[BASE + 7]);                              \
    auto r0 = __builtin_amdgcn_permlane32_swap(a0, b0, false, false); auto r1 = __builtin_amdgcn_permlane32_swap(a1, b1, false, false); \
    u32x4 w = {r0[0], r1[0], r0[1], r1[1]}; OUT = *reinterpret_cast<bf16x8*>(&w); } while (0)
  PK4(p0, 0, pa0); PK4(p0, 8, pa1); PK4(p1, 0, pa2); PK4(p1, 8, pa3);
#undef PK4
}
__device__ __forceinline__ void qkt(f32x16& p0, f32x16& p1, const char* Ks, const bf16x8* qr, int r32, int hi) {
  p0 = f32x16{}; p1 = f32x16{};
#pragma unroll
  for (int d0 = 0; d0 < 8; ++d0) { const int cb = (d0 * 16 + hi * 8) * 2;
    const bf16x8 b0 = *reinterpret_cast<const bf16x8*>(Ks + KSWZ(r32, cb));
    const bf16x8 b1 = *reinterpret_cast<const bf16x8*>(Ks + KSWZ(32 + r32, cb));
    p0 = __builtin_amdgcn_mfma_f32_32x32x16_bf16(b0, qr[d0], p0, 0, 0, 0);
    p1 = __builtin_amdgcn_mfma_f32_32x32x16_bf16(b1, qr[d0], p1, 0, 0, 0); }
}
__device__ __forceinline__ int v_st(int k, int c) { const int kk = (k & ~0xC) | ((k & 4) << 1) | ((k & 8) >> 1); return ((kk >> 3) * 4 + (c >> 5)) * 512 + ((kk & 7) * 32 + (c & 31)) * 2; }
__device__ __forceinline__ int v_rd_base(int lane) { return ((lane & 3) << 3) | (((lane >> 2) & 3) << 6) | (((lane >> 4) & 1) << 5) | (((lane >> 5) & 1) << 8); }
constexpr int v_rd_off(int d0, int ks, int half) { return d0 * 512 + ks * 4096 + half * 2048; }
template <int OFF> __device__ __forceinline__ s16x4 tr_read(int vb) {
  s16x4 r; asm volatile("ds_read_b64_tr_b16 %0, %1 offset:%2" : "=&v"(r) : "v"(vb), "i"(OFF) : "memory"); return r;
}
template <int D0> __device__ __forceinline__ void pv_one(f32x16& od, int vb, bf16x8 pa0, bf16x8 pa1, bf16x8 pa2, bf16x8 pa3) {
  const s16x4 l0 = tr_read<v_rd_off(D0, 0, 0)>(vb), h0 = tr_read<v_rd_off(D0, 0, 1)>(vb), l1 = tr_read<v_rd_off(D0, 1, 0)>(vb), h1 = tr_read<v_rd_off(D0, 1, 1)>(vb);
  const s16x4 l2 = tr_read<v_rd_off(D0, 2, 0)>(vb), h2 = tr_read<v_rd_off(D0, 2, 1)>(vb), l3 = tr_read<v_rd_off(D0, 3, 0)>(vb), h3 = tr_read<v_rd_off(D0, 3, 1)>(vb);
  asm volatile("s_waitcnt lgkmcnt(0)" ::: "memory"); SBAR();
#define PK(L, H) (bf16x8){L[0], L[1], L[2], L[3], H[0], H[1], H[2], H[3]}
  od = __builtin_amdgcn_mfma_f32_32x32x16_bf16(pa0, PK(l0, h0), od, 0, 0, 0);
  od = __builtin_amdgcn_mfma_f32_32x32x16_bf16(pa1, PK(l1, h1), od, 0, 0, 0);
  od = __builtin_amdgcn_mfma_f32_32x32x16_bf16(pa2, PK(l2, h2), od, 0, 0, 0);
  od = __builtin_amdgcn_mfma_f32_32x32x16_bf16(pa3, PK(l3, h3), od, 0, 0, 0);
#undef PK
}
__device__ __forceinline__ void pv_d0(f32x16* o, int vb, bf16x8 pa0, bf16x8 pa1, bf16x8 pa2, bf16x8 pa3) {
  pv_one<0>(o[0], vb, pa0, pa1, pa2, pa3); pv_one<1>(o[1], vb, pa0, pa1, pa2, pa3); pv_one<2>(o[2], vb, pa0, pa1, pa2, pa3); pv_one<3>(o[3], vb, pa0, pa1, pa2, pa3);
}

__device__ __forceinline__ void attn_unit(const bf16_t* __restrict__ Z, bf16_t* __restrict__ O, int qrow0, int head0, int kvh, int ctxrow0, int winrow0, int NT, int dq0, const float* __restrict__ sinkp, char* lds) {
  int tid_l = threadIdx.x; asm volatile("" : "+v"(tid_l));
  const int tid = tid_l, wid = tid >> 6, lane = tid & 63, r32 = lane & 31, hi = lane >> 5;
  char* V_lds = lds; char* K_lds = lds + 2 * SHM_V;
  float* wsl = (float*)(lds + 2 * SHM_V + 2 * SHM_K) + wid * 64; float* li_l = wsl; float* al_l = wsl + 32;
  float m_reg = -1e30f, l_reg = 0; f32x16 o[4] = {}; bf16x8 qr[8];
  const int head = head0 + (wid >> 2), qloc = (wid & 3) * 32 + r32;
  const bf16_t* Qw = Z + (size_t)(qrow0 + qloc) * LDQ + head * D + hi * 8;
#pragma unroll
  for (int d0 = 0; d0 < 8; ++d0) qr[d0] = *reinterpret_cast<const bf16x8*>(Qw + d0 * 16);
  const int sr = tid >> 4, sc = (tid & 15) * 8, vst0 = v_st(sr, sc), vst1 = v_st(32 + sr, sc);
  const int vb0 = (int)(uintptr_t)V_lds + v_rd_base(lane);
  const bf16_t* Kc = Z + 2048 + kvh * D + sc; const bf16_t* Vc = Z + 2560 + kvh * D + sc;
  const int dlane = dq0 - qloc;
  struct { bf16x8 vs0, vs1, ks0, ks1; } sr_[SDEPTH];
#define TROW(jt) ((jt) < 4 ? ctxrow0 + (jt) * 64 : winrow0 + ((jt) - 4) * 64)
#define SLOAD(i, jt) do { const size_t rb0_ = (size_t)(TROW(jt) + sr) * LDQ, rb1_ = rb0_ + (size_t)32 * LDQ; \
    sr_[i].vs0 = *reinterpret_cast<const bf16x8*>(Vc + rb0_); sr_[i].vs1 = *reinterpret_cast<const bf16x8*>(Vc + rb1_); \
    sr_[i].ks0 = *reinterpret_cast<const bf16x8*>(Kc + rb0_); sr_[i].ks1 = *reinterpret_cast<const bf16x8*>(Kc + rb1_); } while (0)
#define SWRITE(b, i) do { *(bf16x8*)(V_lds + (b) * SHM_V + vst0) = sr_[i].vs0;          \
    *(bf16x8*)(V_lds + (b) * SHM_V + vst1) = sr_[i].vs1; const int kc_ = sc * 2;               \
    *(bf16x8*)(K_lds + (b) * SHM_K + KSWZ(sr, kc_)) = sr_[i].ks0;                       \
    *(bf16x8*)(K_lds + (b) * SHM_K + KSWZ(32 + sr, kc_)) = sr_[i].ks1; } while (0)
#define SWAIT() do { if constexpr (SDEPTH == 2) asm volatile("s_waitcnt vmcnt(4)" ::: "memory"); else asm volatile("s_waitcnt vmcnt(0)" ::: "memory"); } while (0)
#define RESC(a) do { if (__any((a) < 1.f)) { if (hi == 0) al_l[r32] = (a); asm volatile("s_waitcnt lgkmcnt(0)" ::: "memory"); \
    _Pragma("unroll") for (int d = 0; d < 4; ++d) _Pragma("unroll") for (int r = 0; r < 16; ++r) o[d][r] *= al_l[crow(r, hi)]; } } while (0)
#define MSK(jt) ((jt) >= 4), (dlane + ((jt) - 4) * 64)
  f32x16 pA0, pA1, pB0, pB1; float mnA, mnB, alA, alB; bf16x8 pa0, pa1, pa2, pa3;
  constexpr int SE = 0, SO = SDEPTH - 1;
  SLOAD(SE, 0); asm volatile("s_waitcnt vmcnt(0)" ::: "memory"); SWRITE(0, SE); __syncthreads();
  qkt(pA0, pA1, K_lds, qr, r32, hi); partialSM(pA0, pA1, m_reg, mnA, alA, MSK(0), hi);
  SLOAD(SO, 1); if constexpr (SDEPTH == 2) { if (2 < NT) SLOAD(SE, 2); }
  SWAIT(); SWRITE(1, SO); __syncthreads();
  for (int j = 1; j + 1 < NT; j += 2) {
    SBAR(); qkt(pB0, pB1, K_lds + SHM_K, qr, r32, hi);
    finishSM(pA0, pA1, alA, l_reg, pa0, pa1, pa2, pa3); SBAR();
    SLOAD(SO, j + SDEPTH); SBAR();
    pv_d0(o, vb0, pa0, pa1, pa2, pa3); partialSM(pB0, pB1, m_reg, mnB, alB, MSK(j), hi);
    __syncthreads(); SWAIT(); SWRITE(0, SE);
    RESC(alB); __syncthreads();
    SBAR(); qkt(pA0, pA1, K_lds, qr, r32, hi);
    finishSM(pB0, pB1, alB, l_reg, pa0, pa1, pa2, pa3); SBAR();
    if (SDEPTH == 1 || j + 3 < NT) SLOAD(SE, j + 1 + SDEPTH);
    SBAR();
    pv_d0(o, vb0 + (int)SHM_V, pa0, pa1, pa2, pa3); partialSM(pA0, pA1, m_reg, mnA, alA, MSK(j + 1), hi);
    __syncthreads(); SWAIT(); SWRITE(1, SO);
    RESC(alA); __syncthreads();
  }
  SBAR(); qkt(pB0, pB1, K_lds + SHM_K, qr, r32, hi);
  finishSM(pA0, pA1, alA, l_reg, pa0, pa1, pa2, pa3); SBAR();
  pv_d0(o, vb0, pa0, pa1, pa2, pa3); partialSM(pB0, pB1, m_reg, mnB, alB, MSK(NT - 1), hi);
  __syncthreads(); RESC(alB);
  finishSM(pB0, pB1, alB, l_reg, pa0, pa1, pa2, pa3); SBAR();
  pv_d0(o, vb0 + (int)SHM_V, pa0, pa1, pa2, pa3);
  { constexpr float C = SCALE * 1.4426950408889634f; l_reg += __builtin_amdgcn_exp2f(sinkp[wid >> 2] * 1.4426950408889634f - m_reg * C); }
  if (hi == 0) li_l[r32] = l_reg; asm volatile("s_waitcnt lgkmcnt(0)" ::: "memory");
  float rli[16];
#pragma unroll
  for (int r = 0; r < 16; ++r) rli[r] = __builtin_amdgcn_rcpf(li_l[crow(r, hi)]);
  bf16_t* Ow = O + (size_t)(qrow0 + (wid & 3) * 32) * DM + head * D;
#pragma unroll
  for (int r = 0; r < 16; ++r) { const int orow = crow(r, hi);
#pragma unroll
    for (int d0 = 0; d0 < 4; ++d0) { const float v = o[d0][r] * rli[r]; Ow[(size_t)orow * DM + d0 * 32 + r32] = (bf16_t)(cvtpk(v, v) & 0xffffu); } }
#undef TROW
#undef SLOAD
#undef SWRITE
#undef SWAIT
#undef RESC
#undef MSK
}
}

__device__ __forceinline__ void phase_attn(const bf16_t* Z, bf16_t* O, const float* sink, char* lds) {
    constexpr int NU_X = 2048, NU = NU_X + 128;
    for (int u = blockIdx.x; u < NU; u += gridDim.x) {
        if (u < NU_X) {
            const int xw = u & 7, sw = (u >> 3) & 31, b = u >> 8;
            const int kvh = xw >> 1, qb = 16 * (xw & 1) + (sw >> 1), hp = sw & 1;
            const int lo = qb > 0 ? (qb - 1) * 128 : 0, hi = qb < 31 ? (qb + 2) * 128 : SEQ;
            att::attn_unit(Z, O, b * SEQ + qb * 128, kvh * 4 + hp * 2, kvh, MX + b * CTXL, b * SEQ + lo, 4 + (hi - lo) / 64, lo - qb * 128, sink + kvh * 4 + hp * 2, lds);
        } else {
            const int v = u - NU_X; const int hp = v & 1, cqb = (v >> 1) & 1, kvh = (v >> 2) & 3, b = v >> 4;
            att::attn_unit(Z, O, MX + b * CTXL + cqb * 128, kvh * 4 + hp * 2, kvh, MX + b * CTXL, 0, 4, 0, sink + kvh * 4 + hp * 2, lds);
        }
        __syncthreads();
    }
}

__device__ __forceinline__ int scan_row(int b, int dir, int s) {
    if (dir == 0) return s < CTXL ? MX + b * CTXL + s : b * SEQ + (s - CTXL);
    return s < CTXL ? MX + b * CTXL + (CTXL - 1 - s) : b * SEQ + (SEQ - 1 - (s - CTXL));
}
namespace ms {
typedef __bf16 bf16x8v __attribute__((ext_vector_type(8)));
typedef __bf16 bf16x4v __attribute__((ext_vector_type(4)));
constexpr int QOFF = 0, KOFF = 16384, VOFF = 32768, BUFB = 49152;
constexpr int NOFF = 2 * BUFB;
constexpr int WPOFF = NOFF + 1024;
constexpr int NCHUNK = (CTXL + SEQ) / 64;
__host__ __device__ __forceinline__ unsigned off_b(unsigned row, unsigned ch) { return 256u * row + 16u * (ch ^ (((row & 3) << 2) | ((row >> 2) & 3))); }
__host__ __device__ __forceinline__ unsigned tr_addr_nat(unsigned lane, unsigned c, unsigned ks, unsigned t) {
    const unsigned h = lane >> 5, blk = (lane >> 4) & 1, q = (lane & 15) >> 2, p = lane & 3;
    return off_b(16 * ks + 8 * h + 4 * t + q, 4 * c + 2 * blk + (p >> 1)) + 8 * (p & 1);
}
__host__ __device__ __forceinline__ unsigned tr_addr_perm(unsigned lane, unsigned c, unsigned ks, unsigned t) {
    const unsigned h = lane >> 5, blk = (lane >> 4) & 1, q = (lane & 15) >> 2, p = lane & 3;
    return off_b(16 * ks + 8 * t + 4 * h + q, 4 * c + 2 * blk + (p >> 1)) + 8 * (p & 1);
}
template <int OFF> __device__ __forceinline__ s16x4 trr(unsigned addr) { s16x4 r; asm volatile("ds_read_b64_tr_b16 %0, %1 offset:%2" : "=v"(r) : "v"(addr), "i"(OFF) : "memory"); return r; }
__host__ __device__ __forceinline__ unsigned xr16(unsigned r) { return ((r & 3) << 2) | ((r >> 2) & 3); }
#define MS_LWAIT() do { asm volatile("s_waitcnt lgkmcnt(0)" ::: "memory"); __builtin_amdgcn_sched_barrier(0); } while (0)
__device__ __forceinline__ int crow(int r, int hi) { return (r & 3) + 8 * (r >> 2) + 4 * hi; }
__device__ __forceinline__ bf16x8 pack8(const f32x16& x, int s) {
    const f32x8 v = {x[8 * s + 0], x[8 * s + 1], x[8 * s + 2], x[8 * s + 3], x[8 * s + 4], x[8 * s + 5], x[8 * s + 6], x[8 * s + 7]};
    return __builtin_bit_cast(bf16x8, __builtin_convertvector(v, bf16x8v));
}
__device__ __forceinline__ float scan_incl_add(float x, int lane) {
#pragma unroll
    for (int o = 1; o < 64; o <<= 1) { const float v = __shfl_up(x, o); if (lane >= o) x += v; }
    return x;
}
__device__ __forceinline__ float scan_incl_max(float x, int lane) {
#pragma unroll
    for (int o = 1; o < 64; o <<= 1) { const float v = __shfl_up(x, o); if (lane >= o) x = fmaxf(x, v); }
    return x;
}
}

__device__ __forceinline__ void phase_scan2(const bf16_t* Z, const float* GATE, bf16_t* HF, bf16_t* HB, bool need_ctx_out, LAS unsigned char* lds, int tid, int lane, int wave) {
    using namespace ms;
    const int cb = wave & 3, th = wave >> 2, r = lane & 31, h = lane >> 5;
    LAS float* wp = (LAS float*)(lds + WPOFF + wave * 2048);
    LAS float* colf_l = wp; LAS float* wg_l = wp + 64; LAS float* ein_l = wp + 128; LAS float* rden_l = wp + 192;
    for (int task = blockIdx.x; task < 256; task += gridDim.x) {
        const int dvh = task & 1, dir = (task >> 1) & 1, hd = (task >> 2) & 7, b = task >> 5;
        bf16_t* HO = dir == 0 ? HF : HB;
        const int ocol = hd * 256 + dvh * 128 + cb * 32 + r;
        const int d_rl = lane >> 4, d_ch = (lane & 15) ^ ((d_rl << 2) | (wave & 3));
        const int d_col0 = hd * 128 + d_ch * 8, d_col1 = 1024 + hd * 128 + d_ch * 8, d_col2 = 2048 + hd * 256 + dvh * 128 + d_ch * 8;
        float g_ig, g_lf;
#define MS_DMA(c_, buf_) do { _Pragma("unroll") for (int i_ = 0; i_ < 6; ++i_) { const int rg_ = 8 * (i_ & 1) + wave; const int row_ = scan_row(b, dir, (c_) * 64 + 4 * rg_ + d_rl); \
            const int col_ = (i_ >> 1) == 0 ? d_col0 : ((i_ >> 1) == 1 ? d_col1 : d_col2); \
            __builtin_amdgcn_global_load_lds((const unsigned*)(Z + (size_t)row_ * NMI + col_), (LAS unsigned*)(lds + (buf_) * BUFB + (i_ >> 1) * 16384 + 1024 * rg_), 16, 0, 0); } \
            { const int row_ = scan_row(b, dir, (c_) * 64 + lane); g_ig = GATE[(size_t)row_ * 32 + (dir * 2) * 8 + hd]; g_lf = GATE[(size_t)row_ * 32 + (dir * 2 + 1) * 8 + hd]; } } while (0)
        f32x16 C[4];
#pragma unroll
        for (int ti = 0; ti < 4; ++ti)
#pragma unroll
            for (int i = 0; i < 16; ++i) C[ti][i] = 0.f;
        float m_prev = 0.f;
        __syncthreads();
        MS_DMA(0, 0);
        if (tid < 128) ((LAS float*)(lds + NOFF))[tid] = 0.f;
        float c_ig = g_ig, c_lf = g_lf;
        asm volatile("s_waitcnt vmcnt(0)" ::: "memory");
        __syncthreads();
        for (int c = 0; c < NCHUNK; ++c) {
            const int cur = c & 1;
            int lane_l = lane; asm volatile("" : "+v"(lane_l));
            const unsigned ul = (unsigned)lane_l, uh = ul >> 5, ublk = (ul >> 4) & 1, uq = (ul & 15) >> 2, up = ul & 3, ur = ul & 31;
            const unsigned cbase = (unsigned)(cur * BUFB);
            const unsigned a_nat = cbase + 256u * (8u * uh + uq) + ((64u * uq) | (32u * (ublk ^ uh)) | (16u * (up >> 1))) + 8u * (up & 1);
            const unsigned a_perm = cbase + 256u * (4u * uh + uq) + ((64u * uq) | (32u * ublk) | (16u * ((up >> 1) ^ uh))) + 8u * (up & 1);
            const unsigned a_row = cbase + 256u * ur + ((16u * xr16(ur)) ^ (16u * uh));
            const unsigned a_q64 = cbase + 256u * ur + 16u * xr16(ur) + 8u * uh + 8192u * (unsigned)th;
            const unsigned a_qn = cbase + 256u * ur + ((16u * xr16(ur)) ^ (128u * uh)) + 8192u * (unsigned)th;
            const LAS float* ncur = (const LAS float*)(lds + NOFF + cur * 512); LAS float* nnxt = (LAS float*)(lds + NOFF + (cur ^ 1) * 512);
            if (c + 1 < NCHUNK) MS_DMA(c + 1, cur ^ 1);
            const float bsum = scan_incl_add(c_lf, lane);
            const float av = c_ig - bsum;
            const float pm = scan_incl_max(av, lane);
            const float mm = fmaxf(m_prev, pm);
            const float ein = __expf(m_prev - mm), eneg = __expf(-(bsum + mm));
            const float b_end = __shfl(bsum, 63), mm_end = __shfl(mm, 63);
            const float e_prev = __expf(m_prev - mm_end);
            colf_l[lane] = av; wg_l[lane] = __expf(av - mm_end); ein_l[lane] = ein;
            const float rowf_r = -__shfl(mm, 32 * th + r), ein_r = __shfl(ein, 32 * th + r), eneg_r = __shfl(eneg, 32 * th + r);
            m_prev = b_end + mm_end;
            f32x16 X0, X1;
#pragma unroll
            for (int i = 0; i < 16; ++i) { X0[i] = 0.f; X1[i] = 0.f; }
#pragma unroll
            for (int ks = 0; ks < 8; ++ks) {
                const unsigned ar = a_row ^ (32u * ks);
                const bf16x8 qf = *(const LAS bf16x8*)(lds + ar + QOFF + 8192 * th);
                const bf16x8 k0 = *(const LAS bf16x8*)(lds + ar + KOFF);
                X0 = __builtin_amdgcn_mfma_f32_32x32x16_bf16(k0, qf, X0, 0, 0, 0);
                if (th == 1) { const bf16x8 k1 = *(const LAS bf16x8*)(lds + ar + KOFF + 8192); X1 = __builtin_amdgcn_mfma_f32_32x32x16_bf16(k1, qf, X1, 0, 0, 0); }
            }
            float qn = 0.f;
#pragma unroll
            for (int cc = 0; cc < 8; ++cc) { const u32x4 qv = *(const LAS u32x4*)(lds + (a_qn ^ (16u * cc)) + QOFF);
                const f32x4 n0 = *(const LAS f32x4*)(ncur + 64 * h + 8 * cc), n1 = *(const LAS f32x4*)(ncur + 64 * h + 8 * cc + 4);
                qn += bflo(qv.x) * n0[0] + bfhi(qv.x) * n0[1] + bflo(qv.y) * n0[2] + bfhi(qv.y) * n0[3] + bflo(qv.z) * n1[0] + bfhi(qv.z) * n1[1] + bflo(qv.w) * n1[2] + bfhi(qv.w) * n1[3]; }
            qn += __shfl_xor(qn, 32);
            float rsum = 0.f;
            if (th == 0) {
#pragma unroll
                for (int g4 = 0; g4 < 4; ++g4) { const f32x4 cf0 = *(const LAS f32x4*)(colf_l + 8 * g4 + 4 * h);
#pragma unroll
                    for (int e = 0; e < 4; ++e) { const int i = 4 * g4 + e; const int srow_ = 8 * g4 + 4 * h + e;
                        const float w = (srow_ <= r) ? __expf(rowf_r + cf0[e]) : 0.f; X0[i] *= w; rsum += X0[i]; } }
            } else {
#pragma unroll
                for (int g4 = 0; g4 < 4; ++g4) { const f32x4 cf0 = *(const LAS f32x4*)(colf_l + 8 * g4 + 4 * h), cf1 = *(const LAS f32x4*)(colf_l + 32 + 8 * g4 + 4 * h);
#pragma unroll
                    for (int e = 0; e < 4; ++e) { const int i = 4 * g4 + e; const int srow_ = 8 * g4 + 4 * h + e;
                        const float w0 = __expf(rowf_r + cf0[e]); X0[i] *= w0; rsum += X0[i];
                        const float w1 = (srow_ <= r) ? __expf(rowf_r + cf1[e]) : 0.f; X1[i] *= w1; rsum += X1[i]; } }
            }
            rsum += __shfl_xor(rsum, 32);
            { const float den = ein_r * qn + rsum; const float rd = 1.0f / fmaxf(fabsf(den), eneg_r); if (h == 0) rden_l[r] = rd; }
            f32x16 hacc;
#pragma unroll
            for (int i = 0; i < 16; ++i) hacc[i] = 0.f;
#pragma unroll
            for (int ti = 0; ti < 4; ++ti)
#pragma unroll
                for (int ks2 = 0; ks2 < 2; ++ks2) {
                    const s16x4 qa = *(const LAS s16x4*)(lds + (a_q64 ^ (16u * (4 * ti + 2 * ks2 + 0))) + QOFF);
                    const s16x4 qb = *(const LAS s16x4*)(lds + (a_q64 ^ (16u * (4 * ti + 2 * ks2 + 1))) + QOFF);
                    const bf16x8 af = {qa[0], qa[1], qa[2], qa[3], qb[0], qb[1], qb[2], qb[3]};
                    hacc = __builtin_amdgcn_mfma_f32_32x32x16_bf16(af, pack8(C[ti], ks2), hacc, 0, 0, 0);
                }
#pragma unroll
            for (int g4 = 0; g4 < 4; ++g4) { const f32x4 ev = *(const LAS f32x4*)(ein_l + 32 * th + 8 * g4 + 4 * h);
#pragma unroll
                for (int e = 0; e < 4; ++e) hacc[4 * g4 + e] *= ev[e]; }
            {
                const unsigned vb = (unsigned)(uintptr_t)lds + (a_perm ^ (64u * (unsigned)cb));
                const unsigned vb1 = vb ^ 32u;
                const s16x4 l00 = trr<VOFF + 256 * 0>(vb), h00 = trr<VOFF + 256 * 8>(vb1), l01 = trr<VOFF + 256 * 16>(vb), h01 = trr<VOFF + 256 * 24>(vb1);
                MS_LWAIT();
                hacc = __builtin_amdgcn_mfma_f32_32x32x16_bf16(pack8(X0, 0), (bf16x8){l00[0], l00[1], l00[2], l00[3], h00[0], h00[1], h00[2], h00[3]}, hacc, 0, 0, 0);
                hacc = __builtin_amdgcn_mfma_f32_32x32x16_bf16(pack8(X0, 1), (bf16x8){l01[0], l01[1], l01[2], l01[3], h01[0], h01[1], h01[2], h01[3]}, hacc, 0, 0, 0);
                if (th == 1) {
                    const s16x4 l10 = trr<VOFF + 256 * 32>(vb), h10 = trr<VOFF + 256 * 40>(vb1), l11 = trr<VOFF + 256 * 48>(vb), h11 = trr<VOFF + 256 * 56>(vb1);
                    MS_LWAIT();
                    hacc = __builtin_amdgcn_mfma_f32_32x32x16_bf16(pack8(X1, 0), (bf16x8){l10[0], l10[1], l10[2], l10[3], h10[0], h10[1], h10[2], h10[3]}, hacc, 0, 0, 0);
                    hacc = __builtin_amdgcn_mfma_f32_32x32x16_bf16(pack8(X1, 1), (bf16x8){l11[0], l11[1], l11[2], l11[3], h11[0], h11[1], h11[2], h11[3]}, hacc, 0, 0, 0);
                }
            }
            if (need_ctx_out || c >= CTXL / 64) {
#pragma unroll
                for (int g4 = 0; g4 < 4; ++g4) { const f32x4 rv = *(const LAS f32x4*)(rden_l + 8 * g4 + 4 * h);
#pragma unroll
                    for (int e = 0; e < 4; ++e) { const int t = 32 * th + 8 * g4 + 4 * h + e; const int row = scan_row(b, dir, c * 64 + t);
                        const float v = hacc[4 * g4 + e] * rv[e]; HO[(size_t)row * DM + ocol] = (bf16_t)(cvtpk(v, v) & 0xffffu); } }
            }
#pragma unroll
            for (int ti = 0; ti < 4; ++ti)
#pragma unroll
                for (int i = 0; i < 16; ++i) C[ti][i] *= e_prev;
            {
                const unsigned nb = (unsigned)(uintptr_t)lds + a_nat;
                const unsigned vb0 = nb ^ (64u * (unsigned)cb), vb1 = vb0 ^ 16u;
                const unsigned kb00 = nb, kb01 = nb ^ 16u, kb10 = nb ^ 64u, kb11 = nb ^ 80u, kb20 = nb ^ 128u, kb21 = nb ^ 144u, kb30 = nb ^ 192u, kb31 = nb ^ 208u;
#define MS_FSTEP(KS) do { \
                    const s16x4 vl = trr<VOFF + 256 * (16 * (KS))>(vb0), vh = trr<VOFF + 256 * (16 * (KS) + 4)>(vb1); \
                    const s16x4 k0l = trr<KOFF + 256 * (16 * (KS))>(kb00), k0h = trr<KOFF + 256 * (16 * (KS) + 4)>(kb01); \
                    const s16x4 k1l = trr<KOFF + 256 * (16 * (KS))>(kb10), k1h = trr<KOFF + 256 * (16 * (KS) + 4)>(kb11); \
                    const s16x4 k2l = trr<KOFF + 256 * (16 * (KS))>(kb20), k2h = trr<KOFF + 256 * (16 * (KS) + 4)>(kb21); \
                    const s16x4 k3l = trr<KOFF + 256 * (16 * (KS))>(kb30), k3h = trr<KOFF + 256 * (16 * (KS) + 4)>(kb31); \
                    const f32x4 w0 = *(const LAS f32x4*)(wg_l + 16 * (KS) + 8 * h), w1 = *(const LAS f32x4*)(wg_l + 16 * (KS) + 8 * h + 4); \
                    MS_LWAIT(); \
                    f32x8 vf; \
                    _Pragma("unroll") for (int e = 0; e < 4; ++e) { vf[e] = bf2f((bf16_t)vl[e]) * w0[e]; vf[4 + e] = bf2f((bf16_t)vh[e]) * w1[e]; } \
                    const bf16x8 vw = __builtin_bit_cast(bf16x8, __builtin_convertvector(vf, bf16x8v)); \
                    C[0] = __builtin_amdgcn_mfma_f32_32x32x16_bf16((bf16x8){k0l[0], k0l[1], k0l[2], k0l[3], k0h[0], k0h[1], k0h[2], k0h[3]}, vw, C[0], 0, 0, 0); \
                    C[1] = __builtin_amdgcn_mfma_f32_32x32x16_bf16((bf16x8){k1l[0], k1l[1], k1l[2], k1l[3], k1h[0], k1h[1], k1h[2], k1h[3]}, vw, C[1], 0, 0, 0); \
                    C[2] = __builtin_amdgcn_mfma_f32_32x32x16_bf16((bf16x8){k2l[0], k2l[1], k2l[2], k2l[3], k2h[0], k2h[1], k2h[2], k2h[3]}, vw, C[2], 0, 0, 0); \
                    C[3] = __builtin_amdgcn_mfma_f32_32x32x16_bf16((bf16x8){k3l[0], k3l[1], k3l[2], k3l[3], k3h[0], k3h[1], k3h[2], k3h[3]}, vw, C[3], 0, 0, 0); } while (0)
                MS_FSTEP(0); MS_FSTEP(1); MS_FSTEP(2); MS_FSTEP(3);
#undef MS_FSTEP
            }
            {
                const unsigned dl = ul & 15, sg = ul >> 4, d = 16u * (unsigned)wave + dl;
                const unsigned nl = cbase + KOFF + 4096u * sg + 16u * (d >> 3) + 2u * (d & 7);
                float acc = 0.f;
#pragma unroll
                for (int ss = 0; ss < 16; ++ss) { const bf16_t kv = *(const LAS bf16_t*)(lds + ((nl ^ (16u * xr16(ss))) + 256u * ss)); acc = fmaf(wg_l[16 * sg + ss], bf2f(kv), acc); }
                acc += __shfl_xor(acc, 16); acc += __shfl_xor(acc, 32);
                if (sg == 0) nnxt[d] = fmaf(e_prev, ncur[d], acc);
            }
            c_ig = g_ig; c_lf = g_lf;
            asm volatile("s_waitcnt vmcnt(0)" ::: "memory");
            __syncthreads();
        }
#undef MS_DMA
    }
}

namespace ms3 {
using namespace ms;
constexpr int SHOFF = NOFF + 1024;
constexpr int WP3OFF = SHOFF + 2048;
}
__device__ __forceinline__ void phase_scan3(const bf16_t* Z, const float* GATE, bf16_t* HF, bf16_t* HB, bool need_ctx_out, LAS unsigned char* lds, int tid, int lane, int wave) {
    using namespace ms; using namespace ms3;
    const int r = lane & 31, h = lane >> 5;
    const bool helper = wave >= 4; const int cb = wave & 3;
    LAS float* sh_colf = (LAS float*)(lds + SHOFF); LAS float* sh_wg = sh_colf + 64; LAS float* sh_ein = sh_colf + 128; LAS float* sh_rowf = sh_colf + 192; LAS float* sh_eneg = sh_colf + 256;
    LAS float* sh_qn = sh_colf + 320; LAS float* sh_scal = sh_colf + 384;
    LAS float* wpv = (LAS float*)(lds + WP3OFF + wave * 1024);
    for (int task = blockIdx.x; task < 256; task += gridDim.x) {
        const int dvh = task & 1, dir = (task >> 1) & 1, hd = (task >> 2) & 7, b = task >> 5;
        bf16_t* HO = dir == 0 ? HF : HB;
        const int ocol = hd * 256 + dvh * 128 + cb * 32 + r;
        const int d_rl = lane >> 4, d_ch = (lane & 15) ^ ((d_rl << 2) | (wave & 3));
        const int d_col0 = hd * 128 + d_ch * 8, d_col1 = 1024 + hd * 128 + d_ch * 8, d_col2 = 2048 + hd * 256 + dvh * 128 + d_ch * 8;
        float g_ig = 0.f, g_lf = 0.f;
#define MS_DMA(c_, buf_) do { _Pragma("unroll") for (int i_ = 0; i_ < 6; ++i_) { const int rg_ = 8 * (i_ & 1) + wave; const int row_ = scan_row(b, dir, (c_) * 64 + 4 * rg_ + d_rl); \
            const int col_ = (i_ >> 1) == 0 ? d_col0 : ((i_ >> 1) == 1 ? d_col1 : d_col2); \
            __builtin_amdgcn_global_load_lds((const unsigned*)(Z + (size_t)row_ * NMI + col_), (LAS unsigned*)(lds + (buf_) * BUFB + (i_ >> 1) * 16384 + 1024 * rg_), 16, 0, 0); } \
            if (helper) { const int row_ = scan_row(b, dir, (c_) * 64 + lane); g_ig = GATE[(size_t)row_ * 32 + (dir * 2) * 8 + hd]; g_lf = GATE[(size_t)row_ * 32 + (dir * 2 + 1) * 8 + hd]; } } while (0)
        f32x16 C[4];
#pragma unroll
        for (int ti = 0; ti < 4; ++ti)
#pragma unroll
            for (int i = 0; i < 16; ++i) C[ti][i] = 0.f;
        float m_prev = 0.f;
        __syncthreads();
        MS_DMA(0, 0);
        if (tid < 128) ((LAS float*)(lds + NOFF))[tid] = 0.f;
        float c_ig = g_ig, c_lf = g_lf;
        asm volatile("s_waitcnt vmcnt(0)" ::: "memory");
        __syncthreads();
        for (int c = 0; c < NCHUNK; ++c) {
            const int cur = c & 1;
            int lane_l = lane; asm volatile("" : "+v"(lane_l));
            const unsigned ul = (unsigned)lane_l, uh = ul >> 5, ublk = (ul >> 4) & 1, uq = (ul & 15) >> 2, up = ul & 3, ur = ul & 31;
            const unsigned cbase = (unsigned)(cur * BUFB);
            const LAS float* ncur = (const LAS float*)(lds + NOFF + cur * 512); LAS float* nnxt = (LAS float*)(lds + NOFF + (cur ^ 1) * 512);
            if (c + 1 < NCHUNK) MS_DMA(c + 1, cur ^ 1);
            if (helper) {
                const int hw = wave - 4;
                const float bsum = scan_incl_add(c_lf, lane);
                const float av = c_ig - bsum;
                const float pm = scan_incl_max(av, lane);
                const float mm = fmaxf(m_prev, pm);
                const float ein = __expf(m_prev - mm), eneg = __expf(-(bsum + mm));
                const float b_end = __shfl(bsum, 63), mm_end = __shfl(mm, 63);
                const float e_prev = __expf(m_prev - mm_end);
                const float wgv = __expf(av - mm_end);
                wpv[lane] = wgv;
                if (hw == 0) { sh_colf[lane] = av; sh_wg[lane] = wgv; sh_ein[lane] = ein; sh_rowf[lane] = -mm; sh_eneg[lane] = eneg; if (lane == 0) sh_scal[0] = e_prev; }
                m_prev = b_end + mm_end;
                {
                    const unsigned rr = ul & 15, dg = ul >> 4, row = 16u * (unsigned)hw + rr;
                    const unsigned qa = cbase + QOFF + 256u * row + 16u * ((4u * dg) ^ xr16(row & 15));
                    float qn = 0.f;
#pragma unroll
                    for (int cc = 0; cc < 4; ++cc) { const u32x4 qv = *(const LAS u32x4*)(lds + (qa ^ (16u * cc)));
                        const f32x4 n0 = *(const LAS f32x4*)(ncur + 32 * dg + 8 * cc), n1 = *(const LAS f32x4*)(ncur + 32 * dg + 8 * cc + 4);
                        qn += bflo(qv.x) * n0[0] + bfhi(qv.x) * n0[1] + bflo(qv.y) * n0[2] + bfhi(qv.y) * n0[3] + bflo(qv.z) * n1[0] + bfhi(qv.z) * n1[1] + bflo(qv.w) * n1[2] + bfhi(qv.w) * n1[3]; }
                    qn += __shfl_xor(qn, 16); qn += __shfl_xor(qn, 32);
                    if (dg == 0) sh_qn[row] = qn;
                }
                asm volatile("s_waitcnt lgkmcnt(0)" ::: "memory");
                __syncthreads();
                {
                    const unsigned dl = ul & 31, sg = ul >> 5, d = 32u * (unsigned)hw + dl;
                    const unsigned nl = cbase + KOFF + 8192u * sg + 16u * (d >> 3) + 2u * (d & 7);
                    float acc = 0.f;
#pragma unroll
                    for (int ss = 0; ss < 32; ++ss) { const bf16_t kv = *(const LAS bf16_t*)(lds + ((nl ^ (16u * xr16(ss & 15))) + 256u * ss)); acc = fmaf(wpv[32 * sg + ss], bf2f(kv), acc); }
                    acc += __shfl_xor(acc, 32);
                    if (sg == 0) nnxt[d] = fmaf(e_prev, ncur[d], acc);
                }
                c_ig = g_ig; c_lf = g_lf;
            } else {
                const unsigned a_nat = cbase + 256u * (8u * uh + uq) + ((64u * uq) | (32u * (ublk ^ uh)) | (16u * (up >> 1))) + 8u * (up & 1);
                const unsigned a_perm = cbase + 256u * (4u * uh + uq) + ((64u * uq) | (32u * ublk) | (16u * ((up >> 1) ^ uh))) + 8u * (up & 1);
                const unsigned a_row = cbase + 256u * ur + ((16u * xr16(ur)) ^ (16u * uh));
                const unsigned a_q64 = cbase + 256u * ur + 16u * xr16(ur) + 8u * uh;
                f32x16 Xa, Xb, Xc;
#pragma unroll
                for (int i = 0; i < 16; ++i) { Xa[i] = 0.f; Xb[i] = 0.f; Xc[i] = 0.f; }
#pragma unroll
                for (int ks = 0; ks < 8; ++ks) {
                    const unsigned ar = a_row ^ (32u * ks);
                    const bf16x8 q0 = *(const LAS bf16x8*)(lds + ar + QOFF), q1 = *(const LAS bf16x8*)(lds + ar + QOFF + 8192);
                    const bf16x8 k0 = *(const LAS bf16x8*)(lds + ar + KOFF), k1 = *(const LAS bf16x8*)(lds + ar + KOFF + 8192);
                    Xa = __builtin_amdgcn_mfma_f32_32x32x16_bf16(k0, q0, Xa, 0, 0, 0);
                    Xb = __builtin_amdgcn_mfma_f32_32x32x16_bf16(k0, q1, Xb, 0, 0, 0);
                    Xc = __builtin_amdgcn_mfma_f32_32x32x16_bf16(k1, q1, Xc, 0, 0, 0);
                }
                __syncthreads();
                const float e_prev = sh_scal[0];
                LAS float* rden_l = wpv;
                {
                    const float rowf0 = sh_rowf[r], rowf1 = sh_rowf[32 + r];
                    float rs0 = 0.f, rs1 = 0.f;
#pragma unroll
                    for (int g4 = 0; g4 < 4; ++g4) { const f32x4 cf0 = *(const LAS f32x4*)(sh_colf + 8 * g4 + 4 * h), cf1 = *(const LAS f32x4*)(sh_colf + 32 + 8 * g4 + 4 * h);
#pragma unroll
                        for (int e = 0; e < 4; ++e) { const int i = 4 * g4 + e; const int srow_ = 8 * g4 + 4 * h + e;
                            const float wa = (srow_ <= r) ? __expf(rowf0 + cf0[e]) : 0.f; Xa[i] *= wa; rs0 += Xa[i];
                            const float wb = __expf(rowf1 + cf0[e]); Xb[i] *= wb; rs1 += Xb[i];
                            const float wc = (srow_ <= r) ? __expf(rowf1 + cf1[e]) : 0.f; Xc[i] *= wc; rs1 += Xc[i]; } }
                    rs0 += __shfl_xor(rs0, 32); rs1 += __shfl_xor(rs1, 32);
                    const float den0 = sh_ein[r] * sh_qn[r] + rs0, den1 = sh_ein[32 + r] * sh_qn[32 + r] + rs1;
                    const float rd0 = 1.0f / fmaxf(fabsf(den0), sh_eneg[r]), rd1 = 1.0f / fmaxf(fabsf(den1), sh_eneg[32 + r]);
                    if (h == 0) { rden_l[r] = rd0; rden_l[32 + r] = rd1; }
                }
                f32x16 h0, h1;
#pragma unroll
                for (int i = 0; i < 16; ++i) { h0[i] = 0.f; h1[i] = 0.f; }
#pragma unroll
                for (int ti = 0; ti < 4; ++ti)
#pragma unroll
                    for (int ks2 = 0; ks2 < 2; ++ks2) {
                        const unsigned qx0 = a_q64 ^ (16u * (4 * ti + 2 * ks2 + 0)), qx1 = a_q64 ^ (16u * (4 * ti + 2 * ks2 + 1));
                        const s16x4 qa0 = *(const LAS s16x4*)(lds + qx0 + QOFF), qb0 = *(const LAS s16x4*)(lds + qx1 + QOFF);
                        const s16x4 qa1 = *(const LAS s16x4*)(lds + qx0 + QOFF + 8192), qb1 = *(const LAS s16x4*)(lds + qx1 + QOFF + 8192);
                        const bf16x8 cp = pack8(C[ti], ks2);
                        h0 = __builtin_amdgcn_mfma_f32_32x32x16_bf16((bf16x8){qa0[0], qa0[1], qa0[2], qa0[3], qb0[0], qb0[1], qb0[2], qb0[3]}, cp, h0, 0, 0, 0);
                        h1 = __builtin_amdgcn_mfma_f32_32x32x16_bf16((bf16x8){qa1[0], qa1[1], qa1[2], qa1[3], qb1[0], qb1[1], qb1[2], qb1[3]}, cp, h1, 0, 0, 0);
                    }
#pragma unroll
                for (int g4 = 0; g4 < 4; ++g4) { const f32x4 e0 = *(const LAS f32x4*)(sh_ein + 8 * g4 + 4 * h), e1 = *(const LAS f32x4*)(sh_ein + 32 + 8 * g4 + 4 * h);
#pragma unroll
                    for (int e = 0; e < 4; ++e) { h0[4 * g4 + e] *= e0[e]; h1[4 * g4 + e] *= e1[e]; } }
                {
                    const unsigned vb = (unsigned)(uintptr_t)lds + (a_perm ^ (64u * (unsigned)cb)); const unsigned vb1 = vb ^ 32u;
                    const s16x4 l00 = trr<VOFF + 256 * 0>(vb), h00 = trr<VOFF + 256 * 8>(vb1), l01 = trr<VOFF + 256 * 16>(vb), h01 = trr<VOFF + 256 * 24>(vb1);
                    const s16x4 l10 = trr<VOFF + 256 * 32>(vb), h10 = trr<VOFF + 256 * 40>(vb1), l11 = trr<VOFF + 256 * 48>(vb), h11 = trr<VOFF + 256 * 56>(vb1);
                    MS_LWAIT();
                    const bf16x8 v00 = {l00[0], l00[1], l00[2], l00[3], h00[0], h00[1], h00[2], h00[3]}, v01 = {l01[0], l01[1], l01[2], l01[3], h01[0], h01[1], h01[2], h01[3]};
                    const bf16x8 v10 = {l10[0], l10[1], l10[2], l10[3], h10[0], h10[1], h10[2], h10[3]}, v11 = {l11[0], l11[1], l11[2], l11[3], h11[0], h11[1], h11[2], h11[3]};
                    h0 = __builtin_amdgcn_mfma_f32_32x32x16_bf16(pack8(Xa, 0), v00, h0, 0, 0, 0);
                    h0 = __builtin_amdgcn_mfma_f32_32x32x16_bf16(pack8(Xa, 1), v01, h0, 0, 0, 0);
                    h1 = __builtin_amdgcn_mfma_f32_32x32x16_bf16(pack8(Xb, 0), v00, h1, 0, 0, 0);
                    h1 = __builtin_amdgcn_mfma_f32_32x32x16_bf16(pack8(Xb, 1), v01, h1, 0, 0, 0);
                    h1 = __builtin_amdgcn_mfma_f32_32x32x16_bf16(pack8(Xc, 0), v10, h1, 0, 0, 0);
                    h1 = __builtin_amdgcn_mfma_f32_32x32x16_bf16(pack8(Xc, 1), v11, h1, 0, 0, 0);
                }
                if (need_ctx_out || c >= CTXL / 64) {
#pragma unroll
                    for (int g4 = 0; g4 < 4; ++g4) { const f32x4 r0 = *(const LAS f32x4*)(rden_l + 8 * g4 + 4 * h), r1 = *(const LAS f32x4*)(rden_l + 32 + 8 * g4 + 4 * h);
#pragma unroll
                        for (int e = 0; e < 4; ++e) { const int t = 8 * g4 + 4 * h + e;
                            const int row0 = scan_row(b, dir, c * 64 + t), row1 = scan_row(b, dir, c * 64 + 32 + t);
                            const float v0 = h0[4 * g4 + e] * r0[e], v1 = h1[4 * g4 + e] * r1[e];
                            HO[(size_t)row0 * DM + ocol] = (bf16_t)(cvtpk(v0, v0) & 0xffffu); HO[(size_t)row1 * DM + ocol] = (bf16_t)(cvtpk(v1, v1) & 0xffffu); } }
                }
#pragma unroll
                for (int ti = 0; ti < 4; ++ti)
#pragma unroll
                    for (int i = 0; i < 16; ++i) C[ti][i] *= e_prev;
                {
                    const unsigned nb = (unsigned)(uintptr_t)lds + a_nat;
                    const unsigned vb0 = nb ^ (64u * (unsigned)cb), vb1 = vb0 ^ 16u;
                    const unsigned kb00 = nb, kb01 = nb ^ 16u, kb10 = nb ^ 64u, kb11 = nb ^ 80u, kb20 = nb ^ 128u, kb21 = nb ^ 144u, kb30 = nb ^ 192u, kb31 = nb ^ 208u;
#define MS_FSTEP(KS) do { \
                        const s16x4 vl = trr<VOFF + 256 * (16 * (KS))>(vb0), vh = trr<VOFF + 256 * (16 * (KS) + 4)>(vb1); \
                        const s16x4 k0l = trr<KOFF + 256 * (16 * (KS))>(kb00), k0h = trr<KOFF + 256 * (16 * (KS) + 4)>(kb01); \
                        const s16x4 k1l = trr<KOFF + 256 * (16 * (KS))>(kb10), k1h = trr<KOFF + 256 * (16 * (KS) + 4)>(kb11); \
                        const s16x4 k2l = trr<KOFF + 256 * (16 * (KS))>(kb20), k2h = trr<KOFF + 256 * (16 * (KS) + 4)>(kb21); \
                        const s16x4 k3l = trr<KOFF + 256 * (16 * (KS))>(kb30), k3h = trr<KOFF + 256 * (16 * (KS) + 4)>(kb31); \
                        const f32x4 w0 = *(const LAS f32x4*)(sh_wg + 16 * (KS) + 8 * h), w1 = *(const LAS f32x4*)(sh_wg + 16 * (KS) + 8 * h + 4); \
                        MS_LWAIT(); \
                        f32x8 vf; \
                        _Pragma("unroll") for (int e = 0; e < 4; ++e) { vf[e] = bf2f((bf16_t)vl[e]) * w0[e]; vf[4 + e] = bf2f((bf16_t)vh[e]) * w1[e]; } \
                        const bf16x8 vw = __builtin_bit_cast(bf16x8, __builtin_convertvector(vf, bf16x8v)); \
                        C[0] = __builtin_amdgcn_mfma_f32_32x32x16_bf16((bf16x8){k0l[0], k0l[1], k0l[2], k0l[3], k0h[0], k0h[1], k0h[2], k0h[3]}, vw, C[0], 0, 0, 0); \
                        C[1] = __builtin_amdgcn_mfma_f32_32x32x16_bf16((bf16x8){k1l[0], k1l[1], k1l[2], k1l[3], k1h[0], k1h[1], k1h[2], k1h[3]}, vw, C[1], 0, 0, 0); \
                        C[2] = __builtin_amdgcn_mfma_f32_32x32x16_bf16((bf16x8){k2l[0], k2l[1], k2l[2], k2l[3], k2h[0], k2h[1], k2h[2], k2h[3]}, vw, C[2], 0, 0, 0); \
                        C[3] = __builtin_amdgcn_mfma_f32_32x32x16_bf16((bf16x8){k3l[0], k3l[1], k3l[2], k3l[3], k3h[0], k3h[1], k3h[2], k3h[3]}, vw, C[3], 0, 0, 0); } while (0)
                    MS_FSTEP(0); MS_FSTEP(1); MS_FSTEP(2); MS_FSTEP(3);
#undef MS_FSTEP
                }
            }
            asm volatile("s_waitcnt vmcnt(0)" ::: "memory");
            __syncthreads();
        }
#undef MS_DMA
    }
}

namespace ms4 {
using namespace ms;
constexpr int GOFF = NOFF + 1024;
constexpr int GBUF = 6 * 64 * 4;
constexpr int POFF = GOFF + 2 * GBUF;
constexpr int RSOFF = POFF + 6144;
constexpr int WP4OFF = RSOFF + 1024;
}
__device__ __forceinline__ void phase_scan4(const bf16_t* Z, const float* GATE, bf16_t* HF, bf16_t* HB, bool need_ctx_out, LAS unsigned char* lds, int tid, int lane, int wave) {
    using namespace ms; using namespace ms4;
    const int r = lane & 31, h = lane >> 5;
    const bool score = wave >= 4; const int cb = wave & 3, T = wave - 4;
    LAS float* rsA = (LAS float*)(lds + RSOFF); LAS float* sh_qn = rsA + 96;
    LAS float* wpv = (LAS float*)(lds + WP4OFF + wave * 512);
    for (int task = blockIdx.x; task < 256; task += gridDim.x) {
        const int dvh = task & 1, dir = (task >> 1) & 1, hd = (task >> 2) & 7, b = task >> 5;
        bf16_t* HO = dir == 0 ? HF : HB;
        const int ocol0 = hd * 256 + dvh * 128 + cb * 32;
        const int d_rl = lane >> 4, d_ch = (lane & 15) ^ ((d_rl << 2) | (wave & 3));
        const int d_col0 = hd * 128 + d_ch * 8, d_col1 = 1024 + hd * 128 + d_ch * 8, d_col2 = 2048 + hd * 256 + dvh * 128 + d_ch * 8;
        float g_ig = 0.f, g_lf = 0.f;
        const int rstep = dir == 0 ? 1 : -1;
#define MS_DMA(c_, buf_) do { const int rb_ = scan_row(b, dir, (c_) * 64); _Pragma("unroll") for (int i_ = 0; i_ < 6; ++i_) { const int rg_ = 8 * (i_ & 1) + wave; const int row_ = rb_ + rstep * (4 * rg_ + d_rl); \
            const int col_ = (i_ >> 1) == 0 ? d_col0 : ((i_ >> 1) == 1 ? d_col1 : d_col2); \
            __builtin_amdgcn_global_load_lds((const unsigned*)(Z + (size_t)row_ * NMI + col_), (LAS unsigned*)(lds + (buf_) * BUFB + (i_ >> 1) * 16384 + 1024 * rg_), 16, 0, 0); } } while (0)
#define MS_GLOAD(c_) do { const int row_ = scan_row(b, dir, (c_) * 64) + rstep * lane; g_ig = GATE[(size_t)row_ * 32 + (dir * 2) * 8 + hd]; g_lf = GATE[(size_t)row_ * 32 + (dir * 2 + 1) * 8 + hd]; } while (0)
#define MS_GATES(gb_) do { \
            const float bsum_ = scan_incl_add(g_lf, lane); const float av_ = g_ig - bsum_; const float pm_ = scan_incl_max(av_, lane); const float mm_ = fmaxf(m_prev, pm_); \
            const float b_end_ = __shfl(bsum_, 63), mm_end_ = __shfl(mm_, 63); \
            if (T == 3) { LAS float* gp_ = (LAS float*)(lds + GOFF + (gb_) * GBUF); gp_[lane] = av_; gp_[64 + lane] = __expf(av_ - mm_end_); gp_[128 + lane] = __expf(m_prev - mm_); \
                gp_[192 + lane] = -mm_; gp_[256 + lane] = __expf(-(bsum_ + mm_)); if (lane == 0) gp_[320] = __expf(m_prev - mm_end_); } \
            m_prev = b_end_ + mm_end_; } while (0)
        f32x16 C[4];
#pragma unroll
        for (int ti = 0; ti < 4; ++ti)
#pragma unroll
            for (int i = 0; i < 16; ++i) C[ti][i] = 0.f;
        float m_prev = 0.f;
        __syncthreads();
        MS_DMA(0, 0);
        if (tid < 128) ((LAS float*)(lds + NOFF))[tid] = 0.f;
        if (score) { MS_GLOAD(0); MS_GATES(0); }
        asm volatile("s_waitcnt vmcnt(0) lgkmcnt(0)" ::: "memory");
        __syncthreads();
        for (int c = 0; c < NCHUNK; ++c) {
            const int cur = c & 1;
            int lane_l = lane; asm volatile("" : "+v"(lane_l));
            const unsigned ul = (unsigned)lane_l, uh = ul >> 5, ublk = (ul >> 4) & 1, uq = (ul & 15) >> 2, up = ul & 3, ur = ul & 31;
            const unsigned cbase = (unsigned)(cur * BUFB);
            const LAS float* ncur = (const LAS float*)(lds + NOFF + cur * 512); LAS float* nnxt = (LAS float*)(lds + NOFF + (cur ^ 1) * 512);
            const LAS float* gcur = (const LAS float*)(lds + GOFF + cur * GBUF);
            if (score) {
                if (c + 1 < NCHUNK) MS_GLOAD(c + 1);
                if (T < 3) {
                    const unsigned a_row = cbase + 256u * ur + ((16u * xr16(ur)) ^ (16u * uh));
                    const unsigned qoff = QOFF + (T == 0 ? 0u : 8192u), koff = KOFF + (T == 2 ? 8192u : 0u);
                    f32x16 X;
#pragma unroll
                    for (int i = 0; i < 16; ++i) X[i] = 0.f;
#pragma unroll
                    for (int ks = 0; ks < 8; ++ks) { const unsigned ar = a_row ^ (32u * ks);
                        X = __builtin_amdgcn_mfma_f32_32x32x16_bf16(*(const LAS bf16x8*)(lds + ar + koff), *(const LAS bf16x8*)(lds + ar + qoff), X, 0, 0, 0); }
                    const float rowf = gcur[192 + (T == 0 ? 0 : 32) + r];
                    const LAS float* cfp = gcur + (T == 2 ? 32 : 0);
                    float rs = 0.f;
#pragma unroll
                    for (int g4 = 0; g4 < 4; ++g4) { const f32x4 cf = *(const LAS f32x4*)(cfp + 8 * g4 + 4 * h);
#pragma unroll
                        for (int e = 0; e < 4; ++e) { const int i = 4 * g4 + e; const int srow_ = 8 * g4 + 4 * h + e;
                            const float w = (T == 1 || srow_ <= r) ? __expf(rowf + cf[e]) : 0.f; X[i] *= w; rs += X[i]; } }
                    rs += __shfl_xor(rs, 32);
                    if (h == 0) rsA[32 * T + r] = rs;
                    *(LAS bf16x8*)(lds + POFF + ((T * 2 + 0) * 64 + lane) * 16) = pack8(X, 0);
                    *(LAS bf16x8*)(lds + POFF + ((T * 2 + 1) * 64 + lane) * 16) = pack8(X, 1);
                }
                {
                    const unsigned rr = ul & 15, dg = ul >> 4, row = 16u * (unsigned)T + rr;
                    const unsigned qa = cbase + QOFF + 256u * row + 16u * ((4u * dg) ^ xr16(row & 15));
                    float qn = 0.f;
#pragma unroll
                    for (int cc = 0; cc < 4; ++cc) { const u32x4 qv = *(const LAS u32x4*)(lds + (qa ^ (16u * cc)));
                        const f32x4 n0 = *(const LAS f32x4*)(ncur + 32 * dg + 8 * cc), n1 = *(const LAS f32x4*)(ncur + 32 * dg + 8 * cc + 4);
                        qn += bflo(qv.x) * n0[0] + bfhi(qv.x) * n0[1] + bflo(qv.y) * n0[2] + bfhi(qv.y) * n0[3] + bflo(qv.z) * n1[0] + bfhi(qv.z) * n1[1] + bflo(qv.w) * n1[2] + bfhi(qv.w) * n1[3]; }
                    qn += __shfl_xor(qn, 16); qn += __shfl_xor(qn, 32);
                    if (dg == 0) sh_qn[row] = qn;
                }
                asm volatile("s_waitcnt lgkmcnt(0)" ::: "memory");
                __builtin_amdgcn_s_barrier(); asm volatile("" ::: "memory");
                asm volatile("" : "+v"(g_ig), "+v"(g_lf));
                if (c + 1 < NCHUNK) MS_DMA(c + 1, cur ^ 1);
                {
                    const float e_prev = gcur[320];
                    const unsigned dl = ul & 31, sg = ul >> 5, d = 32u * (unsigned)T + dl;
                    const unsigned nl = cbase + KOFF + 8192u * sg + 16u * (d >> 3) + 2u * (d & 7);
                    float acc = 0.f;
#pragma unroll
                    for (int ss = 0; ss < 32; ++ss) { const bf16_t kv = *(const LAS bf16_t*)(lds + ((nl ^ (16u * xr16(ss & 15))) + 256u * ss)); acc = fmaf(gcur[64 + 32 * sg + ss], bf2f(kv), acc); }
                    acc += __shfl_xor(acc, 32);
                    if (sg == 0) nnxt[d] = fmaf(e_prev, ncur[d], acc);
                }
                if (c + 1 < NCHUNK) MS_GATES(cur ^ 1);
            } else {
                const unsigned a_nat = cbase + 256u * (8u * uh + uq) + ((64u * uq) | (32u * (ublk ^ uh)) | (16u * (up >> 1))) + 8u * (up & 1);
                const unsigned a_perm = cbase + 256u * (4u * uh + uq) + ((64u * uq) | (32u * ublk) | (16u * ((up >> 1) ^ uh))) + 8u * (up & 1);
                const unsigned a_q64 = cbase + 256u * ur + 16u * xr16(ur) + 8u * uh;
                f32x16 h0, h1;
#pragma unroll
                for (int i = 0; i < 16; ++i) { h0[i] = 0.f; h1[i] = 0.f; }
#pragma unroll
                for (int ti = 0; ti < 4; ++ti)
#pragma unroll
                    for (int ks2 = 0; ks2 < 2; ++ks2) {
                        const unsigned qx0 = a_q64 ^ (16u * (4 * ti + 2 * ks2 + 0)), qx1 = a_q64 ^ (16u * (4 * ti + 2 * ks2 + 1));
                        const s16x4 qa0 = *(const LAS s16x4*)(lds + qx0 + QOFF), qb0 = *(const LAS s16x4*)(lds + qx1 + QOFF);
                        const s16x4 qa1 = *(const LAS s16x4*)(lds + qx0 + QOFF + 8192), qb1 = *(const LAS s16x4*)(lds + qx1 + QOFF + 8192);
                        const bf16x8 cp = pack8(C[ti], ks2);
                        h0 = __builtin_amdgcn_mfma_f32_32x32x16_bf16(cp, (bf16x8){qa0[0], qa0[1], qa0[2], qa0[3], qb0[0], qb0[1], qb0[2], qb0[3]}, h0, 0, 0, 0);
                        h1 = __builtin_amdgcn_mfma_f32_32x32x16_bf16(cp, (bf16x8){qa1[0], qa1[1], qa1[2], qa1[3], qb1[0], qb1[1], qb1[2], qb1[3]}, h1, 0, 0, 0);
                    }
                const float ein0 = gcur[128 + r], ein1 = gcur[128 + 32 + r];
#pragma unroll
                for (int i = 0; i < 16; ++i) { h0[i] *= ein0; h1[i] *= ein1; }
                if (c + 1 < NCHUNK) MS_DMA(c + 1, cur ^ 1);
                asm volatile("s_waitcnt lgkmcnt(0)" ::: "memory"); __builtin_amdgcn_s_barrier(); asm volatile("" ::: "memory");
                const float e_prev = gcur[320];
                const float den0 = ein0 * sh_qn[r] + rsA[r], den1 = ein1 * sh_qn[32 + r] + rsA[32 + r] + rsA[64 + r];
                const float rd0 = __builtin_amdgcn_rcpf(fmaxf(fabsf(den0), gcur[256 + r])), rd1 = __builtin_amdgcn_rcpf(fmaxf(fabsf(den1), gcur[256 + 32 + r]));
                {
                    const unsigned vb = (unsigned)(uintptr_t)lds + (a_perm ^ (64u * (unsigned)cb)); const unsigned vb1 = vb ^ 32u;
                    const s16x4 l00 = trr<VOFF + 256 * 0>(vb), h00 = trr<VOFF + 256 * 8>(vb1), l01 = trr<VOFF + 256 * 16>(vb), h01 = trr<VOFF + 256 * 24>(vb1);
                    const s16x4 l10 = trr<VOFF + 256 * 32>(vb), h10 = trr<VOFF + 256 * 40>(vb1), l11 = trr<VOFF + 256 * 48>(vb), h11 = trr<VOFF + 256 * 56>(vb1);
                    const LAS bf16x8* pf = (const LAS bf16x8*)(lds + POFF) + lane;
                    const bf16x8 pa0 = pf[0 * 64], pa1 = pf[1 * 64], pb0 = pf[2 * 64], pb1 = pf[3 * 64], pc0 = pf[4 * 64], pc1 = pf[5 * 64];
                    MS_LWAIT();
                    const bf16x8 v00 = {l00[0], l00[1], l00[2], l00[3], h00[0], h00[1], h00[2], h00[3]}, v01 = {l01[0], l01[1], l01[2], l01[3], h01[0], h01[1], h01[2], h01[3]};
                    const bf16x8 v10 = {l10[0], l10[1], l10[2], l10[3], h10[0], h10[1], h10[2], h10[3]}, v11 = {l11[0], l11[1], l11[2], l11[3], h11[0], h11[1], h11[2], h11[3]};
                    h0 = __builtin_amdgcn_mfma_f32_32x32x16_bf16(v00, pa0, h0, 0, 0, 0);
                    h0 = __builtin_amdgcn_mfma_f32_32x32x16_bf16(v01, pa1, h0, 0, 0, 0);
                    h1 = __builtin_amdgcn_mfma_f32_32x32x16_bf16(v00, pb0, h1, 0, 0, 0);
                    h1 = __builtin_amdgcn_mfma_f32_32x32x16_bf16(v01, pb1, h1, 0, 0, 0);
                    h1 = __builtin_amdgcn_mfma_f32_32x32x16_bf16(v10, pc0, h1, 0, 0, 0);
                    h1 = __builtin_amdgcn_mfma_f32_32x32x16_bf16(v11, pc1, h1, 0, 0, 0);
                }
                if (need_ctx_out || c >= CTXL / 64) {
                    const long es = (long)rstep * DM;
                    bf16_t* hp0 = HO + (size_t)scan_row(b, dir, c * 64) * DM + ocol0 + 8 * h + (long)r * es;
                    bf16_t* hp1 = hp0 + 32 * es;
#pragma unroll
                    for (int gp = 0; gp < 2; ++gp) { const int ib = 8 * gp;
                        { const unsigned a0 = cvtpk(h0[ib + 0] * rd0, h0[ib + 1] * rd0), a1 = cvtpk(h0[ib + 2] * rd0, h0[ib + 3] * rd0), b0 = cvtpk(h0[ib + 4] * rd0, h0[ib + 5] * rd0), b1 = cvtpk(h0[ib + 6] * rd0, h0[ib + 7] * rd0);
                          auto s0 = __builtin_amdgcn_permlane32_swap(a0, b0, false, false); auto s1 = __builtin_amdgcn_permlane32_swap(a1, b1, false, false);
                          *(u32x4*)(hp0 + 16 * gp) = (u32x4){s0[0], s1[0], s0[1], s1[1]}; }
                        { const unsigned a0 = cvtpk(h1[ib + 0] * rd1, h1[ib + 1] * rd1), a1 = cvtpk(h1[ib + 2] * rd1, h1[ib + 3] * rd1), b0 = cvtpk(h1[ib + 4] * rd1, h1[ib + 5] * rd1), b1 = cvtpk(h1[ib + 6] * rd1, h1[ib + 7] * rd1);
                          auto s0 = __builtin_amdgcn_permlane32_swap(a0, b0, false, false); auto s1 = __builtin_amdgcn_permlane32_swap(a1, b1, false, false);
                          *(u32x4*)(hp1 + 16 * gp) = (u32x4){s0[0], s1[0], s0[1], s1[1]}; } }
                }
#pragma unroll
                for (int ti = 0; ti < 4; ++ti)
#pragma unroll
                    for (int i = 0; i < 16; ++i) C[ti][i] *= e_prev;
                {
                    const unsigned nb = (unsigned)(uintptr_t)lds + a_nat;
                    const unsigned vb0 = nb ^ (64u * (unsigned)cb), vb1 = vb0 ^ 16u;
                    const unsigned kb00 = nb, kb01 = nb ^ 16u, kb10 = nb ^ 64u, kb11 = nb ^ 80u, kb20 = nb ^ 128u, kb21 = nb ^ 144u, kb30 = nb ^ 192u, kb31 = nb ^ 208u;
#define MS_FSTEP(KS) do { \
                        const s16x4 vl = trr<VOFF + 256 * (16 * (KS))>(vb0), vh = trr<VOFF + 256 * (16 * (KS) + 4)>(vb1); \
                        const s16x4 k0l = trr<KOFF + 256 * (16 * (KS))>(kb00), k0h = trr<KOFF + 256 * (16 * (KS) + 4)>(kb01); \
                        const s16x4 k1l = trr<KOFF + 256 * (16 * (KS))>(kb10), k1h = trr<KOFF + 256 * (16 * (KS) + 4)>(kb11); \
                        const s16x4 k2l = trr<KOFF + 256 * (16 * (KS))>(kb20), k2h = trr<KOFF + 256 * (16 * (KS) + 4)>(kb21); \
                        const s16x4 k3l = trr<KOFF + 256 * (16 * (KS))>(kb30), k3h = trr<KOFF + 256 * (16 * (KS) + 4)>(kb31); \
                        const f32x4 w0 = *(const LAS f32x4*)(gcur + 64 + 16 * (KS) + 8 * h), w1 = *(const LAS f32x4*)(gcur + 64 + 16 * (KS) + 8 * h + 4); \
                        MS_LWAIT(); \
                        f32x8 vf; \
                        _Pragma("unroll") for (int e = 0; e < 4; ++e) { vf[e] = bf2f((bf16_t)vl[e]) * w0[e]; vf[4 + e] = bf2f((bf16_t)vh[e]) * w1[e]; } \
                        const bf16x8 vw = __builtin_bit_cast(bf16x8, __builtin_convertvector(vf, bf16x8v)); \
                        C[0] = __builtin_amdgcn_mfma_f32_32x32x16_bf16((bf16x8){k0l[0], k0l[1], k0l[2], k0l[3], k0h[0], k0h[1], k0h[2], k0h[3]}, vw, C[0], 0, 0, 0); \
                        C[1] = __builtin_amdgcn_mfma_f32_32x32x16_bf16((bf16x8){k1l[0], k1l[1], k1l[2], k1l[3], k1h[0], k1h[1], k1h[2], k1h[3]}, vw, C[1], 0, 0, 0); \
                        C[2] = __builtin_amdgcn_mfma_f32_32x32x16_bf16((bf16x8){k2l[0], k2l[1], k2l[2], k2l[3], k2h[0], k2h[1], k2h[2], k2h[3]}, vw, C[2], 0, 0, 0); \
                        C[3] = __builtin_amdgcn_mfma_f32_32x32x16_bf16((bf16x8){k3l[0], k3l[1], k3l[2], k3l[3], k3h[0], k3h[1], k3h[2], k3h[3]}, vw, C[3], 0, 0, 0); } while (0)
                    MS_FSTEP(0); MS_FSTEP(1); MS_FSTEP(2); MS_FSTEP(3);
#undef MS_FSTEP
                }
            }
            if (!score && (need_ctx_out || c >= CTXL / 64)) asm volatile("s_waitcnt vmcnt(4) lgkmcnt(0)" ::: "memory");
            else asm volatile("s_waitcnt vmcnt(0) lgkmcnt(0)" ::: "memory");
            __syncthreads();
        }
#undef MS_DMA
#undef MS_GLOAD
#undef MS_GATES
    }
}

__device__ __forceinline__ void phase_mfinish(const bf16_t* Z, const bf16_t* HF, const bf16_t* HB, const float* ghead, bf16_t* H, int row_end, int lane, int wave) {
    const int gw = blockIdx.x * NWAVES + wave, NGW = gridDim.x * NWAVES;
    const int lcol = (lane >> 5) * 256 + (lane & 31) * 8;
    f32x4 gh[8];
#pragma unroll
    for (int j = 0; j < 4; ++j) { gh[2 * j] = *(const f32x4*)(ghead + lcol + 512 * j); gh[2 * j + 1] = *(const f32x4*)(ghead + lcol + 512 * j + 4); }
    const bool fast = NGW == 2048; const int b = gw & 7, w8 = gw >> 3;
    const int n_it = fast ? 8 + (MX + gw < row_end ? 1 : 0) : (gw < row_end ? (row_end - gw + 2 * NGW - 1) / (2 * NGW) : 0);
    for (int it = 0; it < n_it; ++it) {
        int r, r2;
        if (fast) { if (it < 8) { r = b * SEQ + w8 + 256 * (15 - it); r2 = b * SEQ + w8 + 256 * it; } else { r = MX + gw; r2 = r; } }
        else { r = gw + 2 * NGW * it; r2 = (r + NGW < row_end) ? r + NGW : r; }
        u32x4 fa[4], ba[4], oa[4], fb[4], bb[4], ob[4];
#pragma unroll
        for (int j = 0; j < 4; ++j) { const int col = lcol + 512 * j;
            fa[j] = *(const u32x4*)(HF + (size_t)r * DM + col); ba[j] = *(const u32x4*)(HB + (size_t)r * DM + col); oa[j] = *(const u32x4*)(Z + (size_t)r * NMI + 4096 + col);
            fb[j] = *(const u32x4*)(HF + (size_t)r2 * DM + col); bb[j] = *(const u32x4*)(HB + (size_t)r2 * DM + col); ob[j] = *(const u32x4*)(Z + (size_t)r2 * NMI + 4096 + col); }
#pragma unroll
        for (int j = 0; j < 4; ++j) { const int col = lcol + 512 * j;
            float sa[8] = {bflo(fa[j].x) + bflo(ba[j].x), bfhi(fa[j].x) + bfhi(ba[j].x), bflo(fa[j].y) + bflo(ba[j].y), bfhi(fa[j].y) + bfhi(ba[j].y),
                           bflo(fa[j].z) + bflo(ba[j].z), bfhi(fa[j].z) + bfhi(ba[j].z), bflo(fa[j].w) + bflo(ba[j].w), bfhi(fa[j].w) + bfhi(ba[j].w)};
            float sb[8] = {bflo(fb[j].x) + bflo(bb[j].x), bfhi(fb[j].x) + bfhi(bb[j].x), bflo(fb[j].y) + bflo(bb[j].y), bfhi(fb[j].y) + bfhi(bb[j].y),
                           bflo(fb[j].z) + bflo(bb[j].z), bfhi(fb[j].z) + bfhi(bb[j].z), bflo(fb[j].w) + bflo(bb[j].w), bfhi(fb[j].w) + bfhi(bb[j].w)};
            float qa = 0.f, qb = 0.f;
#pragma unroll
            for (int e = 0; e < 8; ++e) { qa += sa[e] * sa[e]; qb += sb[e] * sb[e]; }
#pragma unroll
            for (int o = 1; o < 32; o <<= 1) { qa += __shfl_xor(qa, o); qb += __shfl_xor(qb, o); }
            const float ra = 1.0f / sqrtf(qa * (1.0f / 256.0f) + RMS_EPS), rb = 1.0f / sqrtf(qb * (1.0f / 256.0f) + RMS_EPS);
            const float oav[8] = {bflo(oa[j].x), bfhi(oa[j].x), bflo(oa[j].y), bfhi(oa[j].y), bflo(oa[j].z), bfhi(oa[j].z), bflo(oa[j].w), bfhi(oa[j].w)};
            const float obv[8] = {bflo(ob[j].x), bfhi(ob[j].x), bflo(ob[j].y), bfhi(ob[j].y), bflo(ob[j].z), bfhi(ob[j].z), bflo(ob[j].w), bfhi(ob[j].w)};
            float ya[8], yb[8];
#pragma unroll
            for (int e = 0; e < 8; ++e) { const float gg = e < 4 ? gh[2 * j][e] : gh[2 * j + 1][e - 4]; ya[e] = sigmoid_f(oav[e]) * (sa[e] * ra) * gg; yb[e] = sigmoid_f(obv[e]) * (sb[e] * rb) * gg; }
            *(u32x4*)(H + (size_t)r * DM + col) = (u32x4){cvtpk(ya[0], ya[1]), cvtpk(ya[2], ya[3]), cvtpk(ya[4], ya[5]), cvtpk(ya[6], ya[7])};
            *(u32x4*)(H + (size_t)r2 * DM + col) = (u32x4){cvtpk(yb[0], yb[1]), cvtpk(yb[2], yb[3]), cvtpk(yb[4], yb[5]), cvtpk(yb[6], yb[7])}; }
    }
}

#ifndef STAGGER_TICKS
#define STAGGER_TICKS 125
#endif
__device__ __forceinline__ void gemm_stagger(int bx) {
    const unsigned long long d = (unsigned long long)((bx >> 3) & 7) * STAGGER_TICKS;
    if (d) { const unsigned long long t0 = __builtin_amdgcn_s_memrealtime(); while (__builtin_amdgcn_s_memrealtime() - t0 < d) __builtin_amdgcn_s_sleep(8); }
}
#ifndef PROBE_KIND
#define PROBE_KIND 0
#endif
#ifndef PROBE_WG
#define PROBE_WG 5
#endif
#ifndef PROBE_SITE
#define PROBE_SITE 0
#endif
#ifndef PROBE_N
#define PROBE_N 16
#endif
#ifndef BG_BUDGET
#define BG_BUDGET 3
#endif
#define BG_TAIL(nunits_, cidx_) do { const int rem_ = (nunits_) % G; if (i < 3 && rem_ != 0 && bx >= rem_) { TL bg_run(a, lds, i + 1, 3, 1 << 30, (const unsigned*)(a.ws + WS_CTL) + CW_DONE + 64 * (cidx_), (unsigned)(nunits_), tid, lane, wave); } } while (0)
constexpr int CW_DONE = 3584;
constexpr int N_PHASES = 38;
#define REP(bit) for (int rep_ = 0; rep_ < (((DUP_MASK) >> (bit)) & 1) + 1; ++rep_)
#ifndef EN_PRO
#define EN_PRO 1
#endif
#ifndef EN_NORM
#define EN_NORM 1
#endif
#ifndef EN_ROPE
#define EN_ROPE 1
#endif
#ifndef EN_ATTN
#define EN_ATTN 1
#endif
#ifndef EN_SCAN
#define EN_SCAN 1
#endif
#ifndef EN_MFIN
#define EN_MFIN 1
#endif
#ifndef EN_CONV
#define EN_CONV 1
#endif
#ifndef EN_FINAL
#define EN_FINAL 1
#endif
#ifndef EN_G1
#define EN_G1 1
#endif
#ifndef EN_G2
#define EN_G2 1
#endif
#ifndef EN_G3
#define EN_G3 1
#endif
#ifndef EN_G4
#define EN_G4 1
#endif
#ifndef EN_G5
#define EN_G5 1
#endif
#ifndef EN_G6
#define EN_G6 1
#endif
__global__ void __launch_bounds__(NTHREADS, 2) fwd(Args a) {
    extern __shared__ __attribute__((aligned(16))) unsigned char lds_raw[];
    LAS unsigned char* lds = (LAS unsigned char*)lds_raw;
    volatile LAS unsigned* MISC = (volatile LAS unsigned*)(lds + MISC_OFF);
    if (threadIdx.x < 32) MISC[threadIdx.x] = 0u;
    __syncthreads();
    unsigned* ctl = (unsigned*)(a.ws + WS_CTL);
    XcdBarrier bar = xcd_barrier_post(ctl + CW_BAR + a.li * XCD_BAR_WORDS, MISC + 8);
    const int G = gridDim.x, bx = blockIdx.x;
    const int lo = a.ph_lo, hi = a.ph_hi;
#define IN(k) (lo <= (k) && (k) < hi)
#define TL int tid = threadIdx.x; asm volatile("" : "+v"(tid)); const int lane = tid & 63, wave = __builtin_amdgcn_readfirstlane(tid >> 6); (void)lane; (void)wave;
#define SEAM(k) do { if (IN(k) && IN((k) + 1)) xcd_barrier(bar); } while (0)
    unsigned char* ws = a.ws;
    bf16_t* X = (bf16_t*)(ws + WS_X); bf16_t* H = (bf16_t*)(ws + WS_H); bf16_t* Z = (bf16_t*)(ws + WS_Z);
    float* GATE = (float*)(ws + WS_GATE); bf16_t* HF = (bf16_t*)(ws + WS_HF); bf16_t* HB = (bf16_t*)(ws + WS_HB);
    const float* mod = (const float*)(ws + WS_MOD);
    float* PART = (float*)(ws + WS_HB);

    if (EN_PRO && IN(0)) REP(0) { TL phase_prologue(a, lds, tid, lane, wave); }
    SEAM(0);

    for (int i = 0; i < 4; ++i) {
        const int P = 1 + 9 * i, j = i >> 1; const bool last = (i == 3);
        const float* modl = mod + (size_t)i * 9 * MODW;
        const float* xin32 = a.in[I_X]; const float* cin32 = a.in[I_CTX] - (size_t)MX * DM;
        const int pm_hi_mix = last ? MX / 256 : MT / 256;
        if (EN_NORM && IN(P + 0)) REP(1) { TL phase_norm(i == 0 ? (const void*)xin32 : (const void*)X, i == 0, i == 0 ? (const void*)cin32 : (const void*)X, i == 0, a.in[I_GMIX] + (size_t)i * DM, modl, 0, DM, H, MT, i > 0 ? PART : (const float*)nullptr, X, lane, wave); }
        SEAM(P + 0);
        if ((i & 1) == 0) {
            if (EN_G1 && IN(P + 1)) REP(2) { pg8::Gemm g{H, (const bf16_t*)(ws + WS_WQKV) + (size_t)j * NQKV * DM, MT, NQKV, DM, DM}; RangeOrder S; S.init(0, MT / 256, NQKV, G, bx);
                EpiQKV E{Z, (const float*)(ws + WS_ROPE), (const float*)(ws + WS_ROPE + 1 * MiB)};
#if PROBE_KIND
                if (PROBE_SITE == 2 && i == 2) pg8::gemm_phase<EpiQKV, RangeOrder, true>(lds, g, S, E, (unsigned long long*)(ws + 512 * 1024) + 64 * bx); else
#endif
                S.donectr = (unsigned*)(ws + WS_CTL) + CW_DONE + 64 * (2 * i);
                pg8::gemm_phase<EpiQKV, RangeOrder>(lds, g, S, E, nullptr);
                BG_TAIL((MT / 256) * (NQKV / 256), 2 * i); }
            SEAM(P + 1);
            if (EN_ATTN && IN(P + 3)) REP(3) { phase_attn(Z, H, a.in[I_SINK] + (size_t)j * 16, (char*)lds_raw); }
            SEAM(P + 3);
            if (EN_G2 && IN(P + 4)) { const bf16_t* Wt = (const bf16_t*)(ws + WS_WAO) + (size_t)j * DM * DM;
                { pg8::Gemm g{H, Wt, MT, DM, DM, DM}; RangeOrder S; S.init(0, MX / 256, DM, G, bx);
                  EpiRes E{xin32, i == 0 ? (const bf16_t*)nullptr : X, X, modl + 2 * DM}; pg8::gemm_phase<EpiRes, RangeOrder>(lds, g, S, E, nullptr); }
                { pg8::Gemm g{H, Wt, MT, DM, DM / 4, DM}; SplitOrder S; S.init(DM, DM, G, bx);
                  EpiPart E{PART, modl + 2 * DM, DM / 4}; pg8::gemm_phase<EpiPart, SplitOrder>(lds, g, S, E, nullptr); } }
            SEAM(P + 4);
        } else {
            if (EN_G3 && IN(P + 1)) REP(4) { pg8::Gemm g{H, (const bf16_t*)(ws + WS_WMI) + (size_t)j * NMI_PAD * DM, MT, NMI, DM, DM}; RangeOrder S; S.init(0, MT / 256, NMI, G, bx);
                EpiMI E{Z, GATE, a.in[I_BMI] + (size_t)j * NMI_RAW}; pg8::gemm_phase<EpiMI, RangeOrder>(lds, g, S, E, nullptr);
                { TL gate_run(a, lds, H, (const bf16_t*)(ws + WS_WMI) + (size_t)j * NMI_PAD * DM + (size_t)NMI * DM, a.in[I_BMI] + (size_t)j * NMI_RAW + NMI, GATE, j, tid, lane, wave); } }
            SEAM(P + 1);
            if (EN_SCAN && IN(P + 2)) REP(5) { TL phase_scan4(Z, GATE, HF, HB, !last, lds, tid, lane, wave); }
            SEAM(P + 2);
            if (EN_MFIN && IN(P + 3)) REP(6) { TL phase_mfinish(Z, HF, HB, a.in[I_GHEAD] + (size_t)j * DM, H, last ? MX : MT, lane, wave); }
            SEAM(P + 3);
            if (EN_G4 && IN(P + 4)) { const bf16_t* Wt = (const bf16_t*)(ws + WS_WMO) + (size_t)j * DM * DM;
                { pg8::Gemm g{H, Wt, MT, DM, DM, DM}; RangeOrder S; S.init(0, MX / 256, DM, G, bx);
                  EpiRes E{xin32, i == 0 ? (const bf16_t*)nullptr : X, X, modl + 2 * DM}; pg8::gemm_phase<EpiRes, RangeOrder>(lds, g, S, E, nullptr); }
                if (!last) { pg8::Gemm g{H, Wt, MT, DM, DM / 4, DM}; SplitOrder S; S.init(DM, DM, G, bx);
                  EpiPart E{PART, modl + 2 * DM, DM / 4}; pg8::gemm_phase<EpiPart, SplitOrder>(lds, g, S, E, nullptr); } }
            SEAM(P + 4);
        }
        if (EN_NORM && IN(P + 5)) REP(1) { TL phase_norm((const void*)X, false, i == 0 ? (const void*)cin32 : (const void*)X, i == 0, a.in[I_GFFN] + (size_t)i * DM, modl, 3 * DM, 4 * DM, H, last ? MX : MT, last ? (const float*)nullptr : PART, X, lane, wave); }
        SEAM(P + 5);
        {
            const int pm_hi = last ? MX / 256 : MT / 256;
            bf16_t* Gb = (bf16_t*)(ws + WS_Z); float* EA = (float*)(ws + WS_HF); float* EB = (float*)(ws + WS_HF + 16 * MiB);
            const float* cwp = a.in[I_CONVW] + (size_t)i * 3 * NUP; const float* cbp = a.in[I_CONVB] + (size_t)i * NUP;
            if (EN_G5 && IN(P + 6)) REP(7) { pg8::Gemm g{H, (const bf16_t*)(ws + WS_WUP) + (size_t)i * NUP * DM, MT, NUP, DM, DM}; RangeOrder S; S.init(0, pm_hi, NUP, G, bx);
                EpiUpConv E{Gb, EA, EB, cwp, cbp, (LAS float*)(lds + 132096)}; S.donectr = (unsigned*)(ws + WS_CTL) + CW_DONE + 64 * (2 * i + 1);
#if PROBE_KIND
                if (PROBE_SITE == 0 && i == 2) pg8::gemm_phase<EpiUpConv, RangeOrder, true>(lds, g, S, E, (unsigned long long*)(ws + 512 * 1024) + 64 * bx); else
#endif
                pg8::gemm_phase<EpiUpConv, RangeOrder>(lds, g, S, E, nullptr);
                BG_TAIL(pm_hi * (NUP / 256), 2 * i + 1); }
            SEAM(P + 6);
            if (EN_CONV && IN(P + 7)) REP(8) { TL phase_ffn_fix(Gb, EA, EB, cwp, cbp, pm_hi, tid); }
            SEAM(P + 7);
            if (EN_G6 && IN(P + 8)) { const bf16_t* Wt = (const bf16_t*)(ws + WS_WDN) + (size_t)i * DM * DFF;
                pg8::Gemm g{Gb, Wt, MT, DM, DFF, DFF}; RangeOrder S; S.init(0, MX / 256, DM, G, bx);
                EpiRes E{(const float*)nullptr, X, X, modl + 5 * DM};
#if PROBE_KIND
                if (PROBE_SITE == 1 && i == 2) pg8::gemm_phase<EpiRes, RangeOrder, true>(lds, g, S, E, (unsigned long long*)(ws + 512 * 1024) + 64 * bx); else
#endif
                pg8::gemm_phase<EpiRes, RangeOrder>(lds, g, S, E, nullptr);
                if (!last) { TL bg_run(a, lds, i + 1, i + 1, 1 << 30, (const unsigned*)nullptr, 0u, tid, lane, wave); __syncthreads(); }
                if (!last) { pg8::Gemm g2{Gb, Wt, MT, DM, DFF / 4, DFF}; SplitOrder S2; S2.init(DM, DFF, G, bx);
                  EpiPart E2{PART, modl + 5 * DM, DFF / 4}; pg8::gemm_phase<EpiPart, SplitOrder>(lds, g2, S2, E2, nullptr); } }
            SEAM(P + 8);
        }
    }
    if (EN_FINAL && IN(37)) { TL phase_final(X, a.in[I_GFINAL], a.out, lane, wave); }
#if PROBE_KIND
    __syncthreads();
    if (blockIdx.x == 0 && threadIdx.x == 0) {
        const unsigned long long* st = (const unsigned long long*)(ws + 512 * 1024) + 64 * PROBE_WG;
        double kl = 0, ep = 0; const int n = PROBE_N;
        for (int u = 1; u < 1 + n; ++u) { kl += (double)(st[2 + 2 * u] - st[3 + 2 * (u - 1)]); ep += (double)(st[3 + 2 * u] - st[2 + 2 * u]); }
        const double cyc = (double)(st[3 + 2 * 20] - st[3 + 2 * 1]), tk = 0;
        float v = 0.f;
        if (PROBE_KIND == 1) v = (float)(kl / n / 100.0);
        if (PROBE_KIND == 2) v = (float)(ep / n / 100.0);
        if (PROBE_KIND == 3) v = (float)((double)(st[63] - st[62]) / 10.0);
        if (PROBE_KIND == 4) v = (float)(cyc / 19.0 / 100.0);
        a.out[0] = v;
    }
#endif
#undef IN
#undef SEAM
}

#ifndef MK_N_LAUNCHES
#define MK_N_LAUNCHES 1
#endif
extern "C" void kernel_launch(void* const* d_in, const int* in_sizes, int n_in, void* d_out, int out_size, void* d_ws, size_t ws_size, hipStream_t stream) {
    static int grid = 0;
    if (grid == 0) {
        if (n_in != 20 || in_sizes[0] != MX * DM || out_size != MX * DM || ws_size < WS_END) {
            fprintf(stderr, "kernel_launch: shape mismatch (n_in %d, in0 %d, out %d, ws %zu, need ws >= %zu); nothing launched\n", n_in, n_in > 0 ? in_sizes[0] : -1, out_size, ws_size, (size_t)WS_END); grid = -1; return; }
        int dev = 0, cus = 0, per_cu = 0;
        if (hipGetDevice(&dev) != hipSuccess || hipDeviceGetAttribute(&cus, hipDeviceAttributeMultiprocessorCount, dev) != hipSuccess) { fprintf(stderr, "kernel_launch: device query failed\n"); grid = -1; return; }
        if (hipFuncSetAttribute((const void*)fwd, hipFuncAttributeMaxDynamicSharedMemorySize, LDS_BYTES) != hipSuccess) { fprintf(stderr, "kernel_launch: hipFuncSetAttribute failed\n"); grid = -1; return; }
        if (hipOccupancyMaxActiveBlocksPerMultiprocessor(&per_cu, (const void*)fwd, NTHREADS, LDS_BYTES) != hipSuccess || per_cu < 1) {
            fprintf(stderr, "kernel_launch: occupancy query reports %d workgroups per CU; nothing launched\n", per_cu); (void)hipGetLastError(); grid = -1; return; }
        grid = cus;
    }
    if (grid < 0) return;
    if (hipMemsetAsync((char*)d_ws + WS_CTL, 0, CTL_ZERO_BYTES, stream) != hipSuccess) { fprintf(stderr, "kernel_launch: memset failed\n"); return; }
    Args a{};
    for (int i = 0; i < 20; ++i) a.in[i] = (const float*)d_in[i];
    a.out = (float*)d_out; a.ws = (unsigned char*)d_ws; a.pad = 0;
    constexpr int NL = MK_N_LAUNCHES;
    for (int li = 0; li < NL; ++li) {
        a.ph_lo = (int)((long)li * N_PHASES / NL); a.ph_hi = (int)((long)(li + 1) * N_PHASES / NL); a.li = li;
        hipLaunchKernelGGL(fwd, dim3(grid), dim3(NTHREADS), LDS_BYTES, stream, a);
        const hipError_t le = hipPeekAtLastError();
        if (le != hipSuccess) { fprintf(stderr, "kernel_launch: launch %d failed: %s\n", li, hipGetErrorName(le)); break; }
    }
}
```
